# Optimizing an MI355X kernel written in HIP

```python
import math
import jax, jax.numpy as jnp
from jax import lax
import numpy as np

D_MODEL = 2048
BATCH = 2
SEQ = 8192
DEPTH = 2

HEAD_DIM = 128
N_MOBA_HEADS = 8
N_FOX_HEADS = 8
MOBA_BLOCK = 256
MOBA_TOPK = 3
MOBA_Q_CHUNK = 64
Q_CHUNK = 128
N_DSA_HEADS = 16
DSA_Q_RANK = 512
DSA_KV_RANK = 512
IDX_HEADS = 16
IDX_DIM = 64
DSA_TOPK_MAX = 256
REL_BUCKETS = 32
REL_MAX_DIST = 128
N_BIAS_HEADS = max(N_MOBA_HEADS, N_DSA_HEADS)
D_FF_DENSE = 5632
N_EXPERTS = 8
MOE_TOPK = 2
D_FF_EXPERT = 7168
EXPERT_ROWS = 256
FORGET_BIAS_CENTER = 2.0
LN_EPS = 1e-5
RMS_EPS = 1e-6
N_EVEN = (DEPTH + 1) // 2
N_ODD = DEPTH // 2
DEEPNORM_ALPHA = (2 * DEPTH) ** 0.25
DEEPNORM_BETA = (8 * DEPTH) ** -0.25
F32 = jnp.float32

kernel_name = 'hybrid_moba_fox_dsa_moe_deepnorm'


def layer_norm(x, g, b):
    xf = x.astype(F32)
    mu = jnp.mean(xf, axis=-1, keepdims=True)
    var = jnp.mean(jnp.square(xf - mu), axis=-1, keepdims=True)
    return ((xf - mu) * lax.rsqrt(var + LN_EPS) * g.astype(F32) + b.astype(F32)).astype(x.dtype)


def rms_norm(x, g):
    xf = x.astype(F32)
    return (xf * lax.rsqrt(jnp.mean(xf * xf, axis=-1, keepdims=True) + RMS_EPS) * g.astype(F32)).astype(x.dtype)


def rel_bucket(dist):
    n = jnp.maximum(dist, 0)
    exact = REL_BUCKETS // 2
    nf = jnp.maximum(n, 1).astype(F32)
    large = exact + (jnp.log(nf / exact) / math.log(REL_MAX_DIST / exact) * (REL_BUCKETS - exact)).astype(jnp.int32)
    large = jnp.minimum(large, REL_BUCKETS - 1)
    return jnp.where(n < exact, n, large)


def rel_bias_per_head(table, bucket):
    n_heads = bucket.shape[1]
    tab = table[:, :n_heads].T.astype(F32)
    hid = jnp.arange(n_heads).reshape((1, n_heads) + (1,) * (bucket.ndim - 2))
    return tab[hid, bucket]


def rel_bias_shared(table, bucket, n_heads):
    return jnp.moveaxis(table[bucket, :n_heads].astype(F32), -1, 0)


def split_heads(z, n_heads):
    b, t, _ = z.shape
    return z.reshape(b, t, n_heads, HEAD_DIM).transpose(0, 2, 1, 3)


def moba_attention(q, k, v, rel_table):
    B, H, T, Dh = q.shape
    nb = -(-T // MOBA_BLOCK)
    tp = nb * MOBA_BLOCK
    pad = ((0, 0), (0, 0), (0, tp - T), (0, 0))
    kp = jnp.pad(k, pad)
    vp = jnp.pad(v, pad)
    kb = kp.reshape(B, H, nb, MOBA_BLOCK, Dh)
    vb = vp.reshape(B, H, nb, MOBA_BLOCK, Dh)
    k_mean = jnp.mean(kb.astype(F32), axis=3)
    n_sel = min(MOBA_TOPK, nb)
    scale = Dh ** -0.5
    blk_ids = jnp.arange(nb)
    offs = jnp.arange(MOBA_BLOCK)
    gather_blocks = jax.vmap(jax.vmap(lambda blocks, idx: blocks[idx]))

    def chunk(ci):
        start = ci * MOBA_Q_CHUNK
        qc = lax.dynamic_slice_in_dim(q, start, MOBA_Q_CHUNK, axis=2)
        t = start + jnp.arange(MOBA_Q_CHUNK)
        own = start // MOBA_BLOCK
        gate = jnp.einsum('bhqd,bhnd->bhqn', qc.astype(F32), k_mean)
        gate = jnp.where(blk_ids < own, gate, -jnp.inf)
        _, sel = lax.top_k(gate, n_sel)
        valid = sel < own
        kg = gather_blocks(kb, sel)
        vg = gather_blocks(vb, sel)
        s_sel = jnp.einsum('bhqd,bhqnld->bhqnl', qc, kg).astype(F32) * scale
        pos = sel[..., None] * MOBA_BLOCK + offs
        s_sel = s_sel + rel_bias_per_head(rel_table, rel_bucket(t[:, None, None] - pos))
        s_sel = jnp.where(valid[..., None], s_sel, -jnp.inf)
        own_start = own * MOBA_BLOCK
        ko = lax.dynamic_slice_in_dim(kp, own_start, MOBA_BLOCK, axis=2)
        vo = lax.dynamic_slice_in_dim(vp, own_start, MOBA_BLOCK, axis=2)
        pos_o = own_start + offs
        s_own = jnp.einsum('bhqd,bhld->bhql', qc, ko).astype(F32) * scale + rel_bias_shared(rel_table, rel_bucket(t[:, None] - pos_o[None, :]), H)
        s_own = jnp.where(pos_o[None, :] <= t[:, None], s_own, -jnp.inf)
        logits = jnp.concatenate([s_sel.reshape(B, H, MOBA_Q_CHUNK, n_sel * MOBA_BLOCK), s_own], axis=-1)
        p = jax.nn.softmax(logits, axis=-1).astype(v.dtype)
        p_sel = p[..., :n_sel * MOBA_BLOCK].reshape(B, H, MOBA_Q_CHUNK, n_sel, MOBA_BLOCK)
        p_own = p[..., n_sel * MOBA_BLOCK:]
        return jnp.einsum('bhqnl,bhqnld->bhqd', p_sel, vg) + jnp.einsum('bhql,bhld->bhqd', p_own, vo)

    outs = lax.map(chunk, jnp.arange(T // MOBA_Q_CHUNK))
    return outs.transpose(1, 0, 3, 2, 4).reshape(B, T, H * Dh)


def forgetting_attention(q, k, v, log_f):
    B, H, T, Dh = q.shape
    csum = jnp.cumsum(log_f, axis=-1)
    scale = Dh ** -0.5
    s_pos = jnp.arange(T)

    def chunk(ci):
        start = ci * Q_CHUNK
        qc = lax.dynamic_slice_in_dim(q, start, Q_CHUNK, axis=2)
        cq = lax.dynamic_slice_in_dim(csum, start, Q_CHUNK, axis=2)
        t = start + jnp.arange(Q_CHUNK)
        s = jnp.einsum('bhqd,bhsd->bhqs', qc, k).astype(F32) * scale + (cq[..., :, None] - csum[:, :, None, :])
        s = jnp.where(s_pos[None, :] <= t[:, None], s, -jnp.inf)
        p = jax.nn.softmax(s, axis=-1).astype(v.dtype)
        return jnp.einsum('bhqs,bhsd->bhqd', p, v)

    outs = lax.map(chunk, jnp.arange(T // Q_CHUNK))
    return outs.transpose(1, 0, 3, 2, 4).reshape(B, T, H * Dh)


def moba_fox_mixer(x, w_in, b_forget, w_out, rel_table):
    wa = N_MOBA_HEADS * HEAD_DIM
    wb = N_FOX_HEADS * HEAD_DIM
    proj = x @ w_in
    cuts = [wa, 2 * wa, 3 * wa, 3 * wa + wb, 3 * wa + 2 * wb, 3 * wa + 3 * wb]
    qa, ka, va, qb, kb, vb, fb = jnp.split(proj, cuts, axis=-1)
    log_f = jax.nn.log_sigmoid(fb.astype(F32) + b_forget.astype(F32)).transpose(0, 2, 1)
    oa = moba_attention(split_heads(qa, N_MOBA_HEADS), split_heads(ka, N_MOBA_HEADS), split_heads(va, N_MOBA_HEADS), rel_table)
    ob = forgetting_attention(split_heads(qb, N_FOX_HEADS), split_heads(kb, N_FOX_HEADS), split_heads(vb, N_FOX_HEADS), log_f)
    return jnp.concatenate([oa, ob], axis=-1) @ w_out


def dsa_mixer(x, w_in, q_norm_g, kv_norm_g, w_uq, w_qidx, w_uk, w_uv, w_out, rel_table):
    B, T, _ = x.shape
    proj = x @ w_in
    c_q, c_kv, k_idx, w_idx = jnp.split(proj, [DSA_Q_RANK, DSA_Q_RANK + DSA_KV_RANK, DSA_Q_RANK + DSA_KV_RANK + IDX_DIM], axis=-1)
    c_q = rms_norm(c_q, q_norm_g)
    c_kv = rms_norm(c_kv, kv_norm_g)
    q_idx = (c_q @ w_qidx).reshape(B, T, IDX_HEADS, IDX_DIM)
    w_idx = w_idx.astype(F32) * IDX_HEADS ** -0.5
    k_sel = min(DSA_TOPK_MAX, T // 4)
    gather_rows = jax.vmap(lambda c, i: c[i])
    s_pos = jnp.arange(T)
    scale = HEAD_DIM ** -0.5

    def chunk(ci):
        start = ci * Q_CHUNK
        t = start + jnp.arange(Q_CHUNK)
        qi = lax.dynamic_slice_in_dim(q_idx, start, Q_CHUNK, axis=1)
        wi = lax.dynamic_slice_in_dim(w_idx, start, Q_CHUNK, axis=1)
        dots = jnp.einsum('bqhd,bsd->bqhs', qi, k_idx).astype(F32) * IDX_DIM ** -0.5
        score = jnp.einsum('bqhs,bqh->bqs', jax.nn.relu(dots), wi)
        score = jnp.where(s_pos[None, None, :] <= t[None, :, None], score, -jnp.inf)
        _, sel = lax.top_k(score, k_sel)
        valid = sel <= t[None, :, None]
        ckv_g = gather_rows(c_kv, sel)
        cq = lax.dynamic_slice_in_dim(c_q, start, Q_CHUNK, axis=1)
        q = (cq @ w_uq).reshape(B, Q_CHUNK, N_DSA_HEADS, HEAD_DIM)
        q_lat = jnp.einsum('bqhd,hrd->bqhr', q, w_uk)
        s = jnp.einsum('bqhr,bqkr->bhqk', q_lat, ckv_g).astype(F32) * scale
        bias = rel_table[rel_bucket(t[None, :, None] - sel), :N_DSA_HEADS].astype(F32)
        s = s + bias.transpose(0, 3, 1, 2)
        s = jnp.where(valid[:, None], s, -jnp.inf)
        p = jax.nn.softmax(s, axis=-1).astype(ckv_g.dtype)
        o_lat = jnp.einsum('bhqk,bqkr->bqhr', p, ckv_g)
        o = jnp.einsum('bqhr,hrd->bqhd', o_lat, w_uv)
        return o.reshape(B, Q_CHUNK, N_DSA_HEADS * HEAD_DIM)

    outs = lax.map(chunk, jnp.arange(T // Q_CHUNK))
    return outs.transpose(1, 0, 2, 3).reshape(B, T, N_DSA_HEADS * HEAD_DIM) @ w_out


def swiglu(x, w1, w3, w2):
    return (jax.nn.silu(x @ w1) * (x @ w3)) @ w2


def moe_swiglu(x, router, w1, w3, w2):
    B, T, D = x.shape
    N = B * T
    xf = x.reshape(N, D)
    logits = (xf @ router).astype(F32)
    top_logits, top_e = lax.top_k(logits, MOE_TOPK)
    gates = jax.nn.softmax(top_logits, axis=-1)
    n_assign = N * MOE_TOPK
    flat_e = top_e.reshape(-1).astype(jnp.int32)
    order = jnp.argsort(flat_e)
    sorted_e = flat_e[order]
    sorted_tok = (order // MOE_TOPK).astype(jnp.int32)
    counts = jnp.bincount(flat_e, length=N_EXPERTS)
    padded = (counts + EXPERT_ROWS - 1) // EXPERT_ROWS * EXPERT_ROWS
    pend = jnp.cumsum(padded)
    pstart = pend - padded
    ustart = jnp.cumsum(counts) - counts
    dest = (pstart[sorted_e] + jnp.arange(n_assign) - ustart[sorted_e]).astype(jnp.int32)
    n_rows = -(-(n_assign + N_EXPERTS * (EXPERT_ROWS - 1)) // EXPERT_ROWS) * EXPERT_ROWS
    n_blk = n_rows // EXPERT_ROWS
    row_tok = jnp.zeros((n_rows,), jnp.int32).at[dest].set(sorted_tok)
    blk_e = jnp.minimum(jnp.searchsorted(pend, jnp.arange(n_blk) * EXPERT_ROWS, side='right'), N_EXPERTS - 1)

    def expert_block(args):
        tok, e = args
        xb = xf[tok]
        h = jax.nn.silu(xb @ w1[e]) * (xb @ w3[e])
        return h @ w2[e]

    rows = lax.map(expert_block, (row_tok.reshape(n_blk, EXPERT_ROWS), blk_e)).reshape(n_rows, D)
    assign_row = jnp.zeros((n_assign,), jnp.int32).at[order].set(dest)
    y = rows[assign_row].reshape(N, MOE_TOPK, D)
    out = jnp.einsum('nkd,nk->nd', y, gates.astype(y.dtype))
    return out.reshape(B, T, D)


def setup_inputs(seed: int = 0) -> dict:
    key = jax.random.key(seed)
    keys = iter(jax.random.split(key, 48))

    def nrm(shape, scale):
        return jax.random.normal(next(keys), shape, F32) * scale

    D = D_MODEL
    beta = DEEPNORM_BETA
    wa = N_MOBA_HEADS * HEAD_DIM
    wb = N_FOX_HEADS * HEAD_DIM
    wc = N_DSA_HEADS * HEAD_DIM
    sd = D ** -0.5
    inp = {}
    inp['x'] = nrm((BATCH, SEQ, D), 1.0)
    inp['rel_table'] = nrm((REL_BUCKETS, N_BIAS_HEADS), 0.3)
    inp['ev_w_in'] = jnp.concatenate([
        nrm((N_EVEN, D, wa), sd), nrm((N_EVEN, D, wa), sd), nrm((N_EVEN, D, wa), beta * sd),
        nrm((N_EVEN, D, wb), sd), nrm((N_EVEN, D, wb), sd), nrm((N_EVEN, D, wb), beta * sd),
        nrm((N_EVEN, D, N_FOX_HEADS), sd)], axis=-1)
    inp['ev_b_forget'] = FORGET_BIAS_CENTER + nrm((N_EVEN, N_FOX_HEADS), 0.1)
    inp['ev_w_out'] = nrm((N_EVEN, wa + wb, D), beta * (wa + wb) ** -0.5)
    inp['ev_ln1_g'] = 1.0 + nrm((N_EVEN, D), 0.01)
    inp['ev_ln1_b'] = nrm((N_EVEN, D), 0.01)
    inp['ev_ffn_w1'] = nrm((N_EVEN, D, D_FF_DENSE), beta * sd)
    inp['ev_ffn_w3'] = nrm((N_EVEN, D, D_FF_DENSE), beta * sd)
    inp['ev_ffn_w2'] = nrm((N_EVEN, D_FF_DENSE, D), beta * D_FF_DENSE ** -0.5)
    inp['ev_ln2_g'] = 1.0 + nrm((N_EVEN, D), 0.01)
    inp['ev_ln2_b'] = nrm((N_EVEN, D), 0.01)
    inp['od_w_in'] = nrm((N_ODD, D, DSA_Q_RANK + DSA_KV_RANK + IDX_DIM + IDX_HEADS), sd)
    inp['od_q_norm_g'] = 1.0 + nrm((N_ODD, DSA_Q_RANK), 0.01)
    inp['od_kv_norm_g'] = 1.0 + nrm((N_ODD, DSA_KV_RANK), 0.01)
    inp['od_w_uq'] = nrm((N_ODD, DSA_Q_RANK, wc), DSA_Q_RANK ** -0.5)
    inp['od_w_qidx'] = nrm((N_ODD, DSA_Q_RANK, IDX_HEADS * IDX_DIM), DSA_Q_RANK ** -0.5)
    inp['od_w_uk'] = nrm((N_ODD, N_DSA_HEADS, DSA_KV_RANK, HEAD_DIM), DSA_KV_RANK ** -0.5)
    inp['od_w_uv'] = nrm((N_ODD, N_DSA_HEADS, DSA_KV_RANK, HEAD_DIM), beta * DSA_KV_RANK ** -0.5)
    inp['od_w_out'] = nrm((N_ODD, wc, D), beta * wc ** -0.5)
    inp['od_ln1_g'] = 1.0 + nrm((N_ODD, D), 0.01)
    inp['od_ln1_b'] = nrm((N_ODD, D), 0.01)
    inp['od_router'] = nrm((N_ODD, D, N_EXPERTS), sd)
    inp['od_exp_w1'] = nrm((N_ODD, N_EXPERTS, D, D_FF_EXPERT), beta * sd)
    inp['od_exp_w3'] = nrm((N_ODD, N_EXPERTS, D, D_FF_EXPERT), beta * sd)
    inp['od_exp_w2'] = nrm((N_ODD, N_EXPERTS, D_FF_EXPERT, D), beta * D_FF_EXPERT ** -0.5)
    inp['od_ln2_g'] = 1.0 + nrm((N_ODD, D), 0.01)
    inp['od_ln2_b'] = nrm((N_ODD, D), 0.01)
    return inp


def reference(x, rel_table, ev_w_in, ev_b_forget, ev_w_out, ev_ln1_g, ev_ln1_b, ev_ffn_w1, ev_ffn_w3, ev_ffn_w2, ev_ln2_g, ev_ln2_b, od_w_in, od_q_norm_g, od_kv_norm_g, od_w_uq, od_w_qidx, od_w_uk, od_w_uv, od_w_out, od_ln1_g, od_ln1_b, od_router, od_exp_w1, od_exp_w3, od_exp_w2, od_ln2_g, od_ln2_b):
    h = x
    for layer in range(DEPTH):
        i = layer // 2
        if layer % 2 == 0:
            mix = moba_fox_mixer(h, ev_w_in[i], ev_b_forget[i], ev_w_out[i], rel_table)
            h = layer_norm(DEEPNORM_ALPHA * h + mix, ev_ln1_g[i], ev_ln1_b[i])
            ff = swiglu(h, ev_ffn_w1[i], ev_ffn_w3[i], ev_ffn_w2[i])
            h = layer_norm(DEEPNORM_ALPHA * h + ff, ev_ln2_g[i], ev_ln2_b[i])
        else:
            mix = dsa_mixer(h, od_w_in[i], od_q_norm_g[i], od_kv_norm_g[i], od_w_uq[i], od_w_qidx[i], od_w_uk[i], od_w_uv[i], od_w_out[i], rel_table)
            h = layer_norm(DEEPNORM_ALPHA * h + mix, od_ln1_g[i], od_ln1_b[i])
            ff = moe_swiglu(h, od_router[i], od_exp_w1[i], od_exp_w3[i], od_exp_w2[i])
            h = layer_norm(DEEPNORM_ALPHA * h + ff, od_ln2_g[i], od_ln2_b[i])
    return h
```

```cpp
#include <hip/hip_runtime.h>
#include <cstdint>
#include <cstdio>

#define GAS __attribute__((address_space(1)))
#define LAS __attribute__((address_space(3)))
typedef unsigned short bf16_t;
typedef short bf16x8 __attribute__((ext_vector_type(8)));
typedef short s16x4 __attribute__((ext_vector_type(4)));
typedef float f32x2 __attribute__((ext_vector_type(2)));
typedef float f32x4 __attribute__((ext_vector_type(4)));
typedef float f32x16 __attribute__((ext_vector_type(16)));
typedef unsigned u32x2 __attribute__((ext_vector_type(2)));
typedef unsigned u32x4 __attribute__((ext_vector_type(4)));
typedef GAS unsigned gu32;
#define RLX_AGENT __ATOMIC_RELAXED, __HIP_MEMORY_SCOPE_AGENT
#define LDS_WAIT() asm volatile("s_waitcnt lgkmcnt(0)" ::: "memory")
#define VM_WAIT() asm volatile("s_waitcnt vmcnt(0)" ::: "memory")
#define SBAR() __builtin_amdgcn_sched_barrier(0)

__device__ __forceinline__ unsigned cvt_pk_bf16(float lo, float hi) { unsigned r; asm volatile("v_cvt_pk_bf16_f32 %0, %1, %2" : "=v"(r) : "v"(lo), "v"(hi)); return r; }
__device__ __forceinline__ unsigned f2bf(float f) { unsigned u = __builtin_bit_cast(unsigned, f); return (u + 0x7fffu + ((u >> 16) & 1u)) >> 16; }
__device__ __forceinline__ unsigned pk2(float lo, float hi) { return f2bf(lo) | (f2bf(hi) << 16); }
__device__ __forceinline__ float bf2f(unsigned short b) { return __builtin_bit_cast(float, ((unsigned)b) << 16); }
__device__ __forceinline__ float bflo(unsigned w) { return __builtin_bit_cast(float, w << 16); }
__device__ __forceinline__ float bfhi(unsigned w) { return __builtin_bit_cast(float, w & 0xffff0000u); }
#define WAVE_DPP(v, ctrl) __builtin_bit_cast(float, __builtin_amdgcn_mov_dpp(__builtin_bit_cast(int, v), ctrl, 0xF, 0xF, true))
#define WAVE_DPP_ROWS(old_, v, ctrl, rmask) __builtin_bit_cast(float, __builtin_amdgcn_update_dpp(__builtin_bit_cast(int, old_), __builtin_bit_cast(int, v), ctrl, rmask, 0xF, false))
__device__ __forceinline__ float wave_sum(float v) {
    v += WAVE_DPP(v, 0xB1);
    v += WAVE_DPP(v, 0x4E);
    v += WAVE_DPP(v, 0x141);
    v += WAVE_DPP(v, 0x140);
    v += WAVE_DPP_ROWS(0.0f, v, 0x142, 0xA);
    v += WAVE_DPP_ROWS(0.0f, v, 0x143, 0xC);
    return __builtin_bit_cast(float, __builtin_amdgcn_readlane(__builtin_bit_cast(int, v), 63));
}
__device__ __forceinline__ float row16_sum(float v) { v += WAVE_DPP(v, 0xB1); v += WAVE_DPP(v, 0x4E); v += WAVE_DPP(v, 0x141); v += WAVE_DPP(v, 0x140); return v; }
__device__ __forceinline__ float wave_max(float v) {
    v = fmaxf(v, WAVE_DPP(v, 0xB1)); v = fmaxf(v, WAVE_DPP(v, 0x4E)); v = fmaxf(v, WAVE_DPP(v, 0x141)); v = fmaxf(v, WAVE_DPP(v, 0x140));
    v = fmaxf(v, WAVE_DPP_ROWS(v, v, 0x142, 0xA)); v = fmaxf(v, WAVE_DPP_ROWS(v, v, 0x143, 0xC));
    return __builtin_bit_cast(float, __builtin_amdgcn_readlane(__builtin_bit_cast(int, v), 63));
}

#define XB_TMO      128
#define XB_XCNT(j)  (256  + 64 * (j))
#define XB_XSUB(j)  (1280 + 64 * (j))
#define XB_XGEN(j)  (2304 + 64 * (j))
#define XB_TOP      3328
#define XB_TOPGEN   3392
#define XCD_BAR_WORDS 3456
#define XB_SPIN_CAP (1u << 18)
__device__ __forceinline__ unsigned xb_ld(unsigned* p)              { return __hip_atomic_load(p, __ATOMIC_RELAXED, __HIP_MEMORY_SCOPE_AGENT); }
__device__ __forceinline__ unsigned xb_add(unsigned* p, unsigned v) { return __hip_atomic_fetch_add(p, v, __ATOMIC_RELAXED, __HIP_MEMORY_SCOPE_AGENT); }
__device__ __forceinline__ unsigned xb_xcc_id() { return (unsigned)__builtin_amdgcn_s_getreg((3 << 11) | 20) & 0xFu; }
#define XB_SPIN(cond, bar) do { unsigned _sp = 0; while (cond) { __builtin_amdgcn_s_sleep(1); \
    if ((++_sp & 255u) == 0u) { if (xb_ld(&(bar)[XB_TMO])) break; if (_sp > XB_SPIN_CAP) { atomicAdd(&(bar)[XB_TMO], 1u); break; } } } } while (0)
struct XcdBarrier { unsigned* bar; unsigned x; volatile LAS unsigned* st; };
__device__ __forceinline__ XcdBarrier xcd_barrier_post(unsigned* bar, volatile LAS unsigned* st, bool leader) {
    XcdBarrier b; b.bar = bar; b.x = xb_xcc_id(); b.st = st;
    if (leader) (void)xb_add(&bar[XB_XCNT(b.x)], 1u);
    return b;
}
__device__ __forceinline__ void xcd_barrier_complete(unsigned* bar, unsigned x, unsigned& nloc, unsigned& nx) {
    const unsigned G = gridDim.x * gridDim.y * gridDim.z;
    unsigned sum, cnt, mine, sp = 0u;
    for (;;) {
        sum = 0u; cnt = 0u; mine = 0u;
#pragma unroll
        for (unsigned j = 0; j < 16; ++j) { const unsigned c = xb_ld(&bar[XB_XCNT(j)]); sum += c; cnt += (c > 0u) ? 1u : 0u; mine = (j == x) ? c : mine; }
        if (sum == G) break;
        __builtin_amdgcn_s_sleep(1);
        if ((++sp & 255u) == 0u) { if (xb_ld(&bar[XB_TMO])) break; if (sp > XB_SPIN_CAP) { atomicAdd(&bar[XB_TMO], 1u); break; } }
    }
    nloc = mine > 0u ? mine : 1u; nx = cnt > 0u ? cnt : 1u;
}
__device__ __forceinline__ void xcd_barrier(const XcdBarrier& b, bool leader) {
    asm volatile("s_waitcnt vmcnt(0)" ::: "memory");
    __syncthreads();
    if (leader) {
        unsigned* bar = b.bar;
        __builtin_amdgcn_s_waitcnt(0);
        unsigned nloc = b.st[0], nx = b.st[1];
        if (nloc == 0u) { xcd_barrier_complete(bar, b.x, nloc, nx); b.st[0] = nloc; b.st[1] = nx; }
        const unsigned old = xb_add(&bar[XB_XSUB(b.x)], 1u);
        const unsigned gen = old / nloc;
        if (old + 1u == (gen + 1u) * nloc) {
            __builtin_amdgcn_fence(__ATOMIC_RELEASE, "agent");
            asm volatile("s_waitcnt vmcnt(0)" ::: "memory");
            const unsigned og = xb_add(&bar[XB_TOP], 1u);
            const unsigned tg = og / nx;
            if (og + 1u == (tg + 1u) * nx) xb_add(&bar[XB_TOPGEN], 1u);
            else XB_SPIN(xb_ld(&bar[XB_TOPGEN]) == tg, bar);
            __builtin_amdgcn_fence(__ATOMIC_ACQUIRE, "agent");
            xb_add(&bar[XB_XGEN(b.x)], 1u);
            asm volatile("s_waitcnt vmcnt(0)" ::: "memory");
        } else {
            XB_SPIN(xb_ld(&bar[XB_XGEN(b.x)]) == gen, bar);
            __builtin_amdgcn_fence(__ATOMIC_ACQUIRE, "agent");
            asm volatile("s_waitcnt vmcnt(0)" ::: "memory");
        }
    }
    __syncthreads();
}

namespace pg8 {
constexpr int BM = 256, BK = 64, HALF = 128, HTB = HALF * BK * 2, STAGE_BYTES = 8 * HTB, NXCD = 8, WGM = 8;
__host__ __device__ __forceinline__ int lds_byte(int r, int c) { const int st = (r >> 4) * 2 + (c >> 5), rr = r & 15, cc = c & 31, ob = rr * 64 + cc * 2; return st * 1024 + (ob ^ (((ob >> 9) & 1) << 5)); }
__host__ __device__ __forceinline__ void stage_rc(int b, int& R, int& C) { const int st = b / 1024, sb = b % 1024, swz = sb ^ (((sb >> 9) & 1) << 5); R = (st >> 1) * 16 + swz / 64; C = (st & 1) * 32 + (swz % 64) / 2; }
__host__ __device__ __forceinline__ int perm32(int rho) { const int n = rho >> 4, i = rho & 15; return 8 * (i >> 2) + 4 * n + (i & 3); }

struct Unit { int arow, brow, akoff, orow, ocol, nt, slab; };
struct Gemm { const bf16_t* A; const bf16_t* Bt; int lda, ldb, K; };

struct TileOrder {
    int nM, nN, nwg, G, c;
    __device__ __forceinline__ void init(int nM_, int nN_, int G_, int c_) { nM = nM_; nN = nN_; nwg = nM * nN; G = G_; c = c_; }
    __device__ __forceinline__ bool tile(int i, int& pm, int& pn) const {
        const long L = (long)i * G + c; if (L >= nwg) return false;
        int wgid = (int)L; { const int q = nwg / NXCD, r = nwg % NXCD, xcd = wgid % NXCD, off = wgid / NXCD; wgid = (xcd < r ? xcd * (q + 1) : r * (q + 1) + (xcd - r) * q) + off; }
        const int nig = WGM * nN, gid = wgid / nig, fm = gid * WGM, gsz = (nM - fm) < WGM ? (nM - fm) : WGM;
        pm = fm + ((wgid % nig) % gsz); pn = (wgid % nig) / gsz; return true;
    }
};
struct PlainSched : TileOrder {
    static constexpr bool KSPLIT = false;
    int akstep;
    __device__ __forceinline__ bool next(int i, Unit& u) const { int pm, pn; if (!tile(i, pm, pn)) return false; u.arow = pm * BM; u.brow = pn * BM; u.akoff = pn * akstep; u.orow = pm * BM; u.ocol = pn * BM; u.nt = 0; u.slab = -1; return true; }
};
struct MoeSched : TileOrder {
    static constexpr bool KSPLIT = false;
    int t1, t2, t3, t4, t5, t6, t7, ttot; int brows;
    __device__ __forceinline__ void set_tstart(const int (&ts)[9]) { t1 = ts[1]; t2 = ts[2]; t3 = ts[3]; t4 = ts[4]; t5 = ts[5]; t6 = ts[6]; t7 = ts[7]; ttot = ts[8]; }
    __device__ __forceinline__ int expert_of(int pm) const { return (pm >= t1) + (pm >= t2) + (pm >= t3) + (pm >= t4) + (pm >= t5) + (pm >= t6) + (pm >= t7); }
    __device__ __forceinline__ bool next(int i, Unit& u) const { int pm, pn; if (!tile(i, pm, pn)) return false;
        const int e = expert_of(pm);
        u.arow = pm * BM; u.brow = e * brows + pn * BM; u.akoff = 0; u.orow = pm * BM; u.ocol = pn * BM; u.nt = 0; u.slab = -1; return true; }
};
__device__ __forceinline__ int split_factor(int nwg, int G, int ktiles) { const int nleft = nwg % G; int S = 1;
#define PG8_TRY_S(v) if (nleft > 0 && (v) * nleft <= G && (ktiles % (2 * (v))) == 0 && ktiles / (v) >= 4) S = (v)
    PG8_TRY_S(2); PG8_TRY_S(4); PG8_TRY_S(7); PG8_TRY_S(8);
#undef PG8_TRY_S
    return S; }
struct MoeSplitSched : MoeSched {
    static constexpr bool KSPLIT = true;
    int nfull, nleft, S, ktiles;
    __device__ __forceinline__ void init2(int nM_, int nN_, int G_, int c_, int ktiles_) { init(nM_, nN_, G_, c_); ktiles = ktiles_; nfull = nwg / G; nleft = nwg - nfull * G; S = split_factor(nwg, G_, ktiles_); }
    __device__ __forceinline__ bool next(int i, Unit& u) const {
        const bool split = (S > 1) && (i >= nfull);
        const int lu = c / S, s = c - lu * S;
        const long L = split ? (long)nfull * G + lu : (long)i * G + c;
        if (L >= nwg || (split && (i > nfull || c >= nleft * S))) return false;
        int wgid = (int)L; { const int q = nwg / NXCD, r = nwg % NXCD, xcd = wgid % NXCD, off = wgid / NXCD; wgid = (xcd < r ? xcd * (q + 1) : r * (q + 1) + (xcd - r) * q) + off; }
        const int nig = WGM * nN, gid = wgid / nig, fm = gid * WGM, gsz = (nM - fm) < WGM ? (nM - fm) : WGM;
        const int pm = fm + ((wgid % nig) % gsz), pn = (wgid % nig) / gsz;
        const int e = expert_of(pm), ntp = ktiles / S;
        u.arow = pm * BM; u.brow = e * brows + pn * BM; u.nt = split ? ntp : 0; u.akoff = split ? s * ntp * BK : 0; u.orow = pm * BM; u.ocol = pn * BM; u.slab = split ? lu * S + s : -1; return true; }
};

struct EpiQKV0 {
    static constexpr bool PERM = true;
    bf16_t* O;
    __device__ __forceinline__ void operator()(const f32x4 (&acc)[2][2][4][2], const Unit& u, int wr, int wc, int fr, int fq) const {
        const int row0 = u.orow + wr * 64 + fr;
#pragma unroll
        for (int bj = 0; bj < 2; ++bj) {
            const int c = u.ocol + bj * HALF, ten = c >> 10, h = (c & 1023) >> 7;
#pragma unroll
            for (int ai = 0; ai < 2; ++ai)
#pragma unroll
                for (int m = 0; m < 4; ++m) { const int row = row0 + ai * HALF + m * 16, b = row >> 13, t = row & 8191;
                    bf16_t* p = O + ((((size_t)ten * 2 + b) * 8 + h) * 8192 + t) * 128 + wc * 32 + 8 * fq;
                    const f32x4 v0 = acc[ai][bj][m][0], v1 = acc[ai][bj][m][1];
                    u32x4 w; w.x = cvt_pk_bf16(v0[0], v0[1]); w.y = cvt_pk_bf16(v0[2], v0[3]); w.z = cvt_pk_bf16(v1[0], v1[1]); w.w = cvt_pk_bf16(v1[2], v1[3]);
                    *(u32x4*)p = w; }
        }
    }
};
struct EpiResF32 {
    static constexpr bool PERM = false;
    const float* res; float* out; int ldc; float alpha; float scale;
    __device__ __forceinline__ void operator()(const f32x4 (&acc)[2][2][4][2], const Unit& u, int wr, int wc, int fr, int fq) const {
        const int row0 = u.orow + wr * 64 + fr, col0 = u.ocol + wc * 32 + 4 * fq;
#pragma unroll
        for (int ai = 0; ai < 2; ++ai)
#pragma unroll
            for (int m = 0; m < 4; ++m) { const size_t off = (size_t)(row0 + ai * HALF + m * 16) * ldc + col0;
                f32x4 r[2][2];
#pragma unroll
                for (int bj = 0; bj < 2; ++bj)
#pragma unroll
                    for (int n = 0; n < 2; ++n) r[bj][n] = *(const f32x4*)(res + off + bj * HALF + n * 16);
#pragma unroll
                for (int bj = 0; bj < 2; ++bj)
#pragma unroll
                    for (int n = 0; n < 2; ++n) *(f32x4*)(out + off + bj * HALF + n * 16) = r[bj][n] * alpha + acc[ai][bj][m][n] * scale;
                asm volatile("" ::: "memory"); }
    }
};
struct EpiResLnF32 {
    static constexpr bool PERM = false;
    const float* res; float* out; int ldc; float alpha; float scale; const float* stat; const float* g; const float* b;
    __device__ __forceinline__ void operator()(const f32x4 (&acc)[2][2][4][2], const Unit& u, int wr, int wc, int fr, int fq) const {
        const int row0 = u.orow + wr * 64 + fr, col0 = u.ocol + wc * 32 + 4 * fq;
#pragma unroll
        for (int bj = 0; bj < 2; ++bj)
#pragma unroll
            for (int n = 0; n < 2; ++n) {
                const int col = col0 + bj * HALF + n * 16;
                const f32x4 gg = *(const f32x4*)(g + col), bb = *(const f32x4*)(b + col);
#pragma unroll
                for (int ai = 0; ai < 2; ++ai)
#pragma unroll
                    for (int m = 0; m < 4; ++m) { const int row = row0 + ai * HALF + m * 16; const size_t off = (size_t)row * ldc + col;
                        const float mean = stat[2 * (size_t)row], rstd = stat[2 * (size_t)row + 1];
                        const f32x4 r = *(const f32x4*)(res + off);
                        *(f32x4*)(out + off) = ((r - mean) * rstd * gg + bb) * alpha + acc[ai][bj][m][n] * scale; }
                asm volatile("" ::: "memory"); }
    }
};
struct EpiF32 {
    static constexpr bool PERM = false;
    float* out; int ldc;
    __device__ __forceinline__ void operator()(const f32x4 (&acc)[2][2][4][2], const Unit& u, int wr, int wc, int fr, int fq) const {
        const int row0 = u.orow + wr * 64 + fr, col0 = u.ocol + wc * 32 + 4 * fq;
#pragma unroll
        for (int ai = 0; ai < 2; ++ai)
#pragma unroll
            for (int m = 0; m < 4; ++m) { float* rowp = out + (size_t)(row0 + ai * HALF + m * 16) * ldc + col0;
#pragma unroll
                for (int bj = 0; bj < 2; ++bj)
#pragma unroll
                    for (int n = 0; n < 2; ++n) *(f32x4*)(rowp + bj * HALF + n * 16) = acc[ai][bj][m][n]; }
    }
};
struct EpiBf16 {
    static constexpr bool PERM = true;
    bf16_t* O0; int ld0; int split; bf16_t* O1; int ld1;
    __device__ __forceinline__ void operator()(const f32x4 (&acc)[2][2][4][2], const Unit& u, int wr, int wc, int fr, int fq) const {
        const int row0 = u.orow + wr * 64 + fr; bf16_t* base = O0; int ld = ld0, colt = u.ocol;
        if (colt >= split) { base = O1; ld = ld1; colt -= split; }
        const int col0 = colt + wc * 32 + 8 * fq;
#pragma unroll
        for (int ai = 0; ai < 2; ++ai)
#pragma unroll
            for (int m = 0; m < 4; ++m) { bf16_t* rowp = base + (size_t)(row0 + ai * HALF + m * 16) * ld + col0;
#pragma unroll
                for (int bj = 0; bj < 2; ++bj) { const f32x4 v0 = acc[ai][bj][m][0], v1 = acc[ai][bj][m][1];
                    u32x4 w; w.x = cvt_pk_bf16(v0[0], v0[1]); w.y = cvt_pk_bf16(v0[2], v0[3]); w.z = cvt_pk_bf16(v1[0], v1[1]); w.w = cvt_pk_bf16(v1[2], v1[3]);
                    *(u32x4*)(rowp + bj * HALF) = w; } }
    }
};
struct EpiYSlab {
    static constexpr bool PERM = true;
    bf16_t* O; int ld; float* slabs; unsigned* flags; int nN, S; float scale;
    __device__ __forceinline__ void operator()(const f32x4 (&acc)[2][2][4][2], const Unit& u, int wr, int wc, int fr, int fq) const {
        if (u.slab < 0) {
            const int row0 = u.orow + wr * 64 + fr, col0 = u.ocol + wc * 32 + 8 * fq;
#pragma unroll
            for (int ai = 0; ai < 2; ++ai)
#pragma unroll
                for (int m = 0; m < 4; ++m) { bf16_t* rowp = O + (size_t)(row0 + ai * HALF + m * 16) * ld + col0;
#pragma unroll
                    for (int bj = 0; bj < 2; ++bj) { const f32x4 v0 = acc[ai][bj][m][0] * scale, v1 = acc[ai][bj][m][1] * scale;
                        u32x4 w; w.x = cvt_pk_bf16(v0[0], v0[1]); w.y = cvt_pk_bf16(v0[2], v0[3]); w.z = cvt_pk_bf16(v1[0], v1[1]); w.w = cvt_pk_bf16(v1[2], v1[3]);
                        *(u32x4*)(rowp + bj * HALF) = w; } }
        } else {
            float* sl = slabs + (size_t)u.slab * 65536 + (size_t)(wr * 64 + fr) * 256 + wc * 32 + 8 * fq;
#pragma unroll
            for (int ai = 0; ai < 2; ++ai)
#pragma unroll
                for (int m = 0; m < 4; ++m)
#pragma unroll
                    for (int bj = 0; bj < 2; ++bj) { float* p = sl + (size_t)(ai * HALF + m * 16) * 256 + bj * HALF; *(f32x4*)p = acc[ai][bj][m][0] * scale; *(f32x4*)(p + 4) = acc[ai][bj][m][1] * scale; }
            if ((u.slab % S) == 0 && wr == 0 && wc == 0 && fr == 0 && fq == 0) flags[(u.orow >> 8) * nN + (u.ocol >> 8)] = (unsigned)u.slab + 1u;
        }
    }
};
typedef int v8i __attribute__((ext_vector_type(8)));
typedef int v8i_a16 __attribute__((ext_vector_type(8), aligned(16)));
__device__ __forceinline__ float quad_xor1(float v) { return __builtin_bit_cast(float, __builtin_amdgcn_mov_dpp(__builtin_bit_cast(int, v), 0xB1, 0xF, 0xF, true)); }
__device__ __forceinline__ float quad_xor2(float v) { return __builtin_bit_cast(float, __builtin_amdgcn_mov_dpp(__builtin_bit_cast(int, v), 0x4E, 0xF, 0xF, true)); }
__device__ __forceinline__ float quad_xor3(float v) { return __builtin_bit_cast(float, __builtin_amdgcn_mov_dpp(__builtin_bit_cast(int, v), 0x1B, 0xF, 0xF, true)); }
__device__ __forceinline__ unsigned pk4_fp8(float a, float b, float c, float d) { int w = __builtin_amdgcn_cvt_pk_fp8_f32(a, b, 0, false); w = __builtin_amdgcn_cvt_pk_fp8_f32(c, d, w, true); return (unsigned)w; }
__device__ __forceinline__ float silu_mul(float a, float b) { return a * __builtin_amdgcn_rcpf(1.0f + __builtin_amdgcn_exp2f(-1.4426950408889634f * a)) * b; }
struct EpiSwiGLU {
    static constexpr bool PERM = true;
    bf16_t* O; int ldc;
    __device__ __forceinline__ void operator()(const f32x4 (&acc)[2][2][4][2], const Unit& u, int wr, int wc, int fr, int fq) const {
        const int row0 = u.orow + wr * 64 + fr, col0 = (u.ocol >> 1) + wc * 32 + 8 * fq;
#pragma unroll
        for (int ai = 0; ai < 2; ++ai)
#pragma unroll
            for (int m = 0; m < 4; ++m) { bf16_t* rowp = O + (size_t)(row0 + ai * HALF + m * 16) * ldc + col0;
                const f32x4 g0 = acc[ai][0][m][0], g1 = acc[ai][0][m][1], u0 = acc[ai][1][m][0], u1 = acc[ai][1][m][1];
                u32x4 w; w.x = cvt_pk_bf16(silu_mul(g0[0], u0[0]), silu_mul(g0[1], u0[1])); w.y = cvt_pk_bf16(silu_mul(g0[2], u0[2]), silu_mul(g0[3], u0[3]));
                w.z = cvt_pk_bf16(silu_mul(g1[0], u1[0]), silu_mul(g1[1], u1[1])); w.w = cvt_pk_bf16(silu_mul(g1[2], u1[2]), silu_mul(g1[3], u1[3]));
                *(u32x4*)rowp = w; }
    }
};

struct Epi8 {
    static constexpr bool PERM = true;
    unsigned char* O; int ld; float scale;
    __device__ __forceinline__ void operator()(const f32x4 (&acc)[2][2][4][2], const Unit& u, int wr, int wc, int fr, int fq) const {
        const int row0 = u.orow + wr * 64 + fr, col0 = u.ocol + wc * 32 + 8 * fq;
#pragma unroll
        for (int ai = 0; ai < 2; ++ai)
#pragma unroll
            for (int m = 0; m < 4; ++m) { unsigned char* rowp = O + (size_t)(row0 + ai * HALF + m * 16) * ld + col0;
#pragma unroll
                for (int bj = 0; bj < 2; ++bj) { const f32x4 v0 = acc[ai][bj][m][0] * scale, v1 = acc[ai][bj][m][1] * scale;
                    u32x2 w; w.x = pk4_fp8(v0[0], v0[1], v0[2], v0[3]); w.y = pk4_fp8(v1[0], v1[1], v1[2], v1[3]); *(u32x2*)(rowp + bj * HALF) = w; } }
    }
};
struct EpiSwiGLU8 {
    static constexpr bool PERM = true;
    unsigned char* O; int ldc;
    __device__ __forceinline__ void operator()(const f32x4 (&acc)[2][2][4][2], const Unit& u, int wr, int wc, int fr, int fq) const {
        const int row0 = u.orow + wr * 64 + fr, col0 = (u.ocol >> 1) + wc * 32 + 8 * fq; constexpr float si = 1.0f / 64.0f;
#pragma unroll
        for (int ai = 0; ai < 2; ++ai)
#pragma unroll
            for (int m = 0; m < 4; ++m) { unsigned char* rowp = O + (size_t)(row0 + ai * HALF + m * 16) * ldc + col0;
                const f32x4 g0 = acc[ai][0][m][0] * si, g1 = acc[ai][0][m][1] * si, u0 = acc[ai][1][m][0] * (si * 8.0f), u1 = acc[ai][1][m][1] * (si * 8.0f);
                u32x2 w; w.x = pk4_fp8(silu_mul(g0[0], u0[0]), silu_mul(g0[1], u0[1]), silu_mul(g0[2], u0[2]), silu_mul(g0[3], u0[3]));
                w.y = pk4_fp8(silu_mul(g1[0], u1[0]), silu_mul(g1[1], u1[1]), silu_mul(g1[2], u1[2]), silu_mul(g1[3], u1[3]));
                *(u32x2*)rowp = w; }
    }
};
template <class Epi, class Sched, bool F8 = false>
__device__ __forceinline__ void gemm_phase(LAS unsigned char* lds, const Gemm g, const Sched& S, const Epi& E, const int tid) {
    const int wid = __builtin_amdgcn_readfirstlane(tid >> 6), lane = tid & 63, wr = wid >> 2, wc = wid & 3, fr = lane & 15, fq = lane >> 4;
    const int K = g.K, nt = K / BK;
    unsigned voffA[2], voffB[2];
#pragma unroll
    for (int i = 0; i < 2; ++i) { int R, C; stage_rc(tid * 16 + i * 8192, R, C); const int Rb = Epi::PERM ? ((R & ~31) + perm32(R & 31)) : R;
        voffA[i] = (unsigned)(R * g.lda + C) * 2u; voffB[i] = (unsigned)(Rb * g.ldb + C) * 2u; }
    const size_t kstep = (size_t)(BK * 2);
    const size_t hstepA = (size_t)HALF * g.lda * 2, hstepB = (size_t)HALF * g.ldb * 2;
    const unsigned ldsw = (unsigned)wid * 1024u;
    const int aoff = F8 ? lds_byte(wr * 64 + fr, fq * 16) : lds_byte(wr * 64 + fr, fq * 8), boff = F8 ? lds_byte(wc * 32 + fr, fq * 16) : lds_byte(wc * 32 + fr, fq * 8);
#define PG8_SA(b, h) (((b) * 2 + (h)) * HTB)
#define PG8_SB(b, h) ((4 + (b) * 2 + (h)) * HTB)
#define PG8_STAGE(bufoff, gbase, voff) do { _Pragma("unroll") for (int _i = 0; _i < 2; ++_i) \
        __builtin_amdgcn_global_load_lds((const unsigned*)((const char*)(gbase) + (voff)[_i]), (LAS unsigned*)(lds + (bufoff) + ldsw + _i * 8192), 16, 0, 0); } while (0)
#define PG8_LDA(dst, b, h) do { _Pragma("unroll") for (int m = 0; m < 4; ++m) { if constexpr (F8) { dst##8[m] = *(const LAS v8i_a16*)(lds + PG8_SA(b, h) + aoff + m * 2048); } \
        else { _Pragma("unroll") for (int k = 0; k < 2; ++k) dst[m][k] = *(const LAS bf16x8*)(lds + PG8_SA(b, h) + aoff + m * 2048 + k * 1024); } } } while (0)
#define PG8_LDB(dst, b, h) do { _Pragma("unroll") for (int n = 0; n < 2; ++n) { if constexpr (F8) { dst##8[n] = *(const LAS v8i_a16*)(lds + PG8_SB(b, h) + boff + n * 2048); } \
        else { _Pragma("unroll") for (int k = 0; k < 2; ++k) dst[n][k] = *(const LAS bf16x8*)(lds + PG8_SB(b, h) + boff + n * 2048 + k * 1024); } } } while (0)
#define PG8_MMA(ai, bj, At, Bt) do { __builtin_amdgcn_s_setprio(1); _Pragma("unroll") for (int m = 0; m < 4; ++m) _Pragma("unroll") for (int n = 0; n < 2; ++n) { if constexpr (F8) { \
            acc[ai][bj][m][n] = __builtin_amdgcn_mfma_scale_f32_16x16x128_f8f6f4(Bt##8[n], At##8[m], acc[ai][bj][m][n], 0, 0, 0, 0x7F7F7F7F, 0, 0x7F7F7F7F); \
        } else { _Pragma("unroll") for (int k = 0; k < 2; ++k) acc[ai][bj][m][n] = __builtin_amdgcn_mfma_f32_16x16x32_bf16(Bt[n][k], At[m][k], acc[ai][bj][m][n], 0, 0, 0); } } __builtin_amdgcn_s_setprio(0); } while (0)
#define PG8_WAIT_V(n) asm volatile("s_waitcnt vmcnt(" #n ")" ::: "memory")
#define PG8_WAIT_L(n) asm volatile("s_waitcnt lgkmcnt(" #n ")" ::: "memory")
#define PG8_BAR __builtin_amdgcn_s_barrier()
    Unit cur, nxt; int ui = 0;
    if (!S.next(0, cur)) return;
    f32x4 acc[2][2][4][2];
#pragma unroll
    for (int a = 0; a < 2; ++a)
#pragma unroll
        for (int b = 0; b < 2; ++b)
#pragma unroll
            for (int m = 0; m < 4; ++m)
#pragma unroll
                for (int n = 0; n < 2; ++n) acc[a][b][m][n] = (f32x4){0.f, 0.f, 0.f, 0.f};
    bf16x8 At[4][2], B0[2][2], B1[2][2]; v8i At8[4], B08[2], B18[2];
    const char* cA = (const char*)g.A + ((size_t)cur.arow * g.lda + cur.akoff) * 2; const char* cB = (const char*)g.Bt + ((size_t)cur.brow * g.ldb + (Sched::KSPLIT ? cur.akoff : 0)) * 2;
    PG8_STAGE(PG8_SB(0, 0), cB, voffB); PG8_STAGE(PG8_SB(0, 1), cB + hstepB, voffB); PG8_STAGE(PG8_SA(0, 0), cA, voffA); PG8_STAGE(PG8_SA(0, 1), cA + hstepA, voffA);
    if (wr == 1) PG8_BAR;
    PG8_WAIT_V(2); PG8_BAR;
    PG8_STAGE(PG8_SB(1, 0), cB + kstep, voffB); PG8_STAGE(PG8_SA(1, 0), cA + kstep, voffA); PG8_STAGE(PG8_SB(1, 1), cB + hstepB + kstep, voffB);
    PG8_WAIT_V(6); PG8_BAR;
    for (;;) {
        const bool has_next = S.next(ui + 1, nxt);
        const char* nA = has_next ? (const char*)g.A + ((size_t)nxt.arow * g.lda + nxt.akoff) * 2 : cA; const char* nB = has_next ? (const char*)g.Bt + ((size_t)nxt.brow * g.ldb + (Sched::KSPLIT ? nxt.akoff : 0)) * 2 : cB;
        const int ntc = (Sched::KSPLIT && cur.nt) ? cur.nt : nt;
        if constexpr (F8) {
#pragma unroll 1
            for (int t = 0; t < ntc; ++t) {
                const int b = t & 1; LAS unsigned char* lb = lds + b * (2 * HTB); LAS unsigned char* lo = lds + (b ^ 1) * (2 * HTB);
                const unsigned lbv = (unsigned)(uintptr_t)lb;
#define PG8_LDS32(dst, addr, imm) do { u32x4 lo_, hi_; asm volatile("ds_read_b128 %0, %2 offset:%3\n\tds_read_b128 %1, %2 offset:%4" : "=&v"(lo_), "=&v"(hi_) : "v"(addr), "i"(imm), "i"((imm) + 16) : "memory"); \
        dst = __builtin_bit_cast(v8i, __builtin_shufflevector(lo_, hi_, 0, 1, 2, 3, 4, 5, 6, 7)); } while (0)
                const char* s1 = (t + 1 < ntc) ? cA + (size_t)(t + 1) * kstep : nA + (size_t)(t + 1 - ntc) * kstep;
                const char* a2 = (t + 2 < ntc) ? cA + (size_t)(t + 2) * kstep : nA + (size_t)(t + 2 - ntc) * kstep;
                const char* b2 = (t + 2 < ntc) ? cB + (size_t)(t + 2) * kstep : nB + (size_t)(t + 2 - ntc) * kstep;
#define PG8_STAGE8(ldsdst, gbase, voff) do { _Pragma("unroll") for (int _i = 0; _i < 2; ++_i) \
        __builtin_amdgcn_global_load_lds((const unsigned*)((const char*)(gbase) + (voff)[_i]), (LAS unsigned*)((ldsdst) + ldsw + _i * 8192), 16, 0, 0); } while (0)
#pragma unroll
                for (int n = 0; n < 2; ++n) { PG8_LDS32(B08[n], lbv + (unsigned)(4 * HTB) + boff, n * 2048); PG8_LDS32(B18[n], lbv + (unsigned)(4 * HTB) + boff, HTB + n * 2048); }
                SBAR();
#pragma unroll
                for (int m = 0; m < 4; ++m) PG8_LDS32(At8[m], lbv + aoff, m * 2048);
                PG8_STAGE8(lo + HTB, s1 + hstepA, voffA);
                PG8_WAIT_V(8); PG8_WAIT_L(0); PG8_BAR; PG8_MMA(0, 0, At, B0); PG8_MMA(0, 1, At, B1); PG8_BAR; SBAR();
#pragma unroll
                for (int m = 0; m < 4; ++m) PG8_LDS32(At8[m], lbv + aoff, HTB + m * 2048);
                PG8_STAGE8(lb + 4 * HTB, b2, voffB); PG8_STAGE8(lb + 5 * HTB, b2 + hstepB, voffB); PG8_STAGE8(lb, a2, voffA);
                PG8_WAIT_V(8); PG8_WAIT_L(0); PG8_BAR; PG8_MMA(1, 0, At, B0); PG8_MMA(1, 1, At, B1); PG8_BAR; SBAR();
#undef PG8_STAGE8
#undef PG8_LDS32
            }
        } else
        for (int t = 0; t < ntc; t += 2) {
            const bool last = (t == ntc - 2);
            const char* a1 = cA + (size_t)(t + 1) * kstep;
            const char* a2 = last ? nA : cA + (size_t)(t + 2) * kstep; const char* b2 = last ? nB : cB + (size_t)(t + 2) * kstep;
            const char* a3 = a2 + kstep; const char* b3 = b2 + kstep;
            PG8_LDB(B0, 0, 0); PG8_LDB(B1, 0, 1); SBAR(); PG8_LDA(At, 0, 0); PG8_STAGE(PG8_SA(1, 1), a1 + hstepA, voffA);
            PG8_WAIT_V(8); PG8_WAIT_L(0); PG8_BAR; PG8_MMA(0, 0, At, B0); PG8_MMA(0, 1, At, B1); PG8_BAR; SBAR();
            PG8_LDA(At, 0, 1); PG8_STAGE(PG8_SB(0, 0), b2, voffB); PG8_STAGE(PG8_SB(0, 1), b2 + hstepB, voffB); PG8_STAGE(PG8_SA(0, 0), a2, voffA);
            PG8_WAIT_V(8); PG8_WAIT_L(0); PG8_BAR; PG8_MMA(1, 0, At, B0); PG8_MMA(1, 1, At, B1); PG8_BAR; SBAR();
            PG8_LDB(B0, 1, 0); PG8_LDB(B1, 1, 1); SBAR(); PG8_LDA(At, 1, 0); PG8_STAGE(PG8_SA(0, 1), a2 + hstepA, voffA);
            PG8_WAIT_V(8); PG8_WAIT_L(0); PG8_BAR; PG8_MMA(0, 0, At, B0); PG8_MMA(0, 1, At, B1); PG8_BAR; SBAR();
            PG8_LDA(At, 1, 1); PG8_STAGE(PG8_SB(1, 0), b3, voffB); PG8_STAGE(PG8_SB(1, 1), b3 + hstepB, voffB); PG8_STAGE(PG8_SA(1, 0), a3, voffA);
            PG8_WAIT_V(8); PG8_WAIT_L(0); PG8_BAR; PG8_MMA(1, 0, At, B0); PG8_MMA(1, 1, At, B1); PG8_BAR; SBAR();
        }
        if (wr == 0) PG8_BAR;
        { int t2 = tid; asm volatile("" : "+v"(t2));
          const int w2 = __builtin_amdgcn_readfirstlane(t2 >> 6), l2 = t2 & 63; E(acc, cur, w2 >> 2, w2 & 3, l2 & 15, l2 >> 4); }
        if (!has_next) break;
#pragma unroll
        for (int a = 0; a < 2; ++a)
#pragma unroll
            for (int b = 0; b < 2; ++b)
#pragma unroll
                for (int m = 0; m < 4; ++m)
#pragma unroll
                    for (int n = 0; n < 2; ++n) acc[a][b][m][n] = (f32x4){0.f, 0.f, 0.f, 0.f};
        cur = nxt; cA = nA; cB = nB; ++ui;
        if (wr == 1) PG8_BAR;
    }
    PG8_WAIT_V(0);
    PG8_BAR;
#undef PG8_SA
#undef PG8_SB
#undef PG8_STAGE
#undef PG8_LDA
#undef PG8_LDB
#undef PG8_MMA
#undef PG8_WAIT_V
#undef PG8_WAIT_L
#undef PG8_BAR
}
}
namespace att {
constexpr int D = 128, NW = 8, QBLK = 32, KVBLK = 64, QB = NW * QBLK;
constexpr int SHM_V = KVBLK * D * 2, SHM_K = KVBLK * D * 2;
constexpr int OFF_V = 0, OFF_K = 2 * SHM_V, OFF_WS = OFF_K + 2 * SHM_K, OFF_NCL = OFF_WS + NW * 64 * 4, OFF_LUT = OFF_NCL + (8192 + 256) * 4, OFF_KM = OFF_LUT + 1024, OFF_MISC = OFF_KM + 32 * 128 * 4, LDS_END = OFF_MISC + 256;
constexpr float SCALE = 0.08838834764831845f, LOG2E = 1.4426950408889634f, C2 = SCALE * LOG2E;
constexpr float THR2 = 8.f * LOG2E;
#define KSWZ(row, colB) ((row) * 256 + ((colB) ^ (((row) & 7) << 4)))
__device__ __forceinline__ int v_st(int k, int c) { const int kk = (k & ~0xC) | ((k & 4) << 1) | ((k & 8) >> 1); return ((kk >> 3) * 4 + (c >> 5)) * 512 + ((kk & 7) * 32 + (c & 31)) * 2; }
__device__ __forceinline__ int v_rd_base(int lane) { return ((lane & 3) << 3) | (((lane >> 2) & 3) << 6) | (((lane >> 4) & 1) << 5) | (((lane >> 5) & 1) << 8); }
constexpr int v_rd_off(int d0, int ks, int half) { return d0 * 512 + ks * 4096 + half * 2048; }
__device__ __forceinline__ int crow(int r, int hi) { return (r & 3) + 8 * (r >> 2) + 4 * hi; }
__device__ __forceinline__ bf16x8 load8(const bf16_t* p) { return *reinterpret_cast<const bf16x8*>(p); }

__device__ __forceinline__ void partialSM(f32x16& p0, f32x16& p1, float& m_reg, float& mn, float& alpha) {
    float pmax = p0[0];
#pragma unroll
    for (int r = 1; r < 16; ++r) pmax = fmaxf(pmax, p0[r]);
#pragma unroll
    for (int r = 0; r < 16; ++r) pmax = fmaxf(pmax, p1[r]);
    { auto rr = __builtin_amdgcn_permlane32_swap(__float_as_uint(pmax), __float_as_uint(pmax), false, false);
      pmax = fmaxf(__uint_as_float(rr[0]), __uint_as_float(rr[1])); }
    if (__builtin_expect(__all((pmax - m_reg) <= THR2), 1)) { mn = m_reg; alpha = 1.f; }
    else { mn = fmaxf(m_reg, pmax); alpha = __builtin_amdgcn_exp2f(m_reg - mn); m_reg = mn; }
#pragma unroll
    for (int r = 0; r < 16; ++r) p0[r] = p0[r] - mn;
#pragma unroll
    for (int r = 0; r < 16; ++r) p1[r] = p1[r] - mn;
#pragma unroll
    for (int r = 0; r < 16; ++r) p0[r] = __builtin_amdgcn_exp2f(p0[r]);
}
__device__ __forceinline__ void finishSM(f32x16& p0, f32x16& p1, float alpha, float& l_reg, bf16x8& pa0, bf16x8& pa1, bf16x8& pa2, bf16x8& pa3) {
#pragma unroll
    for (int r = 0; r < 16; ++r) p1[r] = __builtin_amdgcn_exp2f(p1[r]);
    float ps = 0;
#pragma unroll
    for (int r = 0; r < 16; ++r) ps += p0[r];
#pragma unroll
    for (int r = 0; r < 16; ++r) ps += p1[r];
    { auto rr = __builtin_amdgcn_permlane32_swap(__float_as_uint(ps), __float_as_uint(ps), false, false);
      ps = __uint_as_float(rr[0]) + __uint_as_float(rr[1]); }
    l_reg = l_reg * alpha + ps;
#define PK4(P, B_, OUT) do { unsigned a0 = cvt_pk_bf16(P[B_+0], P[B_+1]), a1 = cvt_pk_bf16(P[B_+2], P[B_+3]);                          \
        unsigned b0 = cvt_pk_bf16(P[B_+4], P[B_+5]), b1 = cvt_pk_bf16(P[B_+6], P[B_+7]);                                             \
        auto r0 = __builtin_amdgcn_permlane32_swap(a0, b0, false, false); auto r1 = __builtin_amdgcn_permlane32_swap(a1, b1, false, false); \
        u32x4 w = {r0[0], r1[0], r0[1], r1[1]}; OUT = *reinterpret_cast<bf16x8*>(&w); } while (0)
    PK4(p0, 0, pa0); PK4(p0, 8, pa1); PK4(p1, 0, pa2); PK4(p1, 8, pa3);
#undef PK4
}
template <int KB>
__device__ __forceinline__ void qkt(f32x16& p0, f32x16& p1, const char* K_lds, int r32, int hi, const bf16x8* qr) {
    p0 = f32x16{}; p1 = f32x16{};
    const char* kb[4];
#pragma unroll
    for (int dd = 0; dd < 4; ++dd) kb[dd] = K_lds + KB * SHM_K + KSWZ(r32, (dd * 16 + hi * 8) * 2);
#pragma unroll
    for (int d0 = 0; d0 < 8; ++d0) { const char* a = kb[d0 & 3] + (d0 >> 2) * 128;
        bf16x8 b0 = *reinterpret_cast<const bf16x8*>(a);
        bf16x8 b1 = *reinterpret_cast<const bf16x8*>(a + 32 * 256);
        p0 = __builtin_amdgcn_mfma_f32_32x32x16_bf16(b0, qr[d0], p0, 0, 0, 0);
        p1 = __builtin_amdgcn_mfma_f32_32x32x16_bf16(b1, qr[d0], p1, 0, 0, 0); }
}
template <int VB>
__device__ __forceinline__ void pv_tile(f32x16* o, int vb0, bf16x8 pa0, bf16x8 pa1, bf16x8 pa2, bf16x8 pa3) {
#define TRRD(dst, off) asm volatile("ds_read_b64_tr_b16 %0, %1 offset:%2" : "=&v"(dst) : "v"(vb0), "i"(off) : "memory")
#define PV_D0(d0) do { s16x4 l0, l1, l2, l3, h0, h1, h2, h3; constexpr int b_ = VB * SHM_V + v_rd_off(d0, 0, 0); \
        TRRD(l0, b_); TRRD(h0, b_ + 2048); TRRD(l1, b_ + 4096); TRRD(h1, b_ + 6144); TRRD(l2, b_ + 8192); TRRD(h2, b_ + 10240); TRRD(l3, b_ + 12288); TRRD(h3, b_ + 14336); \
        asm volatile("s_waitcnt lgkmcnt(0)" ::: "memory"); SBAR(); \
        o[d0] = __builtin_amdgcn_mfma_f32_32x32x16_bf16(pa0, (bf16x8){l0[0], l0[1], l0[2], l0[3], h0[0], h0[1], h0[2], h0[3]}, o[d0], 0, 0, 0);   \
        o[d0] = __builtin_amdgcn_mfma_f32_32x32x16_bf16(pa1, (bf16x8){l1[0], l1[1], l1[2], l1[3], h1[0], h1[1], h1[2], h1[3]}, o[d0], 0, 0, 0);   \
        o[d0] = __builtin_amdgcn_mfma_f32_32x32x16_bf16(pa2, (bf16x8){l2[0], l2[1], l2[2], l2[3], h2[0], h2[1], h2[2], h2[3]}, o[d0], 0, 0, 0);   \
        o[d0] = __builtin_amdgcn_mfma_f32_32x32x16_bf16(pa3, (bf16x8){l3[0], l3[1], l3[2], l3[3], h3[0], h3[1], h3[2], h3[3]}, o[d0], 0, 0, 0); } while (0)
    PV_D0(0); PV_D0(1); PV_D0(2); PV_D0(3);
#undef PV_D0
#undef TRRD
}

template <int VAR>
__device__ __forceinline__ void prep(f32x16& p0, f32x16& p1, int kb, int pos, int qlo, int hi, const LAS float* ncl, int nclbase, const LAS float* lut, unsigned selmask, float farL) {
    const float NEG = -__builtin_inff();
    if constexpr (VAR == 0) {
        if (kb + KVBLK - 1 > qlo) {
            const int dq = pos - kb - 4 * hi;
#pragma unroll
            for (int r = 0; r < 16; ++r) { const int c = (r & 3) + 8 * (r >> 2);
                if (dq - c < 0) p0[r] = NEG;
                if (dq - c - 32 < 0) p1[r] = NEG; }
        }
        const LAS float* nb = ncl + (kb - nclbase) + 4 * hi;
#pragma unroll
        for (int g = 0; g < 4; ++g) { const f32x4 b0 = *(const LAS f32x4*)(nb + 8 * g), b1 = *(const LAS f32x4*)(nb + 32 + 8 * g);
#pragma unroll
            for (int j = 0; j < 4; ++j) { p0[4 * g + j] = fmaf(p0[4 * g + j], C2, b0[j]); p1[4 * g + j] = fmaf(p1[4 * g + j], C2, b1[j]); }
            asm volatile("" ::: "memory"); }
    } else {
        const bool selb = (selmask >> (kb >> 8)) & 1u;
        if (kb + KVBLK - 1 + 128 <= qlo) {
            const float add = selb ? farL : NEG;
#pragma unroll
            for (int r = 0; r < 16; ++r) { p0[r] = fmaf(p0[r], C2, add); p1[r] = fmaf(p1[r], C2, add); }
        } else {
            const int dq = pos - kb - 4 * hi;
#pragma unroll
            for (int r = 0; r < 16; ++r) { const int c = (r & 3) + 8 * (r >> 2);
                const int d0 = dq - c, d1 = dq - c - 32;
                const float b0 = lut[d0 < 0 ? 0 : (d0 > 128 ? 128 : d0)], b1 = lut[d1 < 0 ? 0 : (d1 > 128 ? 128 : d1)];
                const float t0 = fmaf(p0[r], C2, b0), t1 = fmaf(p1[r], C2, b1);
                p0[r] = (d0 < 0 || !selb) ? NEG : t0; p1[r] = (d1 < 0 || !selb) ? NEG : t1;
                if ((r & 3) == 3) asm volatile("" ::: "memory"); }
        }
    }
}

template <int VAR, int OP>
__device__ __forceinline__ void attn_block(const bf16_t* Q, const bf16_t* Kh, const bf16_t* Vh, unsigned char* O, int P0, int j_lo, int j_hi, char* lds,
                                           const LAS float* ncl, int nclbase, const LAS float* lut, unsigned selmask, float farL, const bf16x8 (&qr)[8], const int tid) {
    const int wid = __builtin_amdgcn_readfirstlane(tid >> 6), lane = tid & 63, r32 = lane & 31, hi = lane >> 5;
    const int NT = j_hi - j_lo;
    const int qlo = P0 + wid * QBLK, pos = qlo + r32;
    char* V_lds = lds + OFF_V; char* K_lds = lds + OFF_K;
    float* ws = (float*)(lds + OFF_WS) + wid * 64; float* li_l = ws, * al_l = ws + 32;
    float m_reg = -1e30f, l_reg = 0; f32x16 o[4] = {};
    const int sr = tid >> 4, sc = (tid & 15) * 8, vst0 = v_st(sr, sc), vst1 = v_st(32 + sr, sc), kws = KSWZ(sr, sc * 2);
    const int vb0 = (int)(uintptr_t)V_lds + v_rd_base(lane);
    bf16x8 st_v0, st_v1, st_k0, st_k1;
#define ROW(p, k0, rr) ((p) + (size_t)((k0) + (rr)) * D + sc)
#define SLOAD_H(k0) do { st_v0 = load8(ROW(Vh, k0, sr)); st_v1 = load8(ROW(Vh, k0, 32 + sr)); st_k0 = load8(ROW(Kh, k0, sr)); st_k1 = load8(ROW(Kh, k0, 32 + sr)); } while (0)
#define SWRITE_HK(bf) do { *(bf16x8*)(K_lds + (bf) * SHM_K + kws) = st_k0; *(bf16x8*)(K_lds + (bf) * SHM_K + kws + 32 * 256) = st_k1; } while (0)
#define SWRITE_HV(bf) do { *(bf16x8*)(V_lds + (bf) * SHM_V + vst0) = st_v0; *(bf16x8*)(V_lds + (bf) * SHM_V + vst1) = st_v1; } while (0)
#define SWRITE_H(bf) do { SWRITE_HV(bf); SWRITE_HK(bf); } while (0)
#define RESC(a) do { if (__any((a) < 1.f)) { if (hi == 0) al_l[r32] = (a); asm volatile("s_waitcnt lgkmcnt(0)" ::: "memory");              \
                     for (int d_ = 0; d_ < 4; ++d_) for (int r = 0; r < 16; ++r) o[d_][r] *= al_l[crow(r, hi)]; } } while (0)
#define KBASE(t) ((j_lo + (t)) * KVBLK)
#define PREP(P0_, P1_, t) prep<VAR>(P0_, P1_, KBASE(t), pos, qlo, hi, ncl, nclbase, lut, selmask, farL)
    f32x16 pA0, pA1, pB0, pB1; float mnA, mnB, alA, alB; bf16x8 pa0, pa1, pa2, pa3;
    SLOAD_H(KBASE(0)); VM_WAIT(); SWRITE_H(0); SBAR();
    if (NT > 1) SLOAD_H(KBASE(1));
    __syncthreads();
    SBAR(); qkt<0>(pA0, pA1, K_lds, r32, hi, qr);
    PREP(pA0, pA1, 0); partialSM(pA0, pA1, m_reg, mnA, alA);
    if (NT > 1) { VM_WAIT(); SWRITE_H(1); }
    __syncthreads();
#define HALF_STEP(PX0, PX1, mnX, alX, PY0, PY1, alY, t, KB, VB, SB) do {                                                      \
        SBAR(); qkt<KB>(PX0, PX1, K_lds, r32, hi, qr);                                                                        \
        finishSM(PY0, PY1, alY, l_reg, pa0, pa1, pa2, pa3); SBAR();                                                           \
        if ((t) + 1 < NT) { SLOAD_H(KBASE((t) + 1)); SBAR(); }                                                                \
        pv_tile<VB>(o, vb0, pa0, pa1, pa2, pa3); PREP(PX0, PX1, (t)); partialSM(PX0, PX1, m_reg, mnX, alX);                   \
        __syncthreads();                                                                                                      \
        if ((t) + 1 < NT) { VM_WAIT(); SWRITE_H(SB); }                                                                        \
        RESC(alX); __syncthreads(); } while (0)
    for (int t = 1; t + 1 < NT; t += 2) {
        HALF_STEP(pB0, pB1, mnB, alB, pA0, pA1, alA, t, 1, 0, 0);
        HALF_STEP(pA0, pA1, mnA, alA, pB0, pB1, alB, t + 1, 0, 1, 1);
    }
    const bool even = (NT & 1) == 0;
    if (even) { SBAR(); qkt<1>(pB0, pB1, K_lds, r32, hi, qr); SBAR(); }
    finishSM(pA0, pA1, alA, l_reg, pa0, pa1, pa2, pa3); SBAR();
    pv_tile<0>(o, vb0, pa0, pa1, pa2, pa3);
    if (even) { PREP(pB0, pB1, NT - 1); partialSM(pB0, pB1, m_reg, mnB, alB); __syncthreads(); RESC(alB);
        finishSM(pB0, pB1, alB, l_reg, pa0, pa1, pa2, pa3); SBAR(); pv_tile<1>(o, vb0, pa0, pa1, pa2, pa3); }
    SBAR();
    if (hi == 0) li_l[r32] = l_reg; asm volatile("s_waitcnt lgkmcnt(0)" ::: "memory");
    float rli[16];
#pragma unroll
    for (int r = 0; r < 16; ++r) rli[r] = __builtin_amdgcn_rcpf(li_l[crow(r, hi)]);
    unsigned ob = (unsigned)((wid * QBLK + 4 * hi) * OP + r32);
    asm volatile("" : "+v"(ob));
    char* pb = (char*)O + ob;
#pragma unroll
    for (int r = 0; r < 16; ++r) { char* pr = pb + (size_t)((r & 3) + 8 * (r >> 2)) * OP;
#pragma unroll
        for (int d0 = 0; d0 < 4; ++d0) { const float v = o[d0][r] * (rli[r] * 16.0f);
            const float v1 = pg8::quad_xor1(v), v2 = pg8::quad_xor2(v), v3 = pg8::quad_xor3(v);
            if ((r32 & 3) == 0) *(unsigned*)(pr + d0 * 32) = pg8::pk4_fp8(v, v1, v2, v3); } }
    __syncthreads();
#undef ROW
#undef SLOAD_H
#undef SWRITE_HK
#undef SWRITE_HV
#undef SWRITE_H
#undef RESC
#undef KBASE
#undef PREP
#undef HALF_STEP
}
}
constexpr int NWAVES = 8, NTHREADS = 512;
constexpr int BATCH = 2, T = 8192, M = BATCH * T, DM = 2048;
constexpr int NQKV0 = 6144, WIN0_PITCH = 6152, FF0 = 5632, NIN1 = 1104, NIN1P = 1280, NQ1 = 9216, NEXP = 8, FFE = 7168;
constexpr int MAXROWS = 34816;
constexpr float ALPHA = 1.4142135623730951f;
constexpr float LN_EPS = 1e-5f, RMS_EPS = 1e-6f;
constexpr float LOG2E = 1.4426950408889634f;
constexpr size_t MiB = 1u << 20;
constexpr size_t WS_CTL = 0, CTL_ZERO_BYTES = 1 * MiB;
constexpr size_t WS_WIN0 = 2 * MiB, WS_WOUT0 = 26 * MiB, WS_WFF13 = 34 * MiB, WS_WFF2 = 78 * MiB, WS_WIN1 = 100 * MiB, WS_WQ1 = 105 * MiB, WS_WUV = 114 * MiB, WS_WOUT1 = 118 * MiB,
                 WS_WE13 = 126 * MiB, WS_WE2 = 574 * MiB, WS_XB = 798 * MiB, WS_SMALL = 862 * MiB, WS_BIG = 896 * MiB;
constexpr size_t SM_LOGF = WS_SMALL, SM_CL2 = SM_LOGF + (size_t)M * 8 * 4, SM_KMEAN = SM_CL2 + 16 * 8192 * 4, SM_QN = SM_KMEAN + 16 * 32 * 128 * 4, SM_KN = SM_QN + 16 * 32 * 4,
                 SM_WIDX = SM_KN + 16 * 32 * 4 + 3072, SM_KIDX = SM_WIDX + (size_t)M * 16 * 4, SM_RTE = SM_KIDX + (size_t)M * 64 * 2, SM_RTG = SM_RTE + (size_t)M * 2 * 4, SM_RTP = SM_RTG + (size_t)M * 2 * 4,
                 SM_ROW = SM_RTP + (size_t)M * 2 * 4, SM_SEL = SM_ROW + (size_t)M * 2 * 4, SM_STAT = SM_SEL + (size_t)M * 256 * 4, SM_END = SM_STAT + (size_t)M * 2 * 4;
static_assert(SM_END <= WS_BIG, "small region");
constexpr size_t B0_QKV = WS_BIG, B0_O = WS_BIG + 192 * MiB, B0_ACT = WS_BIG + 256 * MiB;
constexpr size_t B1_PROJ = WS_BIG, B1_CQN = WS_BIG + 80 * MiB, B1_CKVN = WS_BIG + 96 * MiB, B1_QIDX = WS_BIG + 112 * MiB, B1_QLAT = WS_BIG + 144 * MiB, B1_SC = WS_BIG + 400 * MiB, B1_OB = WS_BIG;
constexpr size_t SC_PER_BATCH = (size_t)16384 * (64 * 65 / 2);
static_assert(B1_SC + 2 * SC_PER_BATCH * 4 <= WS_BIG + 662 * MiB, "scores");
constexpr size_t B1_XG = WS_BIG, B1_H = WS_BIG + 136 * MiB, B1_Y = WS_BIG;
constexpr size_t B1_SLAB = WS_BIG + 614 * MiB;
constexpr size_t WS_NEED = WS_BIG + 680 * MiB;
constexpr int CW_BAR = 4096, CW_CNT = 8192, CW_QIDX = 12288, CW_QTOPK = 12352, CW_FLAG = 16384;
constexpr int LDS_BYTES = 147456, SCR_BYTES = 143360, MISC_OFF = SCR_BYTES;

struct Args { const float* in[28]; float* out; unsigned char* ws; int ph_lo, ph_hi; };
struct Ctx {
    LAS unsigned char* lds; unsigned char* ldsg; unsigned char* ws; float* out;
    int tid, lane, wave, G, bid;
};

__device__ __forceinline__ void transpose_item(const float* W, int ldw, int Nsrc, int Ndst, bf16_t* WT, int ldt, int koff, int mode, int row_off, int zero_koff, LAS float* scr, int item, int lane) {
    const int nblk = Ndst / 32, kb = item / nblk, nb = item % nblk, k0 = 64 * kb, n0 = 32 * nb;
    const int ncol = n0 + (lane & 31); const bool ok = ncol < Nsrc;
    float tv[32];
#pragma unroll
    for (int i = 0; i < 32; ++i) { const int kk = 2 * i + (lane >> 5); tv[i] = ok ? W[(size_t)(k0 + kk) * ldw + ncol] : 0.f; }
#pragma unroll
    for (int i = 0; i < 32; ++i) { const int kk = 2 * i + (lane >> 5); scr[kk * 33 + (lane & 31)] = tv[i]; }
    LDS_WAIT(); asm volatile("" ::: "memory");
    const int c = lane & 7;
#pragma unroll
    for (int j = 0; j < 4; ++j) { const int n = (lane >> 3) + 8 * j; const LAS float* s = scr + (8 * c) * 33 + n;
        u32x4 o; o.x = pk2(s[0 * 33], s[1 * 33]); o.y = pk2(s[2 * 33], s[3 * 33]); o.z = pk2(s[4 * 33], s[5 * 33]); o.w = pk2(s[6 * 33], s[7 * 33]);
        const int nn = n0 + n; const int drow = mode ? ((nn >> 7) * 256 + row_off + (nn & 127)) : (row_off + nn);
        *(GAS u32x4*)(WT + (size_t)drow * ldt + koff + k0 + 8 * c) = o;
        if (zero_koff >= 0) *(GAS u32x4*)(WT + (size_t)drow * ldt + zero_koff + k0 + 8 * c) = (u32x4){0u, 0u, 0u, 0u}; }
    LDS_WAIT(); asm volatile("" ::: "memory");
}

__device__ __forceinline__ void transpose_item8(const float* W, int ldw, int Ndst, unsigned char* WT, int ldt, int mode, int row_off, LAS float* scr, int item, int lane, int koff = 0, int zero_koff = -1) {
    const int nblk = Ndst / 32, kb = item / nblk, nb = item % nblk, k0 = 64 * kb, n0 = 32 * nb;
    const int ncol = n0 + (lane & 31);
    float tv[32];
#pragma unroll
    for (int i = 0; i < 32; ++i) { const int kk = 2 * i + (lane >> 5); tv[i] = W[(size_t)(k0 + kk) * ldw + ncol]; }
#pragma unroll
    for (int i = 0; i < 32; ++i) { const int kk = 2 * i + (lane >> 5); scr[kk * 33 + (lane & 31)] = tv[i] * 64.0f; }
    LDS_WAIT(); asm volatile("" ::: "memory");
    const int c = lane & 7;
#pragma unroll
    for (int j = 0; j < 4; ++j) { const int n = (lane >> 3) + 8 * j; const LAS float* s = scr + (8 * c) * 33 + n;
        u32x2 o; o.x = pg8::pk4_fp8(s[0 * 33], s[1 * 33], s[2 * 33], s[3 * 33]); o.y = pg8::pk4_fp8(s[4 * 33], s[5 * 33], s[6 * 33], s[7 * 33]);
        const int nn = n0 + n; const int drow = mode ? ((nn >> 7) * 256 + row_off + (nn & 127)) : (row_off + nn);
        *(GAS u32x2*)(WT + (size_t)drow * ldt + koff + k0 + 8 * c) = o;
        if (zero_koff >= 0) *(GAS u32x2*)(WT + (size_t)drow * ldt + zero_koff + k0 + 8 * c) = (u32x2){0u, 0u}; }
    LDS_WAIT(); asm volatile("" ::: "memory");
}
template <bool F8>
__device__ __forceinline__ void transpose_tile(const float* W, int ldw, int Nsrc, void* WTv, int ldt, int koff, int mode, int row_off, int zero_koff, int k0, int n0, LAS float* tile, int tid) {
    constexpr int KT = F8 ? 128 : 64, NI = KT / 8;
    const int wv = tid >> 6, ln = tid & 63;
    float v[NI][4];
#pragma unroll
    for (int i = 0; i < NI; ++i)
#pragma unroll
        for (int e = 0; e < 4; ++e) { const int col = ln + 64 * e; v[i][e] = (n0 + col) < Nsrc ? W[(size_t)(k0 + wv + 8 * i) * ldw + n0 + col] : 0.f; }
#pragma unroll
    for (int i = 0; i < NI; ++i)
#pragma unroll
        for (int e = 0; e < 4; ++e) tile[(wv + 8 * i) * 257 + ln + 64 * e] = v[i][e];
    __syncthreads();
    const int c = tid & 7;
#pragma unroll
    for (int j = 0; j < 4; ++j) { const int n = (tid >> 3) + 64 * j; const int nn = n0 + n; const int drow = mode ? ((nn >> 7) * 256 + row_off + (nn & 127)) : (row_off + nn);
        if constexpr (F8) { const LAS float* s = tile + (16 * c) * 257 + n; u32x4 o;
            o.x = pg8::pk4_fp8(s[0 * 257] * 64.f, s[1 * 257] * 64.f, s[2 * 257] * 64.f, s[3 * 257] * 64.f); o.y = pg8::pk4_fp8(s[4 * 257] * 64.f, s[5 * 257] * 64.f, s[6 * 257] * 64.f, s[7 * 257] * 64.f);
            o.z = pg8::pk4_fp8(s[8 * 257] * 64.f, s[9 * 257] * 64.f, s[10 * 257] * 64.f, s[11 * 257] * 64.f); o.w = pg8::pk4_fp8(s[12 * 257] * 64.f, s[13 * 257] * 64.f, s[14 * 257] * 64.f, s[15 * 257] * 64.f);
            *(GAS u32x4*)((unsigned char*)WTv + (size_t)drow * ldt + koff + k0 + 16 * c) = o; }
        else { const LAS float* s = tile + (8 * c) * 257 + n; u32x4 o;
            o.x = pk2(s[0 * 257], s[1 * 257]); o.y = pk2(s[2 * 257], s[3 * 257]); o.z = pk2(s[4 * 257], s[5 * 257]); o.w = pk2(s[6 * 257], s[7 * 257]);
            *(GAS u32x4*)((bf16_t*)WTv + (size_t)drow * ldt + koff + k0 + 8 * c) = o;
            if (zero_koff >= 0) *(GAS u32x4*)((bf16_t*)WTv + (size_t)drow * ldt + zero_koff + k0 + 8 * c) = (u32x4){0u, 0u, 0u, 0u}; } }
    __syncthreads();
}
struct ProIn { const float *x, *w_in0, *b_forget, *w_out0, *w1, *w3, *w2, *w_in1, *w_uq, *w_qidx, *w_uk, *w_uv, *w_out1, *e1, *e3, *e2; };
__device__ __forceinline__ void phase_prologue(const Ctx& F, const ProIn& I) {
    LAS float* scr = (LAS float*)(F.lds + F.wave * 8448);
    LAS float* wf = (LAS float*)(F.lds + 69632);
    const int gw = F.bid * NWAVES + F.wave, NGW = F.G * NWAVES;
    unsigned char* ws = F.ws;
    for (int i = F.tid; i < 8 * 2048; i += NTHREADS) { const int j = i & 7, k = i >> 3; wf[j * 2048 + k] = I.w_in0[(size_t)k * WIN0_PITCH + 6144 + j]; }
    __syncthreads();
    for (int m = gw; m < M; m += NGW) {
        const GAS f32x4* xr = (const GAS f32x4*)(I.x + (size_t)m * DM) + F.lane;
        f32x4 v[8];
#pragma unroll
        for (int j = 0; j < 8; ++j) v[j] = xr[64 * j];
        GAS u32x2* o8 = (GAS u32x2*)((bf16_t*)(ws + WS_XB) + (size_t)m * DM) + F.lane;
#pragma unroll
        for (int j = 0; j < 8; ++j) { u32x2 w; w.x = pk2(v[j][0], v[j][1]); w.y = pk2(v[j][2], v[j][3]); o8[64 * j] = w; }
        float z = 0.f;
#pragma unroll 1
        for (int h = 0; h < 8; ++h) { float s = 0.f;
#pragma unroll
            for (int j = 0; j < 8; ++j) { const f32x4 w = *(const LAS f32x4*)(wf + h * 2048 + 256 * j + 4 * F.lane); s += v[j][0] * w[0] + v[j][1] * w[1] + v[j][2] * w[2] + v[j][3] * w[3]; }
            s = wave_sum(s); z = (F.lane == h) ? s : z; }
        if (F.lane < 8) {
            z += I.b_forget[F.lane];
            const float lf = z >= 0.f ? -log1pf(expf(-z)) : z - log1pf(expf(z));
            ((float*)(ws + SM_LOGF))[(size_t)m * 8 + F.lane] = lf; }
    }
    __syncthreads();
    {
        LAS float* tile = (LAS float*)F.lds;
        unsigned char* const W_IN0 = ws + WS_WIN0; unsigned char* const W_OUT0 = ws + WS_WOUT0; unsigned char* const W_FF13 = ws + WS_WFF13; unsigned char* const W_FF2 = ws + WS_WFF2;
        unsigned char* const W_IN1 = ws + WS_WIN1; unsigned char* const W_Q1 = ws + WS_WQ1; unsigned char* const W_OUT1 = ws + WS_WOUT1;
        unsigned char* const W_E13 = ws + WS_WE13; unsigned char* const W_E2 = ws + WS_WE2;
        constexpr int T_IN0 = (2048 / 128) * (6144 / 128), T_SQ = (2048 / 128) * (2048 / 128), T_FF = (2048 / 128) * (FF0 / 128), T_FF2 = (FF0 / 128) * (2048 / 128), T_IN1 = (2048 / 128) * (NIN1P / 128),
                      T_QI = (512 / 128) * (1024 / 128), T_E = (2048 / 128) * (FFE / 128), T_E2 = (FFE / 128) * (2048 / 128);
        constexpr int TOT = 8 * (2 * T_E + T_E2) + 2 * T_FF + T_FF2 + T_IN0 + 2 * T_SQ + T_IN1 + T_QI;
#define TILE_DECODE(it_, Wp, ldw_, Nsrc_, Dp, ldt_, f8_, mode_, roff_, k0_, n0_) do { int r = (it_); \
            if (r < 8 * T_E) { const int e = r / T_E, rr = r % T_E, nb = FFE / 128; Wp = I.e1 + (size_t)e * 2048 * FFE; ldw_ = FFE; Nsrc_ = FFE; Dp = W_E13 + (size_t)e * 2 * FFE * 2048; ldt_ = 2048; f8_ = 1; mode_ = 1; roff_ = 0; k0_ = 128 * (rr / nb); n0_ = 128 * (rr % nb); break; } r -= 8 * T_E; \
            if (r < 8 * T_E) { const int e = r / T_E, rr = r % T_E, nb = FFE / 128; Wp = I.e3 + (size_t)e * 2048 * FFE; ldw_ = FFE; Nsrc_ = FFE; Dp = W_E13 + (size_t)e * 2 * FFE * 2048; ldt_ = 2048; f8_ = 1; mode_ = 1; roff_ = 128; k0_ = 128 * (rr / nb); n0_ = 128 * (rr % nb); break; } r -= 8 * T_E; \
            if (r < 8 * T_E2) { const int e = r / T_E2, rr = r % T_E2, nb = 2048 / 128; Wp = I.e2 + (size_t)e * FFE * 2048; ldw_ = 2048; Nsrc_ = 2048; Dp = W_E2 + (size_t)e * 2048 * FFE; ldt_ = FFE; f8_ = 1; mode_ = 0; roff_ = 0; k0_ = 128 * (rr / nb); n0_ = 128 * (rr % nb); break; } r -= 8 * T_E2; \
            if (r < T_FF) { const int nb = FF0 / 128; Wp = I.w1; ldw_ = FF0; Nsrc_ = FF0; Dp = W_FF13; ldt_ = 2048; f8_ = 1; mode_ = 1; roff_ = 0; k0_ = 128 * (r / nb); n0_ = 128 * (r % nb); break; } r -= T_FF; \
            if (r < T_FF) { const int nb = FF0 / 128; Wp = I.w3; ldw_ = FF0; Nsrc_ = FF0; Dp = W_FF13; ldt_ = 2048; f8_ = 1; mode_ = 1; roff_ = 128; k0_ = 128 * (r / nb); n0_ = 128 * (r % nb); break; } r -= T_FF; \
            if (r < T_FF2) { const int nb = 2048 / 128; Wp = I.w2; ldw_ = 2048; Nsrc_ = 2048; Dp = W_FF2; ldt_ = FF0; f8_ = 1; mode_ = 0; roff_ = 0; k0_ = 128 * (r / nb); n0_ = 128 * (r % nb); break; } r -= T_FF2; \
            if (r < T_IN0) { const int nb = 6144 / 128; Wp = I.w_in0; ldw_ = WIN0_PITCH; Nsrc_ = 6144; Dp = W_IN0; ldt_ = 2048; f8_ = 0; mode_ = 0; roff_ = 0; k0_ = 128 * (r / nb); n0_ = 128 * (r % nb); break; } r -= T_IN0; \
            if (r < T_SQ) { const int nb = 2048 / 128; Wp = I.w_out0; ldw_ = 2048; Nsrc_ = 2048; Dp = W_OUT0; ldt_ = 2048; f8_ = 1; mode_ = 0; roff_ = 0; k0_ = 128 * (r / nb); n0_ = 128 * (r % nb); break; } r -= T_SQ; \
            if (r < T_SQ) { const int nb = 2048 / 128; Wp = I.w_out1; ldw_ = 2048; Nsrc_ = 2048; Dp = W_OUT1; ldt_ = 2048; f8_ = 1; mode_ = 0; roff_ = 0; k0_ = 128 * (r / nb); n0_ = 128 * (r % nb); break; } r -= T_SQ; \
            if (r < T_IN1) { const int nb = NIN1P / 128; Wp = I.w_in1; ldw_ = NIN1; Nsrc_ = NIN1; Dp = W_IN1; ldt_ = 2048; f8_ = 0; mode_ = 0; roff_ = 0; k0_ = 128 * (r / nb); n0_ = 128 * (r % nb); break; } r -= T_IN1; \
            { const int nb = 1024 / 128; Wp = I.w_qidx; ldw_ = 1024; Nsrc_ = 1024; Dp = W_Q1; ldt_ = 512; f8_ = 0; mode_ = 0; roff_ = 8192; k0_ = 128 * (r / nb); n0_ = 128 * (r % nb); } } while (0)
        const int wv = F.wave, ln = F.lane, tid = F.tid;
        float v[16][2];
#define TILE_LOAD(it_) do { const float* Wp; unsigned char* Dp; int ldw_, Nsrc_, ldt_, f8_, mode_, roff_, k0_, n0_; TILE_DECODE(it_, Wp, ldw_, Nsrc_, Dp, ldt_, f8_, mode_, roff_, k0_, n0_); (void)Dp; (void)ldt_; (void)f8_; (void)mode_; (void)roff_; \
            _Pragma("unroll") for (int i = 0; i < 16; ++i) _Pragma("unroll") for (int e = 0; e < 2; ++e) { const int col = n0_ + ln + 64 * e; v[i][e] = col < Nsrc_ ? Wp[(size_t)(k0_ + wv + 8 * i) * ldw_ + col] : 0.f; } } while (0)
        int it = F.bid;
        if (it < TOT) {
            TILE_LOAD(it);
#pragma unroll
            for (int i = 0; i < 16; ++i) { tile[(wv + 8 * i) * 129 + ln] = v[i][0]; tile[(wv + 8 * i) * 129 + ln + 64] = v[i][1]; }
            __syncthreads();
            for (;;) {
                const int nx = it + F.G; const bool more = nx < TOT;
                if (more) TILE_LOAD(nx);
                { const float* Wp; unsigned char* Dp; int ldw_, Nsrc_, ldt_, f8_, mode_, roff_, k0_, n0_; TILE_DECODE(it, Wp, ldw_, Nsrc_, Dp, ldt_, f8_, mode_, roff_, k0_, n0_); (void)Wp; (void)ldw_; (void)Nsrc_;
                  if (f8_) { const int c = tid & 7;
#pragma unroll
                      for (int j = 0; j < 2; ++j) { const int n = (tid >> 3) + 64 * j, nn = n0_ + n; const int drow = mode_ ? ((nn >> 7) * 256 + roff_ + (nn & 127)) : (roff_ + nn);
                          const LAS float* s = tile + (16 * c) * 129 + n; u32x4 o;
                          o.x = pg8::pk4_fp8(s[0 * 129] * 64.f, s[1 * 129] * 64.f, s[2 * 129] * 64.f, s[3 * 129] * 64.f); o.y = pg8::pk4_fp8(s[4 * 129] * 64.f, s[5 * 129] * 64.f, s[6 * 129] * 64.f, s[7 * 129] * 64.f);
                          o.z = pg8::pk4_fp8(s[8 * 129] * 64.f, s[9 * 129] * 64.f, s[10 * 129] * 64.f, s[11 * 129] * 64.f); o.w = pg8::pk4_fp8(s[12 * 129] * 64.f, s[13 * 129] * 64.f, s[14 * 129] * 64.f, s[15 * 129] * 64.f);
                          *(GAS u32x4*)(Dp + (size_t)drow * ldt_ + k0_ + 16 * c) = o; } }
                  else { const int c = tid & 15;
#pragma unroll
                      for (int j = 0; j < 4; ++j) { const int n = (tid >> 4) + 32 * j, nn = n0_ + n; const int drow = roff_ + nn;
                          const LAS float* s = tile + (8 * c) * 129 + n; u32x4 o;
                          o.x = pk2(s[0 * 129], s[1 * 129]); o.y = pk2(s[2 * 129], s[3 * 129]); o.z = pk2(s[4 * 129], s[5 * 129]); o.w = pk2(s[6 * 129], s[7 * 129]);
                          *(GAS u32x4*)(Dp + ((size_t)drow * ldt_ + k0_ + 8 * c) * 2) = o; } } }
                if (!more) break;
                __syncthreads();
#pragma unroll
                for (int i = 0; i < 16; ++i) { tile[(wv + 8 * i) * 129 + ln] = v[i][0]; tile[(wv + 8 * i) * 129 + ln + 64] = v[i][1]; }
                __syncthreads();
                it = nx;
            }
        }
        __syncthreads();
#undef TILE_LOAD
#undef TILE_DECODE
        bf16_t* const W_UV = (bf16_t*)(ws + WS_WUV);
        { LAS float* scr = (LAS float*)(F.lds + F.wave * 8448); constexpr int I_UV = (512 / 64) * (128 / 32);
          for (int it = gw; it < 16 * I_UV; it += NGW) { const int h = it / I_UV, rr = it % I_UV;
              transpose_item8(I.w_uv + (size_t)h * 512 * 128, 128, 128, (unsigned char*)W_UV, 1024, 0, h * 128, scr, rr, F.lane, (h & 1) * 512, ((h & 1) ^ 1) * 512); } }
    }
    {
        const float* wuq = I.w_uq; const float* wuk = I.w_uk; bf16_t* WQ = (bf16_t*)(ws + WS_WQ1);
        constexpr float C2s = 0.08838834764831845f * LOG2E;
        const int l15 = F.lane & 15, l4 = F.lane >> 4;
        for (int it = gw; it < 16 * 16 * 16; it += NGW) {
            const int h = it >> 8, rt = (it >> 4) & 15, jt = it & 15;
            f32x4 acc[2][2] = {};
            const float* ap = wuk + ((size_t)h * 512 + rt * 32 + l15) * 128 + 4 * l4;
            const float* bp = wuq + (size_t)(jt * 32 + l15) * 2048 + h * 128 + 4 * l4;
#pragma unroll 2
            for (int J = 0; J < 8; ++J) {
                const f32x4 a0 = *(const f32x4*)(ap + 16 * J), a1 = *(const f32x4*)(ap + 16 * 128 + 16 * J), b0 = *(const f32x4*)(bp + 16 * J), b1 = *(const f32x4*)(bp + (size_t)16 * 2048 + 16 * J);
#pragma unroll
                for (int e = 0; e < 4; ++e) {
                    acc[0][0] = __builtin_amdgcn_mfma_f32_16x16x4f32(a0[e], b0[e], acc[0][0], 0, 0, 0); acc[0][1] = __builtin_amdgcn_mfma_f32_16x16x4f32(a0[e], b1[e], acc[0][1], 0, 0, 0);
                    acc[1][0] = __builtin_amdgcn_mfma_f32_16x16x4f32(a1[e], b0[e], acc[1][0], 0, 0, 0); acc[1][1] = __builtin_amdgcn_mfma_f32_16x16x4f32(a1[e], b1[e], acc[1][1], 0, 0, 0); }
            }
#pragma unroll
            for (int a = 0; a < 2; ++a)
#pragma unroll
                for (int b = 0; b < 2; ++b)
#pragma unroll
                    for (int e = 0; e < 4; ++e) { const int r = rt * 32 + a * 16 + l4 * 4 + e, j = jt * 32 + b * 16 + l15;
                        WQ[(size_t)(h * 512 + r) * 512 + j] = (bf16_t)f2bf(acc[a][b][e] * C2s); }
        }
    }
}

__device__ __forceinline__ void phase_pre0(const Ctx& F) {
    unsigned char* ws = F.ws;
    LAS float* red = (LAS float*)F.lds;
    for (int job = F.bid; job < 16 + 256; job += F.G) {
        if (job < 16) {
            const int b = job >> 3, h = job & 7; const float* lf = (const float*)(ws + SM_LOGF) + (size_t)b * T * 8 + h;
            float v[16]; float s = 0.f;
#pragma unroll
            for (int i = 0; i < 16; ++i) { s += lf[(size_t)(F.tid * 16 + i) * 8]; v[i] = s; }
            float inc = s;
#pragma unroll
            for (int o = 1; o < 64; o <<= 1) { const float t = __shfl_up(inc, o); if (F.lane >= o) inc += t; }
            if (F.lane == 63) red[F.wave] = inc;
            __syncthreads();
            float base = 0.f;
            for (int w = 0; w < F.wave; ++w) base += red[w];
            base += inc - s;
            float* cl = (float*)(ws + SM_CL2) + (size_t)job * 8192 + F.tid * 16;
#pragma unroll
            for (int i = 0; i < 16; ++i) cl[i] = (base + v[i]) * LOG2E;
            __syncthreads();
        } else {
            const int jj = job - 16;
            for (int half = 0; half < 2; ++half) {
                const int bh = jj >> 4, blk = (jj & 15) * 2 + half;
                const bf16_t* kA = (const bf16_t*)(ws + B0_QKV) + ((size_t)(1 * 16 + bh) * 8192 + blk * 256) * 128;
                const bf16_t* qB = (const bf16_t*)(ws + B0_QKV) + ((size_t)(3 * 16 + bh) * 8192 + blk * 256) * 128;
                const bf16_t* kB = (const bf16_t*)(ws + B0_QKV) + ((size_t)(4 * 16 + bh) * 8192 + blk * 256) * 128;
                const int rg = F.tid >> 4, c8 = F.tid & 15;
                float cs[8] = {0, 0, 0, 0, 0, 0, 0, 0}; float qm = 0.f, km = 0.f;
                for (int i = 0; i < 8; ++i) { const int row = rg * 8 + i;
                    const u32x4 a = *(const u32x4*)(kA + (size_t)row * 128 + c8 * 8), q = *(const u32x4*)(qB + (size_t)row * 128 + c8 * 8), k = *(const u32x4*)(kB + (size_t)row * 128 + c8 * 8);
                    float sq = 0.f, sk = 0.f;
#pragma unroll
                    for (int e = 0; e < 4; ++e) { cs[2 * e] += bflo(a[e]); cs[2 * e + 1] += bfhi(a[e]);
                        sq += bflo(q[e]) * bflo(q[e]) + bfhi(q[e]) * bfhi(q[e]); sk += bflo(k[e]) * bflo(k[e]) + bfhi(k[e]) * bfhi(k[e]); }
                    sq = row16_sum(sq); sk = row16_sum(sk);
                    qm = fmaxf(qm, sq); km = fmaxf(km, sk); }
#pragma unroll
                for (int e = 0; e < 8; ++e) red[rg * 128 + c8 * 8 + e] = cs[e];
                qm = wave_max(qm); km = wave_max(km);
                if (F.lane == 0) { red[4096 + F.wave] = qm; red[4096 + 8 + F.wave] = km; }
                __syncthreads();
                if (F.tid < 128) { float s = 0.f; for (int g = 0; g < 32; ++g) s += red[g * 128 + F.tid]; ((float*)(ws + SM_KMEAN))[((size_t)bh * 32 + blk) * 128 + F.tid] = s * (1.0f / 256.0f); }
                if (F.tid == 128) { float a = 0.f, k = 0.f; for (int w = 0; w < 8; ++w) { a = fmaxf(a, red[4096 + w]); k = fmaxf(k, red[4096 + 8 + w]); }
                    ((float*)(ws + SM_QN))[bh * 32 + blk] = a; ((float*)(ws + SM_KN))[bh * 32 + blk] = k; }
                __syncthreads();
            }
        }
    }
}

__device__ __forceinline__ int rel_bucket_dev(int n) {
    if (n < 16) return n;
    const int l = 16 + (int)(logf((float)n / 16.0f) / 2.0794415416798357f * 16.0f);
    return l > 31 ? 31 : l;
}

#define ATT_COMMON() \
    unsigned char* ws = F.ws; char* lds = (char*)F.ldsg; \
    const bf16_t* QKV = (const bf16_t*)(ws + B0_QKV); unsigned char* O = ws + B0_O; \
    LAS float* ncl = (LAS float*)(F.lds + att::OFF_NCL); LAS float* lut = (LAS float*)(F.lds + att::OFF_LUT); LAS float* kmL = (LAS float*)(F.lds + att::OFF_KM); LAS int* misc = (LAS int*)(F.lds + att::OFF_MISC); \
    const size_t TSTR = (size_t)16 * 8192 * 128; \
    const int tid0 = F.tid;
#define ATT_LANE() int tid = tid0; asm volatile("" : "+v"(tid)); const int wid = __builtin_amdgcn_readfirstlane(tid >> 6), lane = tid & 63, r32 = lane & 31, hi = lane >> 5;
__device__ __forceinline__ void phase_attn0_moba(const Ctx& F, const float* tab) {
    ATT_COMMON()
    for (int u = F.bid; u < 256; u += F.G) {
        const int bh = u >> 4, b = bh >> 3, h = bh & 7;
        for (int i = tid0; i < 129; i += NTHREADS) lut[i] = tab[rel_bucket_dev(i) * 16 + h] * LOG2E;
        const float farL = tab[31 * 16 + h] * LOG2E;
        for (int pass = 0; pass < 2; ++pass) {
            ATT_LANE()
            const int qb = pass ? 31 - (u & 15) : (u & 15), P0 = qb * 256;
            const bf16_t* Qp = QKV + 0 * TSTR + ((size_t)bh * 8192 + P0) * 128; const bf16_t* Kh = QKV + 1 * TSTR + (size_t)bh * 8192 * 128; const bf16_t* Vh = QKV + 2 * TSTR + (size_t)bh * 8192 * 128;
            for (int i = tid; i < qb * 128; i += NTHREADS) kmL[i] = ((const float*)(ws + SM_KMEAN))[(size_t)bh * 32 * 128 + i];
            bf16x8 qr[8];
#pragma unroll
            for (int d0 = 0; d0 < 8; ++d0) qr[d0] = att::load8(Qp + (size_t)(wid * 32 + r32) * 128 + d0 * 16 + hi * 8);
            __syncthreads();
            float g1 = -__builtin_inff(), g2 = g1, g3 = g1; int i1 = -1, i2 = -1, i3 = -1;
            for (int blk = 0; blk < qb; ++blk) {
                float g = 0.f; const LAS float* km = kmL + blk * 128 + hi * 8;
#pragma unroll
                for (int d0 = 0; d0 < 8; ++d0) { const f32x4 k0 = *(const LAS f32x4*)(km + d0 * 16), k1 = *(const LAS f32x4*)(km + d0 * 16 + 4); const u32x4 q = *reinterpret_cast<const u32x4*>(&qr[d0]);
                    g += bflo(q[0]) * k0[0] + bfhi(q[0]) * k0[1] + bflo(q[1]) * k0[2] + bfhi(q[1]) * k0[3] + bflo(q[2]) * k1[0] + bfhi(q[2]) * k1[1] + bflo(q[3]) * k1[2] + bfhi(q[3]) * k1[3]; }
                g += __shfl_xor(g, 32);
                if (g > g1) { g3 = g2; i3 = i2; g2 = g1; i2 = i1; g1 = g; i1 = blk; }
                else if (g > g2) { g3 = g2; i3 = i2; g2 = g; i2 = blk; }
                else if (g > g3) { g3 = g; i3 = blk; }
            }
            unsigned selmask = 1u << qb;
            if (i1 >= 0) selmask |= 1u << i1; if (i2 >= 0) selmask |= 1u << i2; if (i3 >= 0) selmask |= 1u << i3;
            att::attn_block<1, 2048>(Qp, Kh, Vh, O + ((size_t)b * 8192 + P0) * 2048 + h * 128, P0, 0, (P0 + 255) / 64 + 1, lds, ncl, 0, lut, selmask, farL, qr, tid);
        }
    }
}
__device__ __forceinline__ void phase_attn0_fox(const Ctx& F) {
    ATT_COMMON()
    for (int u = F.bid; u < 512; u += F.G) {
        ATT_LANE()
        const int bh = u >> 5, b = bh >> 3, h = bh & 7, qb = 31 - (u & 31), P0 = qb * 256;
        const float* cl2 = (const float*)(ws + SM_CL2) + (size_t)bh * 8192;
        const bf16_t* Qp = QKV + 3 * TSTR + ((size_t)bh * 8192 + P0) * 128; const bf16_t* Kh = QKV + 4 * TSTR + (size_t)bh * 8192 * 128; const bf16_t* Vh = QKV + 5 * TSTR + (size_t)bh * 8192 * 128;
        const float ref = cl2[P0];
        if (wid == 0) {
            float kmax = 0.f; for (int i = lane; i <= qb; i += 64) kmax = fmaxf(kmax, ((const float*)(ws + SM_KN))[bh * 32 + i]);
            kmax = wave_max(kmax);
            const float qmax = ((const float*)(ws + SM_QN))[bh * 32 + qb];
            const float B2 = (105.0f + 2.0f * sqrtf(qmax * kmax) * att::SCALE * 1.0001f) * LOG2E;
            const int ntile = P0 / 64; int first = ntile;
            for (int base = 0; base < ntile; base += 64) { const int J = base + lane; const bool need = (J < ntile) && (cl2[64 * J + 63] - ref <= B2);
                const unsigned long long bal = __ballot(need); if (bal) { first = base + __builtin_ctzll(bal); break; } }
            if (lane == 0) misc[0] = first;
        }
        bf16x8 qr[8];
#pragma unroll
        for (int d0 = 0; d0 < 8; ++d0) qr[d0] = att::load8(Qp + (size_t)(wid * 32 + r32) * 128 + d0 * 16 + hi * 8);
        __syncthreads();
        const int j_lo = __builtin_amdgcn_readfirstlane(misc[0]), nclbase = j_lo * 64;
        for (int k = nclbase + tid; k < P0 + 256; k += NTHREADS) ncl[k - nclbase] = ref - cl2[k];
        att::attn_block<0, 2048>(Qp, Kh, Vh, O + ((size_t)b * 8192 + P0) * 2048 + 1024 + h * 128, P0, j_lo, (P0 + 255) / 64 + 1, lds, ncl, nclbase, lut, 0u, 0.f, qr, tid);
    }
}

__device__ __forceinline__ void ln_row(const f32x4 (&v)[8], const float* g, const float* bta, int lane, f32x4 (&y)[8], float* stat = nullptr) {
    float s = 0.f;
#pragma unroll
    for (int j = 0; j < 8; ++j) s += (v[j][0] + v[j][1]) + (v[j][2] + v[j][3]);
    const float mean = wave_sum(s) * (1.f / DM); float s2 = 0.f;
#pragma unroll
    for (int j = 0; j < 8; ++j) { const f32x4 d = v[j] - mean; s2 += (d[0] * d[0] + d[1] * d[1]) + (d[2] * d[2] + d[3] * d[3]); }
    const float rstd = 1.0f / sqrtf(wave_sum(s2) * (1.f / DM) + LN_EPS);
    if (stat != nullptr && lane == 0) { stat[0] = mean; stat[1] = rstd; }
#pragma unroll
    for (int j = 0; j < 8; ++j) { const f32x4 gg = *(const f32x4*)(g + 256 * j + 4 * lane), bb = *(const f32x4*)(bta + 256 * j + 4 * lane); y[j] = (v[j] - mean) * rstd * gg + bb; }
}
template <bool OUT8>
__device__ __forceinline__ void phase_ln(const Ctx& F, const float* g, const float* bta) {
    const int gw = F.bid * NWAVES + F.wave, NGW = F.G * NWAVES;
    for (int m = gw; m < M; m += NGW) {
        GAS f32x4* xr = (GAS f32x4*)(F.out + (size_t)m * DM) + F.lane;
        f32x4 v[8], y[8];
#pragma unroll
        for (int j = 0; j < 8; ++j) v[j] = xr[64 * j];
        ln_row(v, g, bta, F.lane, y, (float*)(F.ws + SM_STAT) + 2 * (size_t)m);
        if constexpr (OUT8) { GAS unsigned* o8 = (GAS unsigned*)(F.ws + WS_XB + (size_t)m * DM) + F.lane;
#pragma unroll
            for (int j = 0; j < 8; ++j) o8[64 * j] = pg8::pk4_fp8(y[j][0], y[j][1], y[j][2], y[j][3]); }
        else { GAS u32x2* o8 = (GAS u32x2*)((bf16_t*)(F.ws + WS_XB) + (size_t)m * DM) + F.lane;
#pragma unroll
            for (int j = 0; j < 8; ++j) { u32x2 w; w.x = pk2(y[j][0], y[j][1]); w.y = pk2(y[j][2], y[j][3]); o8[64 * j] = w; } }
    }
}
__device__ __forceinline__ void phase_ln_router(const Ctx& F, const float* g, const float* bta, const float* router) {
    const int gw = F.bid * NWAVES + F.wave, NGW = F.G * NWAVES;
    LAS float* wr = (LAS float*)F.lds;
    for (int i = F.tid; i < 8 * 2048; i += NTHREADS) { const int j = i & 7, k = i >> 3; wr[j * 2048 + k] = router[(size_t)k * 8 + j]; }
    __syncthreads();
    unsigned* cnt = (unsigned*)(F.ws + WS_CTL) + CW_CNT;
    for (int m = gw; m < M; m += NGW) {
        GAS f32x4* xr = (GAS f32x4*)(F.out + (size_t)m * DM) + F.lane;
        f32x4 v[8], y[8];
#pragma unroll
        for (int j = 0; j < 8; ++j) v[j] = xr[64 * j];
        ln_row(v, g, bta, F.lane, y, (float*)(F.ws + SM_STAT) + 2 * (size_t)m);
        GAS unsigned* o8 = (GAS unsigned*)(F.ws + WS_XB + (size_t)m * DM) + F.lane;
#pragma unroll
        for (int j = 0; j < 8; ++j) o8[64 * j] = pg8::pk4_fp8(y[j][0], y[j][1], y[j][2], y[j][3]);
        float mylg = 0.f;
#pragma unroll 1
        for (int e = 0; e < 8; ++e) { float s = 0.f;
#pragma unroll
            for (int j = 0; j < 8; ++j) { const f32x4 w = *(const LAS f32x4*)(wr + e * 2048 + 256 * j + 4 * F.lane); s += y[j][0] * w[0] + y[j][1] * w[1] + y[j][2] * w[2] + y[j][3] * w[3]; }
            s = wave_sum(s); mylg = (F.lane == e) ? s : mylg; }
        float lg[8];
#pragma unroll
        for (int e = 0; e < 8; ++e) lg[e] = __builtin_bit_cast(float, __builtin_amdgcn_readlane(__builtin_bit_cast(int, mylg), e));
        if (F.lane == 0) {
            int e0 = 0; float l0 = lg[0];
#pragma unroll
            for (int e = 1; e < 8; ++e) if (lg[e] > l0) { l0 = lg[e]; e0 = e; }
            int e1 = -1; float l1 = -__builtin_inff();
#pragma unroll
            for (int e = 0; e < 8; ++e) if (e != e0 && lg[e] > l1) { l1 = lg[e]; e1 = e; }
            const float ex = expf(l1 - l0), g0 = 1.0f / (1.0f + ex), g1 = ex / (1.0f + ex);
            const unsigned p0 = __hip_atomic_fetch_add(cnt + 64 * e0, 1u, RLX_AGENT), p1 = __hip_atomic_fetch_add(cnt + 64 * e1, 1u, RLX_AGENT);
            int* rte = (int*)(F.ws + SM_RTE) + (size_t)m * 2; float* rtg = (float*)(F.ws + SM_RTG) + (size_t)m * 2; int* rtp = (int*)(F.ws + SM_RTP) + (size_t)m * 2;
            rte[0] = e0; rte[1] = e1; rtg[0] = g0; rtg[1] = g1; rtp[0] = (int)p0; rtp[1] = (int)p1;
        }
    }
}
__device__ __forceinline__ void moe_tstart(const Ctx& F, int (&ts)[9]) {
    const unsigned* cnt = (const unsigned*)(F.ws + WS_CTL) + CW_CNT; int a = 0;
#pragma unroll
    for (int e = 0; e < 8; ++e) { ts[e] = a; a += ((int)__hip_atomic_load(cnt + 64 * e, RLX_AGENT) + 255) >> 8; }
    ts[8] = a;
}
__device__ __forceinline__ void phase_gather(const Ctx& F) {
    int ts[9]; moe_tstart(F, ts);
    const int gw = F.bid * NWAVES + F.wave, NGW = F.G * NWAVES;
    const int* rte = (const int*)(F.ws + SM_RTE); const int* rtp = (const int*)(F.ws + SM_RTP); int* rrow = (int*)(F.ws + SM_ROW);
    for (int a = gw; a < 2 * M; a += NGW) {
        const int m = a >> 1, e = rte[a], p = rtp[a]; int st = 0;
#pragma unroll
        for (int j = 0; j < 8; ++j) st = (e == j) ? ts[j] : st;
        const int row = st * 256 + p;
        const GAS u32x4* src = (const GAS u32x4*)(F.ws + WS_XB + (size_t)m * DM) + F.lane;
        GAS u32x4* dst = (GAS u32x4*)(F.ws + B1_XG + (size_t)row * DM) + F.lane;
#pragma unroll
        for (int j = 0; j < 2; ++j) dst[64 * j] = src[64 * j];
        if (F.lane == 0) rrow[a] = row;
    }
}
__device__ __forceinline__ void phase_final(const Ctx& F, const float* g, const float* bta, const int S, const float* gp, const float* bp) {
    const int gw = F.bid * NWAVES + F.wave, NGW = F.G * NWAVES;
    const int* rrow = (const int*)(F.ws + SM_ROW); const float* rtg = (const float*)(F.ws + SM_RTG); const bf16_t* Y = (const bf16_t*)(F.ws + B1_Y);
    const unsigned* flags = (const unsigned*)(F.ws + WS_CTL) + CW_FLAG; const float* slabs = (const float*)(F.ws + B1_SLAB);
    for (int m = gw; m < M; m += NGW) {
        GAS f32x4* xr = (GAS f32x4*)(F.out + (size_t)m * DM) + F.lane;
        const int r0 = rrow[2 * m], r1 = rrow[2 * m + 1]; const float g0 = rtg[2 * m], g1 = rtg[2 * m + 1];
        const float pmean = ((const float*)(F.ws + SM_STAT))[2 * (size_t)m], prstd = ((const float*)(F.ws + SM_STAT))[2 * (size_t)m + 1];
        int lz = F.lane; asm volatile("" : "+v"(lz));
        const float* gpl = gp + 4 * lz; const float* bpl = bp + 4 * lz;
        const GAS u32x2* y0 = (const GAS u32x2*)(Y + (size_t)r0 * DM) + F.lane; const GAS u32x2* y1 = (const GAS u32x2*)(Y + (size_t)r1 * DM) + F.lane;
        f32x4 v[8], y[8];
        const unsigned* fl0 = flags + (r0 >> 8) * 8; const unsigned* fl1 = flags + (r1 >> 8) * 8;
#pragma unroll
        for (int j = 0; j < 8; ++j) { const f32x4 x = (xr[64 * j] - pmean) * prstd * *(const f32x4*)(gpl + 256 * j) + *(const f32x4*)(bpl + 256 * j); f32x4 fa, fc;
            const unsigned f0 = fl0[j], f1 = fl1[j];
            if (f0 == 0u) { const u32x2 a = y0[64 * j]; fa = (f32x4){bflo(a.x), bfhi(a.x), bflo(a.y), bfhi(a.y)}; }
            else { const float* sp = slabs + (size_t)(f0 - 1u) * 65536 + (size_t)(r0 & 255) * 256 + 4 * F.lane; fa = *(const f32x4*)sp; for (int s = 1; s < S; ++s) fa = fa + *(const f32x4*)(sp + (size_t)s * 65536); fa = (f32x4){bf2f((unsigned short)f2bf(fa[0])), bf2f((unsigned short)f2bf(fa[1])), bf2f((unsigned short)f2bf(fa[2])), bf2f((unsigned short)f2bf(fa[3]))}; }
            if (f1 == 0u) { const u32x2 c = y1[64 * j]; fc = (f32x4){bflo(c.x), bfhi(c.x), bflo(c.y), bfhi(c.y)}; }
            else { const float* sp = slabs + (size_t)(f1 - 1u) * 65536 + (size_t)(r1 & 255) * 256 + 4 * F.lane; fc = *(const f32x4*)sp; for (int s = 1; s < S; ++s) fc = fc + *(const f32x4*)(sp + (size_t)s * 65536); fc = (f32x4){bf2f((unsigned short)f2bf(fc[0])), bf2f((unsigned short)f2bf(fc[1])), bf2f((unsigned short)f2bf(fc[2])), bf2f((unsigned short)f2bf(fc[3]))}; }
            v[j] = x * ALPHA + (fa * g0 + fc * g1); }
        ln_row(v, g, bta, F.lane, y);
#pragma unroll
        for (int j = 0; j < 8; ++j) xr[64 * j] = y[j];
    }
}
__device__ __forceinline__ void phase_norm1(const Ctx& F, const float* gq, const float* gk) {
    const int gw = F.bid * NWAVES + F.wave, NGW = F.G * NWAVES;
    const float* proj = (const float*)(F.ws + B1_PROJ);
    for (int m = gw; m < M; m += NGW) {
        const float* pr = proj + (size_t)m * NIN1P;
        const f32x4 q0 = *(const f32x4*)(pr + 8 * F.lane), q1 = *(const f32x4*)(pr + 8 * F.lane + 4), k0 = *(const f32x4*)(pr + 512 + 8 * F.lane), k1 = *(const f32x4*)(pr + 512 + 8 * F.lane + 4);
        float sq = q0[0] * q0[0] + q0[1] * q0[1] + q0[2] * q0[2] + q0[3] * q0[3] + q1[0] * q1[0] + q1[1] * q1[1] + q1[2] * q1[2] + q1[3] * q1[3];
        float sk = k0[0] * k0[0] + k0[1] * k0[1] + k0[2] * k0[2] + k0[3] * k0[3] + k1[0] * k1[0] + k1[1] * k1[1] + k1[2] * k1[2] + k1[3] * k1[3];
        sq = wave_sum(sq); sk = wave_sum(sk);
        const float rq = 1.0f / sqrtf(sq * (1.f / 512.f) + RMS_EPS), rk = 1.0f / sqrtf(sk * (1.f / 512.f) + RMS_EPS);
        const f32x4 gq0 = *(const f32x4*)(gq + 8 * F.lane), gq1 = *(const f32x4*)(gq + 8 * F.lane + 4), gk0 = *(const f32x4*)(gk + 8 * F.lane), gk1 = *(const f32x4*)(gk + 8 * F.lane + 4);
        const f32x4 a0 = q0 * rq * gq0, a1 = q1 * rq * gq1, c0 = k0 * rk * gk0, c1 = k1 * rk * gk1;
        u32x4 w; w.x = pk2(a0[0], a0[1]); w.y = pk2(a0[2], a0[3]); w.z = pk2(a1[0], a1[1]); w.w = pk2(a1[2], a1[3]);
        *((GAS u32x4*)((bf16_t*)(F.ws + B1_CQN) + (size_t)m * 512) + F.lane) = w;
        w.x = pk2(c0[0], c0[1]); w.y = pk2(c0[2], c0[3]); w.z = pk2(c1[0], c1[1]); w.w = pk2(c1[2], c1[3]);
        *((GAS u32x4*)((bf16_t*)(F.ws + B1_CKVN) + (size_t)m * 512) + F.lane) = w;
        if (F.lane < 32) { const float a = pr[1024 + 2 * F.lane], c = pr[1024 + 2 * F.lane + 1]; ((unsigned*)((bf16_t*)(F.ws + SM_KIDX) + (size_t)m * 64))[F.lane] = pk2(a, c); }
        else if (F.lane < 48) ((float*)(F.ws + SM_WIDX))[(size_t)m * 16 + (F.lane - 32)] = pr[1088 + (F.lane - 32)];
    }
}
__device__ __forceinline__ size_t sc_row_off(int b, int t) { const int qc = t >> 7; return (size_t)b * SC_PER_BATCH + (size_t)16384 * (qc * (qc + 1) / 2) + (size_t)(t & 127) * (128 * (qc + 1)); }

__device__ __forceinline__ float relu_f(float x) { const int b = __builtin_bit_cast(int, x); return __builtin_bit_cast(float, b > 0 ? b : 0); }
__device__ __forceinline__ void phase_index(const Ctx& F, float* SC) {
    const bf16_t* QI = (const bf16_t*)(F.ws + B1_QIDX); const bf16_t* KI = (const bf16_t*)(F.ws + SM_KIDX); const float* WI = (const float*)(F.ws + SM_WIDX);
    const int tid = F.tid, lane = F.lane, l15 = lane & 15, q4 = lane >> 4, wid = F.wave;
    LAS unsigned char* ktile = F.lds + 65536;
    const int skey = tid >> 3, sch = tid & 7; const unsigned st_off = (unsigned)(skey * 128 + ((sch ^ (skey & 7)) << 4));
    unsigned rd_off[4][2];
#pragma unroll
    for (int sg = 0; sg < 4; ++sg)
#pragma unroll
        for (int s = 0; s < 2; ++s) { const int k = sg * 16 + l15, c = s * 4 + q4; rd_off[sg][s] = (unsigned)(k * 128 + ((c ^ (k & 7)) << 4)); }
    unsigned* qhead = (unsigned*)(F.ws + WS_CTL) + CW_QIDX; LAS int* qslot = (LAS int*)(F.lds + 65536 + 16384);
    if (tid == 0) qslot[0] = (int)__hip_atomic_fetch_add(qhead, 1u, RLX_AGENT);
    __syncthreads();
    for (;;) {
        const int u = __builtin_amdgcn_readfirstlane(qslot[0]);
        if (u >= 576) break;
        int unext = 0; if (tid == 0) unext = (int)__hip_atomic_fetch_add(qhead, 1u, RLX_AGENT);
        const int v = 575 - u;
        const int b = v / 288, w = v % 288; int g = 0;
#pragma unroll
        for (int j = 1; j < 8; ++j) g += (w >= 4 * j * (j + 1)) ? 1 : 0;
        const int rem = w - 4 * g * (g + 1), qc = 8 * g + rem / (g + 1), ks = rem % (g + 1);
        const int k_lo = ks * 1024; int k_hi = k_lo + 1024; if (k_hi > 128 * (qc + 1)) k_hi = 128 * (qc + 1);
        const int pitch = 128 * (qc + 1), ntile = (k_hi - k_lo) >> 6;
        const bf16_t* kg = KI + ((size_t)b * T + k_lo + skey) * 64 + sch * 8;
#pragma unroll 1
        for (int pass = 0; pass < 4; ++pass) {
            const int t0 = qc * 128 + wid * 16 + pass * 4;
            bf16x8 af[4][2]; f32x4 wq[4];
#pragma unroll
            for (int i = 0; i < 4; ++i) { const size_t m = (size_t)b * T + t0 + i;
                af[i][0] = *(const bf16x8*)(QI + m * 1024 + l15 * 64 + q4 * 8); af[i][1] = *(const bf16x8*)(QI + m * 1024 + l15 * 64 + 32 + q4 * 8);
                wq[i] = *(const f32x4*)(WI + m * 16 + 4 * q4); }
            LAS float* stg = (LAS float*)(F.lds + wid * 8192) + lane; float* scp = SC + sc_row_off(b, t0) + k_lo;
            u32x4 kreg = *(const u32x4*)kg;
            *(LAS u32x4*)(ktile + st_off) = kreg;
            if (ntile > 1) kreg = *(const u32x4*)(kg + (size_t)64 * 64);
            __syncthreads();
#pragma unroll 1
            for (int ti = 0; ti < ntile; ++ti) {
                const LAS unsigned char* kt = ktile + (ti & 1) * 8192;
                bf16x8 bfr[4][2];
#pragma unroll
                for (int sg = 0; sg < 4; ++sg) { bfr[sg][0] = *(const LAS bf16x8*)(kt + rd_off[sg][0]); bfr[sg][1] = *(const LAS bf16x8*)(kt + rd_off[sg][1]); }
                if (ti + 1 < ntile) *(LAS u32x4*)(ktile + ((ti + 1) & 1) * 8192 + st_off) = kreg;
                if (ti + 2 < ntile) kreg = *(const u32x4*)(kg + (size_t)(ti + 2) * 64 * 64);
                f32x4 acc[4][4];
#pragma unroll
                for (int i = 0; i < 4; ++i)
#pragma unroll
                    for (int sg = 0; sg < 4; ++sg) acc[i][sg] = __builtin_amdgcn_mfma_f32_16x16x32_bf16(af[i][0], bfr[sg][0], (f32x4){0.f, 0.f, 0.f, 0.f}, 0, 0, 0);
#pragma unroll
                for (int i = 0; i < 4; ++i)
#pragma unroll
                    for (int sg = 0; sg < 4; ++sg) acc[i][sg] = __builtin_amdgcn_mfma_f32_16x16x32_bf16(af[i][1], bfr[sg][1], acc[i][sg], 0, 0, 0);
#pragma unroll
                for (int i = 0; i < 4; ++i) {
                    float part[4];
#pragma unroll
                    for (int sg = 0; sg < 4; ++sg) part[sg] = relu_f(acc[i][sg][0]) * wq[i][0] + relu_f(acc[i][sg][1]) * wq[i][1] + relu_f(acc[i][sg][2]) * wq[i][2] + relu_f(acc[i][sg][3]) * wq[i][3];
                    auto s0 = __builtin_amdgcn_permlane32_swap(__float_as_uint(part[0]), __float_as_uint(part[2]), false, false);
                    auto s1 = __builtin_amdgcn_permlane32_swap(__float_as_uint(part[1]), __float_as_uint(part[3]), false, false);
                    const float k0 = __uint_as_float(s0[0]) + __uint_as_float(s0[1]), k1 = __uint_as_float(s1[0]) + __uint_as_float(s1[1]);
                    auto s2 = __builtin_amdgcn_permlane16_swap(__float_as_uint(k0), __float_as_uint(k1), false, false);
                    stg[i * 512 + (ti & 7) * 64] = __uint_as_float(s2[0]) + __uint_as_float(s2[1]);
                }
                if ((ti & 7) == 7 || ti + 1 == ntile) {
                    LDS_WAIT(); asm volatile("" ::: "memory");
                    const int c0 = (ti & ~7) * 64, nc = (ti + 1) * 64 - c0;
#pragma unroll
                    for (int i = 0; i < 4; ++i) for (int k = 4 * lane; k < nc; k += 256) *(f32x4*)(scp + (size_t)i * pitch + c0 + k) = *(const LAS f32x4*)((LAS float*)(F.lds + wid * 8192) + i * 512 + k);
                    LDS_WAIT(); asm volatile("" ::: "memory"); }
                __syncthreads();
            }
        }
        if (tid == 0) qslot[0] = unext;
        __syncthreads();
    }
}

__device__ __forceinline__ int cnt_ge8(unsigned a0, unsigned a1, unsigned a2, unsigned a3, unsigned a4, unsigned a5, unsigned a6, unsigned a7, unsigned b) {
    unsigned long long m0, m1, m2, m3, m4, m5, m6, m7;
    asm("v_cmp_ge_u32_e64 %0, %8, %16\n\tv_cmp_ge_u32_e64 %1, %9, %16\n\tv_cmp_ge_u32_e64 %2, %10, %16\n\tv_cmp_ge_u32_e64 %3, %11, %16\n\t"
        "v_cmp_ge_u32_e64 %4, %12, %16\n\tv_cmp_ge_u32_e64 %5, %13, %16\n\tv_cmp_ge_u32_e64 %6, %14, %16\n\tv_cmp_ge_u32_e64 %7, %15, %16"
        : "=&s"(m0), "=&s"(m1), "=&s"(m2), "=&s"(m3), "=&s"(m4), "=&s"(m5), "=&s"(m6), "=&s"(m7)
        : "v"(a0), "v"(a1), "v"(a2), "v"(a3), "v"(a4), "v"(a5), "v"(a6), "v"(a7), "v"(b));
    return (__builtin_popcountll(m0) + __builtin_popcountll(m1)) + (__builtin_popcountll(m2) + __builtin_popcountll(m3)) + (__builtin_popcountll(m4) + __builtin_popcountll(m5)) + (__builtin_popcountll(m6) + __builtin_popcountll(m7));
}
__device__ __forceinline__ void phase_topk(const Ctx& F, const int reps) {
    const float* SC = (const float*)(F.ws + B1_SC); int* SEL = (int*)(F.ws + SM_SEL);
    const int lane = F.lane;
    LAS int* lst = (LAS int*)(F.lds + F.wave * 1024);
    unsigned* qhead = (unsigned*)(F.ws + WS_CTL) + CW_QTOPK;
    unsigned nxt = 0u; if (lane == 0) nxt = __hip_atomic_fetch_add(qhead, 1u, RLX_AGENT);
#pragma unroll 1
    for (;;) {
        const unsigned qi = (unsigned)__builtin_amdgcn_readfirstlane((int)nxt);
        if (qi >= (unsigned)(M * reps)) break;
        if (lane == 0) nxt = __hip_atomic_fetch_add(qhead, 1u, RLX_AGENT);
        const int qq = (int)(qi % (unsigned)M), b = qq & 1, t = 8191 - (qq >> 1), m = b * T + t; int* out = SEL + (size_t)m * 256;
        if (t < 256) {
#pragma unroll
            for (int j = 0; j < 4; ++j) { const int i = lane + 64 * j; out[i] = (i <= t) ? i : -1; }
            continue;
        }
        const float* row = SC + sc_row_off(b, t);
        const int nreg = (t >> 6) + 1;
        unsigned u[128];
#pragma unroll
        for (int gi = 0; gi < 8; ++gi) {
            if (gi * 16 < nreg) {
#pragma unroll
                for (int i = gi * 16; i < gi * 16 + 16; ++i) u[i] = __float_as_uint(row[lane + 64 * i]);
            } else {
#pragma unroll
                for (int i = gi * 16; i < gi * 16 + 16; ++i) u[i] = 0u;
            }
        }
#pragma unroll
        for (int gi = 0; gi < 8; ++gi) if (gi * 16 < nreg) {
#pragma unroll
            for (int i = gi * 16; i < gi * 16 + 16; ++i) { const int idx = lane + 64 * i; const unsigned bits = u[i]; const unsigned key = (bits & 0x80000000u) ? ~bits : (bits | 0x80000000u); u[i] = (idx <= t) ? key : 0u; }
        }
        bool done = false;
        if (nreg > 16) {
            unsigned Tl = 0u;
            for (int bit = 31; bit >= 0; --bit) { const unsigned cand = Tl | (1u << bit); int c = 0;
#pragma unroll
                for (int gi = 0; gi < 8; ++gi) if (gi * 16 < nreg) c += __builtin_popcountll(__ballot(u[gi * 16] >= cand)) + __builtin_popcountll(__ballot(u[gi * 16 + 8] >= cand));
                if (c >= 48) Tl = cand; }
            int call = 0;
#pragma unroll
            for (int gi = 0; gi < 8; ++gi) if (gi * 16 < nreg) {
#pragma unroll
                for (int i = gi * 16; i < gi * 16 + 16; i += 8) call += cnt_ge8(u[i], u[i + 1], u[i + 2], u[i + 3], u[i + 4], u[i + 5], u[i + 6], u[i + 7], Tl); }
            if (call >= 256 && call <= 1024) {
                LAS unsigned* keyL = (LAS unsigned*)(F.lds + 8192 + F.wave * 8192); LAS unsigned* idxL = keyL + 1024;
                int cb = 0;
#pragma unroll
                for (int gi = 0; gi < 8; ++gi) if (gi * 16 < nreg) {
#pragma unroll
                    for (int i = gi * 16; i < gi * 16 + 16; ++i) { const bool s = u[i] >= Tl; const unsigned long long sb = __ballot(s);
                        if (s) { const int p = cb + (int)__builtin_amdgcn_mbcnt_hi((unsigned)(sb >> 32), __builtin_amdgcn_mbcnt_lo((unsigned)sb, 0u)); keyL[p] = u[i]; idxL[p] = (unsigned)(lane + 64 * i); }
                        cb += __builtin_popcountll(sb); } }
                LDS_WAIT(); asm volatile("" ::: "memory");
                const int nc = (call + 63) >> 6;
                unsigned ck[16], ci[16];
#pragma unroll
                for (int j = 0; j < 16; ++j) { const int p = lane + 64 * j; const bool ok = (j < nc) && (p < call); ck[j] = ok ? keyL[p] : 0u; ci[j] = ok ? idxL[p] : 0u; }
                unsigned Tk = 0u; bool exact = false;
                for (int bit = 31; bit >= 0; --bit) { const unsigned cand = Tk | (1u << bit); int c = 0;
#pragma unroll
                    for (int j = 0; j < 16; ++j) if (j < nc) c += __builtin_popcountll(__ballot(ck[j] >= cand));
                    if (c >= 256) { Tk = cand; if (c == 256) { exact = true; break; } } }
                int need = 0;
                if (!exact) { int c = 0;
#pragma unroll
                    for (int j = 0; j < 16; ++j) if (j < nc) c += __builtin_popcountll(__ballot(ck[j] > Tk));
                    need = 256 - c; }
                int base = 0, eq_taken = 0;
#pragma unroll
                for (int j = 0; j < 16; ++j) if (j < nc) {
                    const bool eq = ck[j] == Tk; const unsigned long long eb = __ballot(eq && !exact);
                    const int rank = eq_taken + __builtin_popcountll(eb & ((1ull << lane) - 1ull)); eq_taken += __builtin_popcountll(eb);
                    const bool s = exact ? (ck[j] >= Tk) : ((ck[j] > Tk) || (eq && rank < need));
                    const unsigned long long sb = __ballot(s);
                    if (s) { const int pos = base + __builtin_popcountll(sb & ((1ull << lane) - 1ull)); if (pos < 256) lst[pos] = (int)ci[j]; }
                    base += __builtin_popcountll(sb); }
                done = true;
            }
        }
        if (!done) {
            unsigned Tk = 0u; bool exact = false;
            for (int bit = 31; bit >= 0; --bit) {
                const unsigned cand = Tk | (1u << bit); int c = 0;
    #pragma unroll
                for (int gi = 0; gi < 8; ++gi) if (gi * 16 < nreg) {
    #pragma unroll
                    for (int i = gi * 16; i < gi * 16 + 16; i += 8) c += cnt_ge8(u[i], u[i + 1], u[i + 2], u[i + 3], u[i + 4], u[i + 5], u[i + 6], u[i + 7], cand); }
                if (c >= 256) { Tk = cand; if (c == 256) { exact = true; break; } }
            }
            int need = 0;
            if (!exact) { int c = 0;
    #pragma unroll
                for (int gi = 0; gi < 8; ++gi) if (gi * 16 < nreg) {
    #pragma unroll
                    for (int i = gi * 16; i < gi * 16 + 16; ++i) c += __builtin_popcountll(__ballot(u[i] > Tk)); }
                need = 256 - c; }
            int base = 0;
            if (exact) {
    #pragma unroll
                for (int gi = 0; gi < 8; ++gi) if (gi * 16 < nreg) {
    #pragma unroll
                    for (int i = gi * 16; i < gi * 16 + 16; ++i) {
                        const bool s = u[i] >= Tk; const unsigned long long sb = __ballot(s);
                        if (s) lst[base + (int)__builtin_amdgcn_mbcnt_hi((unsigned)(sb >> 32), __builtin_amdgcn_mbcnt_lo((unsigned)sb, 0u))] = lane + 64 * i;
                        base += __builtin_popcountll(sb);
                    } }
            } else {
                int eq_taken = 0;
    #pragma unroll
                for (int gi = 0; gi < 8; ++gi) if (gi * 16 < nreg) {
    #pragma unroll
                    for (int i = gi * 16; i < gi * 16 + 16; ++i) {
                        const bool eq = u[i] == Tk; const unsigned long long eb = __ballot(eq);
                        const int rank = eq_taken + __builtin_popcountll(eb & ((1ull << lane) - 1ull)); eq_taken += __builtin_popcountll(eb);
                        const bool s = (u[i] > Tk) || (eq && rank < need);
                        const unsigned long long sb = __ballot(s);
                        if (s) { const int pos = base + __builtin_popcountll(sb & ((1ull << lane) - 1ull)); if (pos < 256) lst[pos] = lane + 64 * i; }
                        base += __builtin_popcountll(sb);
                    } }
            }
        }
        LDS_WAIT(); asm volatile("" ::: "memory");
        *(GAS u32x4*)(out + 4 * lane) = *(const LAS u32x4*)(lst + 4 * lane);
        LDS_WAIT(); asm volatile("" ::: "memory");
    }
}

__device__ __forceinline__ void quad_barrier(volatile LAS unsigned* cnt, unsigned& epoch, int lane) {
    asm volatile("s_waitcnt lgkmcnt(0)" ::: "memory");
    epoch += 4u;
    if (lane == 0) __hip_atomic_fetch_add((LAS unsigned*)cnt, 1u, __ATOMIC_RELAXED, __HIP_MEMORY_SCOPE_WORKGROUP);
    for (unsigned sp = 0; __builtin_amdgcn_readfirstlane(*cnt) < epoch && sp < (1u << 24); ++sp) __builtin_amdgcn_s_sleep(1);
    asm volatile("" ::: "memory");
}
__device__ __forceinline__ void quad_signal(volatile LAS unsigned* cnt4, int qt, unsigned value, int lane) {
    asm volatile("s_waitcnt lgkmcnt(0)" ::: "memory");
    if (lane == 0) cnt4[qt] = value;
}
__device__ __forceinline__ void quad_wait(volatile LAS unsigned* cnt4, unsigned target) {
    for (unsigned sp = 0; sp < (1u << 24); ++sp) {
        const u32x4 v = *(const volatile LAS u32x4*)cnt4;
        unsigned mn = v.x < v.y ? v.x : v.y; const unsigned m2 = v.z < v.w ? v.z : v.w; mn = mn < m2 ? mn : m2;
        if ((int)((unsigned)__builtin_amdgcn_readfirstlane(mn) - target) >= 0) break;
        __builtin_amdgcn_s_sleep(1); }
    asm volatile("" ::: "memory");
}
namespace dsa {
constexpr int OFF_ROWS = 0, OFF_XCH = 65536, OFF_SEL = OFF_XCH + 32768, OFF_LUT = OFF_SEL + 4096, OFF_AL = OFF_LUT + 129 * 16 * 4 + 64, OFF_QB = OFF_AL + 8 * 64 * 4, LDS_END = OFF_QB + 64;
__device__ __forceinline__ unsigned off_a(unsigned row, unsigned ch) { return 2048u * (row >> 3) + 512u * (ch >> 2) + 64u * (row & 7) + 16u * ((ch & 3) ^ ((row >> 2) & 3)); }
}
#ifndef SATTN_LMAP
#define SATTN_LMAP 1
#endif
template <int V>
__device__ __forceinline__ void phase_sattn(const Ctx& F, const float* tab, unsigned char* OL) {
    using namespace dsa;
    const bf16_t* CKV = (const bf16_t*)(F.ws + B1_CKVN); const bf16_t* QL = (const bf16_t*)(F.ws + B1_QLAT); const int* SEL = (const int*)(F.ws + SM_SEL);
    const int lane = F.lane, wid = F.wave, l15 = lane & 15, q4 = lane >> 4, slot = wid >> 2, qt = wid & 3;
    char* lds = (char*)F.ldsg;
    char* rows = lds + OFF_ROWS + wid * 8192;
    float* lut = (float*)(lds + OFF_LUT); float* alw = (float*)(lds + OFF_AL) + wid * 64;
    for (int i = F.tid; i < 129 * 16; i += NTHREADS) lut[i] = tab[rel_bucket_dev(i >> 4) * 16 + (i & 15)] * LOG2E;
    unsigned st_addr[2][4];
#pragma unroll
    for (int c = 0; c < 2; ++c)
#pragma unroll
        for (int s = 0; s < 4; ++s) st_addr[c][s] = off_a(8u * (l15 >> 2) + 4u * c + (l15 & 3), 4u * s + q4);
    unsigned wr_addr[2];
#if SATTN_LMAP == 2
#define WR_IMM(s_) (4096 * ((s_) >> 1) + 1024 * ((s_) & 1))
#pragma unroll
    for (int c = 0; c < 2; ++c) { const unsigned nl = lane >> 3; wr_addr[c] = off_a(8u * (nl >> 2) + 4u * c + (nl & 3), lane & 7); }
#else
#define WR_IMM(s_) (512 * (s_))
#pragma unroll
    for (int c = 0; c < 2; ++c) { const unsigned nl = lane >> 2; wr_addr[c] = off_a(8u * (nl >> 2) + 4u * c + (nl & 3), lane & 3); }
#endif
    unsigned tr_base[2][2];
    { const unsigned q = (lane & 15) >> 2, p = lane & 3;
#pragma unroll
      for (int c1 = 0; c1 < 2; ++c1)
#pragma unroll
          for (int t = 0; t < 2; ++t) tr_base[c1][t] = (unsigned)(uintptr_t)rows + off_a(8u * q4 + 4u * t + q, 2u * c1 + (p >> 1)) + 8u * (p & 1); }
    __syncthreads();
    volatile LAS unsigned* pcnt = (volatile LAS unsigned*)(F.lds + OFF_QB) + slot * 8; volatile LAS unsigned* ccnt = pcnt + 4;
    if (F.tid < 16) ((LAS unsigned*)(F.lds + OFF_QB))[F.tid] = 0u;
    const int per = (M + F.G - 1) / F.G;
    int* sellb = (int*)(lds + OFF_SEL);
    bf16x8 bq[4];
    const bool xmap = (F.G == 256) && (per == 64);
    const int xb = (F.bid >> 2) & 1, xj = ((F.bid >> 3) << 2) | (F.bid & 3);
#define QUERY_OF(it_) (xmap ? (xb * T + ((it_) + slot) * 128 + xj) : (F.bid * per + (it_) + slot))
    { const int m0 = QUERY_OF(0); const int mm0 = m0 < M ? m0 : M - 1;
      if (qt == 0) *(u32x4*)(sellb + slot * 256 + 4 * lane) = *(const u32x4*)(SEL + (size_t)mm0 * 256 + 4 * lane);
#pragma unroll
      for (int s = 0; s < 4; ++s) bq[s] = *(const bf16x8*)(QL + (size_t)mm0 * 8192 + l15 * 512 + qt * 128 + 32 * s + 8 * q4); }
    __syncthreads();
    if (slot == 1) { for (int i = 0; i < 12; ++i) __builtin_amdgcn_s_sleep(64); }
    for (int it = 0; it < per; it += 2) {
        const int par = (it >> 1) & 1;
        const int m = QUERY_OF(it); const bool live = m < M;
        const int mm = live ? m : M - 1; const int b = mm >> 13, t = mm & 8191;
        const int* sell = sellb + (par * 2 + slot) * 256;
        int mn = QUERY_OF(it + 2); if (it + 2 >= per || mn >= M) mn = mm;
        u32x4 seln = {0u, 0u, 0u, 0u}; bf16x8 bqn[4];
        bf16x8 afn[2][4];
#if SATTN_LMAP == 2
#define LOAD_ROWS(dst, step_) do { _Pragma("unroll") for (int c = 0; c < 2; ++c) { _Pragma("unroll") for (int h2 = 0; h2 < 2; ++h2) { int kidx = sell[(step_) * 32 + c * 16 + 8 * h2 + (lane >> 3)]; kidx = kidx < 0 ? 0 : kidx; \
            const bf16_t* rp = CKV + ((size_t)b * T + kidx) * 512 + qt * 128 + 8 * (lane & 7); dst[c][2 * h2] = *(const bf16x8*)rp; dst[c][2 * h2 + 1] = *(const bf16x8*)(rp + 64); } } } while (0)
#else
#define LOAD_ROWS(dst, step_) do { _Pragma("unroll") for (int c = 0; c < 2; ++c) { int kidx = sell[(step_) * 32 + c * 16 + (lane >> 2)]; kidx = kidx < 0 ? 0 : kidx; \
            const bf16_t* rp = CKV + ((size_t)b * T + kidx) * 512 + qt * 128 + 8 * (lane & 3); _Pragma("unroll") for (int s = 0; s < 4; ++s) dst[c][s] = *(const bf16x8*)(rp + 32 * s); } } while (0)
#endif
        LOAD_ROWS(afn, 0);
        f32x4 o[8];
#pragma unroll
        for (int cb = 0; cb < 8; ++cb) o[cb] = (f32x4){0.f, 0.f, 0.f, 0.f};
        float m_run = -1e30f, l_run = 0.f;
        s16x4 v0[8], v1[8];
        const unsigned gbase = (unsigned)(it >> 1) * 8u;
#pragma unroll 1
        for (int step = 0; step <= 8; ++step) {
            if (step < 8) {
#pragma unroll
                for (int c = 0; c < 2; ++c)
#pragma unroll
                    for (int s = 0; s < 4; ++s) *(bf16x8*)(rows + wr_addr[c] + WR_IMM(s)) = afn[c][s];
                if (step < 7) LOAD_ROWS(afn, step + 1);
                if (step == 6) {
                    if (qt == 0) seln = *(const u32x4*)(SEL + (size_t)mn * 256 + 4 * lane);
#pragma unroll
                    for (int s = 0; s < 4; ++s) bqn[s] = *(const bf16x8*)(QL + (size_t)mn * 8192 + l15 * 512 + qt * 128 + 32 * s + 8 * q4); }
                f32x4 sp[2]; bf16x8 af[2][4];
#pragma unroll
                for (int c = 0; c < 2; ++c) { sp[c] = (f32x4){0.f, 0.f, 0.f, 0.f};
#pragma unroll
                    for (int s = 0; s < 4; ++s) af[c][s] = *(const bf16x8*)(rows + st_addr[c][s]);
#pragma unroll
                    for (int s = 0; s < 4; ++s) sp[c] = __builtin_amdgcn_mfma_f32_16x16x32_bf16(af[c][s], bq[s], sp[c], 0, 0, 0); }
                const unsigned g = gbase + (unsigned)step;
                if (g >= 2u) quad_wait(ccnt, g - 1u);
                if (step == 7 && qt == 0) *(u32x4*)(sellb + ((par ^ 1) * 2 + slot) * 256 + 4 * lane) = seln;
                f32x4* xch = (f32x4*)(lds + OFF_XCH) + (size_t)(step & 1) * 1024;
                xch[(wid * 2 + 0) * 64 + lane] = sp[0]; xch[(wid * 2 + 1) * 64 + lane] = sp[1];
                quad_signal(pcnt, qt, g + 1u, lane);
            }
            if (step > 0) {
                const int ps = step - 1;
                quad_wait(pcnt, gbase + (unsigned)ps + 1u);
                const f32x4* xch = (const f32x4*)(lds + OFF_XCH) + (size_t)(ps & 1) * 1024;
                f32x4 st[2];
#pragma unroll
                for (int c = 0; c < 2; ++c) { st[c] = xch[((slot * 4 + 0) * 2 + c) * 64 + lane] + xch[((slot * 4 + 1) * 2 + c) * 64 + lane] + xch[((slot * 4 + 2) * 2 + c) * 64 + lane] + xch[((slot * 4 + 3) * 2 + c) * 64 + lane]; }
                quad_signal(ccnt, qt, gbase + (unsigned)ps + 1u, lane);
                float pmax = -__builtin_inff();
#pragma unroll
                for (int c = 0; c < 2; ++c) { const u32x4 kk = *(const u32x4*)(sell + ps * 32 + c * 16 + 4 * q4);
                    float bv[4];
#pragma unroll
                    for (int j = 0; j < 4; ++j) { int d = t - (int)kk[j]; d = d < 0 ? 0 : (d > 128 ? 128 : d); bv[j] = lut[d * 16 + l15]; }
                    asm volatile("" : "+v"(bv[0]), "+v"(bv[1]), "+v"(bv[2]), "+v"(bv[3]));
#pragma unroll
                    for (int j = 0; j < 4; ++j) { const int kidx = (int)kk[j]; const bool ok = (kidx >= 0) && (kidx <= t);
                        const float v = ok ? st[c][j] + bv[j] : -__builtin_inff(); st[c][j] = v; pmax = fmaxf(pmax, v); } }
                { auto r16 = __builtin_amdgcn_permlane16_swap(__float_as_uint(pmax), __float_as_uint(pmax), false, false); pmax = fmaxf(__uint_as_float(r16[0]), __uint_as_float(r16[1]));
                  auto r32 = __builtin_amdgcn_permlane32_swap(__float_as_uint(pmax), __float_as_uint(pmax), false, false); pmax = fmaxf(__uint_as_float(r32[0]), __uint_as_float(r32[1])); }
                float alpha = 1.f;
                if (!__all((pmax - m_run) <= att::THR2)) { const float mnew = fmaxf(m_run, pmax); alpha = __builtin_amdgcn_exp2f(m_run - mnew); m_run = mnew;
                    if (q4 == 0) alw[l15] = alpha;
                    LDS_WAIT(); asm volatile("" ::: "memory");
                    const f32x4 a4 = *(const f32x4*)(alw + 4 * q4);
#pragma unroll
                    for (int cb = 0; cb < 8; ++cb) o[cb] = o[cb] * a4; }
                float ps_ = 0.f; unsigned pk[4];
#pragma unroll
                for (int c = 0; c < 2; ++c) { float p0 = __builtin_amdgcn_exp2f(st[c][0] - m_run), p1 = __builtin_amdgcn_exp2f(st[c][1] - m_run), p2 = __builtin_amdgcn_exp2f(st[c][2] - m_run), p3 = __builtin_amdgcn_exp2f(st[c][3] - m_run);
                    ps_ += (p0 + p1) + (p2 + p3); pk[2 * c] = cvt_pk_bf16(p0, p1); pk[2 * c + 1] = cvt_pk_bf16(p2, p3); }
                l_run = l_run * alpha + ps_;
                const u32x4 pw = {pk[0], pk[1], pk[2], pk[3]}; const bf16x8 pa = *reinterpret_cast<const bf16x8*>(&pw);
                asm volatile("s_waitcnt lgkmcnt(0)" ::: "memory");
#pragma unroll
                for (int cb = 0; cb < 8; ++cb)
                    o[cb] = __builtin_amdgcn_mfma_f32_16x16x32_bf16(pa, (bf16x8){v0[cb][0], v0[cb][1], v0[cb][2], v0[cb][3], v1[cb][0], v1[cb][1], v1[cb][2], v1[cb][3]}, o[cb], 0, 0, 0);
            }
            if (step < 8) {
#pragma unroll
                for (int cb = 0; cb < 8; ++cb) {
                    asm volatile("ds_read_b64_tr_b16 %0, %1 offset:%2" : "=&v"(v0[cb]) : "v"(tr_base[cb & 1][0]), "i"(512 * (cb >> 1)) : "memory");
                    asm volatile("ds_read_b64_tr_b16 %0, %1 offset:%2" : "=&v"(v1[cb]) : "v"(tr_base[cb & 1][1]), "i"(512 * (cb >> 1)) : "memory"); }
            }
        }
#undef LOAD_ROWS
        float l = l_run;
        { auto r16 = __builtin_amdgcn_permlane16_swap(__float_as_uint(l), __float_as_uint(l), false, false); l = __uint_as_float(r16[0]) + __uint_as_float(r16[1]);
          auto r32 = __builtin_amdgcn_permlane32_swap(__float_as_uint(l), __float_as_uint(l), false, false); l = __uint_as_float(r32[0]) + __uint_as_float(r32[1]); }
        if (q4 == 0) alw[16 + l15] = 1.0f / l;
        LDS_WAIT(); asm volatile("" ::: "memory");
        const f32x4 r4 = *(const f32x4*)(alw + 16 + 4 * q4);
        if (live) {
#pragma unroll
            for (int cb = 0; cb < 8; ++cb)
#pragma unroll
                for (int e = 0; e < 4; ++e) { const float v = o[cb][e] * (r4[e] * 16.0f); const float v1_ = pg8::quad_xor1(v), v2_ = pg8::quad_xor2(v), v3_ = pg8::quad_xor3(v);
                    if ((lane & 3) == 0) *(unsigned*)(OL + (size_t)m * 8192 + (4 * q4 + e) * 512 + qt * 128 + 16 * cb + l15) = pg8::pk4_fp8(v, v1_, v2_, v3_); }
        }
#pragma unroll
        for (int s = 0; s < 4; ++s) bq[s] = bqn[s];
    }
    __syncthreads();
}
#ifndef MK_PER_PHASE
#define MK_PER_PHASE 0
#endif
constexpr int NPHASE = 22;
#ifndef REPEAT_MASK
#define REPEAT_MASK 0ull
#endif
#define REP(k) ((int)(((unsigned long long)(REPEAT_MASK) >> (k)) & 1ull))
__global__ void __launch_bounds__(NTHREADS, 2) fwd(Args args) {
    extern __shared__ __attribute__((aligned(16))) unsigned char lds_raw[];
    const int wave_s = __builtin_amdgcn_readfirstlane((int)threadIdx.x >> 6);
#define MKCTX(F) Ctx F; { int t_ = (int)__builtin_amdgcn_mbcnt_hi(~0u, __builtin_amdgcn_mbcnt_lo(~0u, 0u)); asm volatile("" : "+v"(t_)); t_ |= wave_s << 6; F.lds = (LAS unsigned char*)lds_raw; F.ldsg = lds_raw; F.ws = args.ws; F.out = args.out; \
        F.tid = t_; F.lane = t_ & 63; F.wave = __builtin_amdgcn_readfirstlane(t_ >> 6); F.G = gridDim.x; F.bid = blockIdx.x; }
    volatile LAS unsigned* MISC = (volatile LAS unsigned*)((LAS unsigned char*)lds_raw + MISC_OFF);
    for (int u = (int)threadIdx.x; u < (LDS_BYTES - MISC_OFF) / 4; u += NTHREADS) ((LAS unsigned*)((LAS unsigned char*)lds_raw + MISC_OFF))[u] = 0u;
    __syncthreads();
    const int lo = args.ph_lo, hi = args.ph_hi;
    XcdBarrier bar; bar.bar = (unsigned*)(args.ws + WS_CTL) + CW_BAR; bar.x = 0; bar.st = nullptr;
    #define LEADER() (wave_s == 0 && __builtin_amdgcn_mbcnt_hi(~0u, __builtin_amdgcn_mbcnt_lo(~0u, 0u)) == 0u)
    if (hi - lo > 1) bar = xcd_barrier_post((unsigned*)(args.ws + WS_CTL) + CW_BAR, MISC + 8, LEADER());
#ifdef ONLY_PHASE
#define IN(k) ((k) == ONLY_PHASE && lo <= (k) && (k) < hi)
#else
#define IN(k) (lo <= (k) && (k) < hi)
#endif
#define SEAM(k) do { if (IN(k) && IN((k) + 1)) xcd_barrier(bar, LEADER()); } while (0)
    unsigned char* ws = args.ws;
    bf16_t* XB = (bf16_t*)(ws + WS_XB);

    if (IN(0)) for (int rep_ = 0; rep_ <= REP(0); ++rep_) { if (rep_) xcd_barrier(bar, LEADER()); MKCTX(F); const ProIn I{args.in[0], args.in[2], args.in[3], args.in[4], args.in[7], args.in[8], args.in[9], args.in[12], args.in[15], args.in[16], args.in[17], args.in[18], args.in[19], args.in[23], args.in[24], args.in[25]}; phase_prologue(F, I); } SEAM(0);
    if (IN(1)) for (int rep_ = 0; rep_ <= REP(1); ++rep_) { if (rep_) xcd_barrier(bar, LEADER()); MKCTX(F);
        pg8::Gemm g{XB, (const bf16_t*)(ws + WS_WIN0), 2048, 2048, 2048}; pg8::PlainSched S; S.init(M / 256, NQKV0 / 256, F.G, F.bid); S.akstep = 0;
        pg8::EpiQKV0 E{(bf16_t*)(ws + B0_QKV)}; pg8::gemm_phase(F.lds, g, S, E, F.tid); } SEAM(1);
    if (IN(2)) for (int rep_ = 0; rep_ <= REP(2); ++rep_) { if (rep_) xcd_barrier(bar, LEADER()); MKCTX(F); phase_pre0(F); } SEAM(2);
    if (IN(3)) { for (int rep_ = 0; rep_ <= REP(3); ++rep_) { if (rep_) xcd_barrier(bar, LEADER()); MKCTX(F); phase_attn0_moba(F, args.in[1]); } for (int rep_ = 0; rep_ <= REP(22); ++rep_) { if (rep_) xcd_barrier(bar, LEADER()); MKCTX(F); phase_attn0_fox(F); } } SEAM(3);
    if (IN(4)) for (int rep_ = 0; rep_ <= REP(4); ++rep_) { if (rep_) xcd_barrier(bar, LEADER()); MKCTX(F);
        pg8::Gemm g{(const bf16_t*)(ws + B0_O), (const bf16_t*)(ws + WS_WOUT0), 1024, 1024, 1024}; pg8::PlainSched S; S.init(M / 256, DM / 256, F.G, F.bid); S.akstep = 0;
        pg8::EpiResF32 E{args.in[0], args.out, DM, ALPHA, 1.0f / 1024.0f}; pg8::gemm_phase<pg8::EpiResF32, pg8::PlainSched, true>(F.lds, g, S, E, F.tid); } SEAM(4);
    if (IN(5)) for (int rep_ = 0; rep_ <= REP(5); ++rep_) { if (rep_) xcd_barrier(bar, LEADER()); MKCTX(F); phase_ln<true>(F, args.in[5], args.in[6]); } SEAM(5);
    if (IN(6)) for (int rep_ = 0; rep_ <= REP(6); ++rep_) { if (rep_) xcd_barrier(bar, LEADER()); MKCTX(F);
        pg8::Gemm g{XB, (const bf16_t*)(ws + WS_WFF13), 1024, 1024, 1024}; pg8::PlainSched S; S.init(M / 256, 2 * FF0 / 256, F.G, F.bid); S.akstep = 0;
        pg8::EpiSwiGLU8 E{ws + B0_ACT, FF0}; pg8::gemm_phase<pg8::EpiSwiGLU8, pg8::PlainSched, true>(F.lds, g, S, E, F.tid); } SEAM(6);
    if (IN(7)) for (int rep_ = 0; rep_ <= REP(7); ++rep_) { if (rep_) xcd_barrier(bar, LEADER()); MKCTX(F);
        pg8::Gemm g{(const bf16_t*)(ws + B0_ACT), (const bf16_t*)(ws + WS_WFF2), FF0 / 2, FF0 / 2, FF0 / 2}; pg8::PlainSched S; S.init(M / 256, DM / 256, F.G, F.bid); S.akstep = 0;
        pg8::EpiResLnF32 E{args.out, args.out, DM, ALPHA, 1.0f / 512.0f, (const float*)(ws + SM_STAT), args.in[5], args.in[6]}; pg8::gemm_phase<pg8::EpiResLnF32, pg8::PlainSched, true>(F.lds, g, S, E, F.tid); } SEAM(7);
    if (IN(8)) for (int rep_ = 0; rep_ <= REP(8); ++rep_) { if (rep_) xcd_barrier(bar, LEADER()); MKCTX(F); phase_ln<false>(F, args.in[10], args.in[11]); } SEAM(8);
    if (IN(9)) for (int rep_ = 0; rep_ <= REP(9); ++rep_) { if (rep_) xcd_barrier(bar, LEADER()); MKCTX(F);
        pg8::Gemm g{XB, (const bf16_t*)(ws + WS_WIN1), 2048, 2048, 2048}; pg8::PlainSched S; S.init(M / 256, NIN1P / 256, F.G, F.bid); S.akstep = 0;
        pg8::EpiF32 E{(float*)(ws + B1_PROJ), NIN1P}; pg8::gemm_phase(F.lds, g, S, E, F.tid); } SEAM(9);
    if (IN(10)) for (int rep_ = 0; rep_ <= REP(10); ++rep_) { if (rep_) xcd_barrier(bar, LEADER()); MKCTX(F); phase_norm1(F, args.in[13], args.in[14]); } SEAM(10);
    if (IN(11)) for (int rep_ = 0; rep_ <= REP(11); ++rep_) { if (rep_) xcd_barrier(bar, LEADER()); MKCTX(F);
        pg8::Gemm g{(const bf16_t*)(ws + B1_CQN), (const bf16_t*)(ws + WS_WQ1), 512, 512, 512}; pg8::PlainSched S; S.init(M / 256, NQ1 / 256, F.G, F.bid); S.akstep = 0;
        pg8::EpiBf16 E{(bf16_t*)(ws + B1_QLAT), 8192, 8192, (bf16_t*)(ws + B1_QIDX), 1024}; pg8::gemm_phase(F.lds, g, S, E, F.tid); } SEAM(11);
    if (IN(12)) for (int rep_ = 0; rep_ <= REP(12); ++rep_) { if (rep_) xcd_barrier(bar, LEADER()); MKCTX(F); phase_index(F, (float*)(ws + B1_SC)); } SEAM(12);
    if (IN(13)) { MKCTX(F); phase_topk(F, 1 + REP(13)); } SEAM(13);
    if (IN(14)) for (int rep_ = 0; rep_ <= REP(14); ++rep_) { if (rep_) xcd_barrier(bar, LEADER()); MKCTX(F); phase_sattn<0>(F, args.in[1], ws + B1_SC); }
#ifdef SATTN_PROBE
    if (IN(14)) { xcd_barrier(bar, LEADER()); MKCTX(F); phase_sattn<SATTN_PROBE>(F, args.in[1], ws + B1_SC); }
#endif
    SEAM(14);
    if (IN(15)) for (int rep_ = 0; rep_ <= REP(15); ++rep_) { if (rep_) xcd_barrier(bar, LEADER()); MKCTX(F);
        pg8::Gemm g{(const bf16_t*)(ws + B1_SC), (const bf16_t*)(ws + WS_WUV), 4096, 512, 512}; pg8::PlainSched S; S.init(M / 256, DM / 256, F.G, F.bid); S.akstep = 512;
        pg8::Epi8 E{ws + B1_OB, DM, 1.0f / 64.0f}; pg8::gemm_phase<pg8::Epi8, pg8::PlainSched, true>(F.lds, g, S, E, F.tid); } SEAM(15);
    if (IN(16)) for (int rep_ = 0; rep_ <= REP(16); ++rep_) { if (rep_) xcd_barrier(bar, LEADER()); MKCTX(F);
        pg8::Gemm g{(const bf16_t*)(ws + B1_OB), (const bf16_t*)(ws + WS_WOUT1), 1024, 1024, 1024}; pg8::PlainSched S; S.init(M / 256, DM / 256, F.G, F.bid); S.akstep = 0;
        pg8::EpiResLnF32 E{args.out, args.out, DM, ALPHA, 1.0f / 1024.0f, (const float*)(ws + SM_STAT), args.in[10], args.in[11]}; pg8::gemm_phase<pg8::EpiResLnF32, pg8::PlainSched, true>(F.lds, g, S, E, F.tid); } SEAM(16);
    if (IN(17)) for (int rep_ = 0; rep_ <= REP(17); ++rep_) { if (rep_) xcd_barrier(bar, LEADER()); MKCTX(F); phase_ln_router(F, args.in[20], args.in[21], args.in[22]); } SEAM(17);
    if (IN(18)) for (int rep_ = 0; rep_ <= REP(18); ++rep_) { if (rep_) xcd_barrier(bar, LEADER()); MKCTX(F); phase_gather(F); } SEAM(18);
    if (IN(19)) for (int rep_ = 0; rep_ <= REP(19); ++rep_) { if (rep_) xcd_barrier(bar, LEADER()); MKCTX(F);
        int ts_[9]; moe_tstart(F, ts_); pg8::MoeSched S; S.set_tstart(ts_); S.brows = 2 * FFE; S.init(ts_[8], 2 * FFE / 256, F.G, F.bid);
        pg8::Gemm g{(const bf16_t*)(ws + B1_XG), (const bf16_t*)(ws + WS_WE13), 1024, 1024, 1024};
        pg8::EpiSwiGLU8 E{ws + B1_H, FFE}; pg8::gemm_phase<pg8::EpiSwiGLU8, pg8::MoeSched, true>(F.lds, g, S, E, F.tid); } SEAM(19);
    if (IN(20)) for (int rep_ = 0; rep_ <= REP(20); ++rep_) { if (rep_) xcd_barrier(bar, LEADER()); MKCTX(F);
        int ts_[9]; moe_tstart(F, ts_); pg8::MoeSplitSched S; S.set_tstart(ts_); S.brows = DM; S.init2(ts_[8], DM / 256, F.G, F.bid, FFE / 128);
        pg8::Gemm g{(const bf16_t*)(ws + B1_H), (const bf16_t*)(ws + WS_WE2), FFE / 2, FFE / 2, FFE / 2};
        pg8::EpiYSlab E{(bf16_t*)(ws + B1_Y), DM, (float*)(ws + B1_SLAB), (unsigned*)(ws + WS_CTL) + CW_FLAG, DM / 256, S.S, 1.0f / 512.0f}; pg8::gemm_phase<pg8::EpiYSlab, pg8::MoeSplitSched, true>(F.lds, g, S, E, F.tid); } SEAM(20);
    if (IN(21)) for (int rep_ = 0; rep_ <= REP(21); ++rep_) { if (rep_) xcd_barrier(bar, LEADER()); MKCTX(F); int ts_[9]; moe_tstart(F, ts_); phase_final(F, args.in[26], args.in[27], pg8::split_factor(ts_[8] * (DM / 256), F.G, FFE / 128), args.in[20], args.in[21]); }
#undef IN
#undef SEAM
}

extern "C" void kernel_launch(void* const* d_in, const int* in_sizes, int n_in, void* d_out, int out_size, void* d_ws, size_t ws_size, hipStream_t stream) {
    static int grid = 0;
    if (grid == 0) {
        if (n_in != 28 || out_size != M * DM || ws_size < WS_NEED) { fprintf(stderr, "kernel_launch: unexpected shapes (n_in %d, out %d, ws %zu < %zu)\n", n_in, out_size, ws_size, (size_t)WS_NEED); grid = -1; return; }
        int dev = 0, cus = 0, per_cu = 0;
        if (hipGetDevice(&dev) != hipSuccess || hipDeviceGetAttribute(&cus, hipDeviceAttributeMultiprocessorCount, dev) != hipSuccess) { grid = -1; return; }
        if (hipFuncSetAttribute((const void*)fwd, hipFuncAttributeMaxDynamicSharedMemorySize, LDS_BYTES) != hipSuccess) { fprintf(stderr, "kernel_launch: hipFuncSetAttribute failed\n"); grid = -1; return; }
        if (hipOccupancyMaxActiveBlocksPerMultiprocessor(&per_cu, (const void*)fwd, NTHREADS, LDS_BYTES) != hipSuccess || per_cu < 1) fprintf(stderr, "kernel_launch: occupancy query reports %d\n", per_cu);
        (void)hipGetLastError();
        grid = cus;
    }
    if (grid < 0) return;
    if (hipMemsetAsync((char*)d_ws + WS_CTL, 0, CTL_ZERO_BYTES, stream) != hipSuccess) return;
    Args a{};
    for (int i = 0; i < 28; ++i) a.in[i] = (const float*)d_in[i];
    a.out = (float*)d_out; a.ws = (unsigned char*)d_ws;
#if MK_PER_PHASE
    for (int p = 0; p < NPHASE; ++p) { a.ph_lo = p; a.ph_hi = p + 1; hipLaunchKernelGGL(fwd, dim3(grid), dim3(NTHREADS), LDS_BYTES, stream, a); }
#else
    a.ph_lo = 0; a.ph_hi = NPHASE; hipLaunchKernelGGL(fwd, dim3(grid), dim3(NTHREADS), LDS_BYTES, stream, a);
#endif
}
```

```cpp
#include <hip/hip_runtime.h>
#include <cstdint>
#include <cstdio>

#define GAS __attribute__((address_space(1)))
#define LAS __attribute__((address_space(3)))
typedef unsigned short bf16_t;
typedef short bf16x8 __attribute__((ext_vector_type(8)));
typedef short s16x4 __attribute__((ext_vector_type(4)));
typedef float f32x2 __attribute__((ext_vector_type(2)));
typedef float f32x4 __attribute__((ext_vector_type(4)));
typedef float f32x16 __attribute__((ext_vector_type(16)));
typedef unsigned u32x2 __attribute__((ext_vector_type(2)));
typedef unsigned u32x4 __attribute__((ext_vector_type(4)));
typedef GAS unsigned gu32;
#define RLX_AGENT __ATOMIC_RELAXED, __HIP_MEMORY_SCOPE_AGENT
#define LDS_WAIT() asm volatile("s_waitcnt lgkmcnt(0)" ::: "memory")
#define VM_WAIT() asm volatile("s_waitcnt vmcnt(0)" ::: "memory")
#define SBAR() __builtin_amdgcn_sched_barrier(0)

__device__ __forceinline__ unsigned cvt_pk_bf16(float lo, float hi) { unsigned r; asm volatile("v_cvt_pk_bf16_f32 %0, %1, %2" : "=v"(r) : "v"(lo), "v"(hi)); return r; }
__device__ __forceinline__ unsigned f2bf(float f) { unsigned u = __builtin_bit_cast(unsigned, f); return (u + 0x7fffu + ((u >> 16) & 1u)) >> 16; }
__device__ __forceinline__ unsigned pk2(float lo, float hi) { return f2bf(lo) | (f2bf(hi) << 16); }
__device__ __forceinline__ float bf2f(unsigned short b) { return __builtin_bit_cast(float, ((unsigned)b) << 16); }
__device__ __forceinline__ float bflo(unsigned w) { return __builtin_bit_cast(float, w << 16); }
__device__ __forceinline__ float bfhi(unsigned w) { return __builtin_bit_cast(float, w & 0xffff0000u); }
#define WAVE_DPP(v, ctrl) __builtin_bit_cast(float, __builtin_amdgcn_mov_dpp(__builtin_bit_cast(int, v), ctrl, 0xF, 0xF, true))
#define WAVE_DPP_ROWS(old_, v, ctrl, rmask) __builtin_bit_cast(float, __builtin_amdgcn_update_dpp(__builtin_bit_cast(int, old_), __builtin_bit_cast(int, v), ctrl, rmask, 0xF, false))
__device__ __forceinline__ float wave_sum(float v) {
    v += WAVE_DPP(v, 0xB1);
    v += WAVE_DPP(v, 0x4E);
    v += WAVE_DPP(v, 0x141);
    v += WAVE_DPP(v, 0x140);
    v += WAVE_DPP_ROWS(0.0f, v, 0x142, 0xA);
    v += WAVE_DPP_ROWS(0.0f, v, 0x143, 0xC);
    return __builtin_bit_cast(float, __builtin_amdgcn_readlane(__builtin_bit_cast(int, v), 63));
}
__device__ __forceinline__ float wave_max(float v) {
    v = fmaxf(v, WAVE_DPP(v, 0xB1)); v = fmaxf(v, WAVE_DPP(v, 0x4E)); v = fmaxf(v, WAVE_DPP(v, 0x141)); v = fmaxf(v, WAVE_DPP(v, 0x140));
    v = fmaxf(v, WAVE_DPP_ROWS(v, v, 0x142, 0xA)); v = fmaxf(v, WAVE_DPP_ROWS(v, v, 0x143, 0xC));
    return __builtin_bit_cast(float, __builtin_amdgcn_readlane(__builtin_bit_cast(int, v), 63));
}

#define XB_TMO      128
#define XB_XCNT(j)  (256  + 64 * (j))
#define XB_XSUB(j)  (1280 + 64 * (j))
#define XB_XGEN(j)  (2304 + 64 * (j))
#define XB_TOP      3328
#define XB_TOPGEN   3392
#define XCD_BAR_WORDS 3456
#define XB_SPIN_CAP (1u << 18)
__device__ __forceinline__ unsigned xb_ld(unsigned* p)              { return __hip_atomic_load(p, __ATOMIC_RELAXED, __HIP_MEMORY_SCOPE_AGENT); }
__device__ __forceinline__ unsigned xb_add(unsigned* p, unsigned v) { return __hip_atomic_fetch_add(p, v, __ATOMIC_RELAXED, __HIP_MEMORY_SCOPE_AGENT); }
__device__ __forceinline__ unsigned xb_xcc_id() { return (unsigned)__builtin_amdgcn_s_getreg((3 << 11) | 20) & 0xFu; }
#define XB_SPIN(cond, bar) do { unsigned _sp = 0; while (cond) { __builtin_amdgcn_s_sleep(1); \
    if ((++_sp & 255u) == 0u) { if (xb_ld(&(bar)[XB_TMO])) break; if (_sp > XB_SPIN_CAP) { atomicAdd(&(bar)[XB_TMO], 1u); break; } } } } while (0)
struct XcdBarrier { unsigned* bar; unsigned x; volatile LAS unsigned* st; };
__device__ __forceinline__ XcdBarrier xcd_barrier_post(unsigned* bar, volatile LAS unsigned* st, bool leader) {
    XcdBarrier b; b.bar = bar; b.x = xb_xcc_id(); b.st = st;
    if (leader) (void)xb_add(&bar[XB_XCNT(b.x)], 1u);
    return b;
}
__device__ __forceinline__ void xcd_barrier_complete(unsigned* bar, unsigned x, unsigned& nloc, unsigned& nx) {
    const unsigned G = gridDim.x * gridDim.y * gridDim.z;
    unsigned sum, cnt, mine, sp = 0u;
    for (;;) {
        sum = 0u; cnt = 0u; mine = 0u;
#pragma unroll
        for (unsigned j = 0; j < 16; ++j) { const unsigned c = xb_ld(&bar[XB_XCNT(j)]); sum += c; cnt += (c > 0u) ? 1u : 0u; mine = (j == x) ? c : mine; }
        if (sum == G) break;
        __builtin_amdgcn_s_sleep(1);
        if ((++sp & 255u) == 0u) { if (xb_ld(&bar[XB_TMO])) break; if (sp > XB_SPIN_CAP) { atomicAdd(&bar[XB_TMO], 1u); break; } }
    }
    nloc = mine > 0u ? mine : 1u; nx = cnt > 0u ? cnt : 1u;
}
__device__ __forceinline__ void xcd_barrier(const XcdBarrier& b, bool leader) {
    asm volatile("s_waitcnt vmcnt(0)" ::: "memory");
    __syncthreads();
    if (leader) {
        unsigned* bar = b.bar;
        __builtin_amdgcn_s_waitcnt(0);
        unsigned nloc = b.st[0], nx = b.st[1];
        if (nloc == 0u) { xcd_barrier_complete(bar, b.x, nloc, nx); b.st[0] = nloc; b.st[1] = nx; }
        const unsigned old = xb_add(&bar[XB_XSUB(b.x)], 1u);
        const unsigned gen = old / nloc;
        if (old + 1u == (gen + 1u) * nloc) {
            __builtin_amdgcn_fence(__ATOMIC_RELEASE, "agent");
            asm volatile("s_waitcnt vmcnt(0)" ::: "memory");
            const unsigned og = xb_add(&bar[XB_TOP], 1u);
            const unsigned tg = og / nx;
            if (og + 1u == (tg + 1u) * nx) xb_add(&bar[XB_TOPGEN], 1u);
            else XB_SPIN(xb_ld(&bar[XB_TOPGEN]) == tg, bar);
            __builtin_amdgcn_fence(__ATOMIC_ACQUIRE, "agent");
            xb_add(&bar[XB_XGEN(b.x)], 1u);
            asm volatile("s_waitcnt vmcnt(0)" ::: "memory");
        } else {
            XB_SPIN(xb_ld(&bar[XB_XGEN(b.x)]) == gen, bar);
            __builtin_amdgcn_fence(__ATOMIC_ACQUIRE, "agent");
            asm volatile("s_waitcnt vmcnt(0)" ::: "memory");
        }
    }
    __syncthreads();
}

namespace pg8 {
constexpr int BM = 256, BK = 64, HALF = 128, HTB = HALF * BK * 2, STAGE_BYTES = 8 * HTB, NXCD = 8, WGM = 8;
__host__ __device__ __forceinline__ int lds_byte(int r, int c) { const int st = (r >> 4) * 2 + (c >> 5), rr = r & 15, cc = c & 31, ob = rr * 64 + cc * 2; return st * 1024 + (ob ^ (((ob >> 9) & 1) << 5)); }
__host__ __device__ __forceinline__ void stage_rc(int b, int& R, int& C) { const int st = b / 1024, sb = b % 1024, swz = sb ^ (((sb >> 9) & 1) << 5); R = (st >> 1) * 16 + swz / 64; C = (st & 1) * 32 + (swz % 64) / 2; }
__host__ __device__ __forceinline__ int perm32(int rho) { const int n = rho >> 4, i = rho & 15; return 8 * (i >> 2) + 4 * n + (i & 3); }

struct Unit { int arow, brow, akoff, orow, ocol, nt, slab; };
struct Gemm { const bf16_t* A; const bf16_t* Bt; int lda, ldb, K; };

struct TileOrder {
    int nM, nN, nwg, G, c;
    __device__ __forceinline__ void init(int nM_, int nN_, int G_, int c_) { nM = nM_; nN = nN_; nwg = nM * nN; G = G_; c = c_; }
    __device__ __forceinline__ bool tile(int i, int& pm, int& pn) const {
        const long L = (long)i * G + c; if (L >= nwg) return false;
        int wgid = (int)L; { const int q = nwg / NXCD, r = nwg % NXCD, xcd = wgid % NXCD, off = wgid / NXCD; wgid = (xcd < r ? xcd * (q + 1) : r * (q + 1) + (xcd - r) * q) + off; }
        const int nig = WGM * nN, gid = wgid / nig, fm = gid * WGM, gsz = (nM - fm) < WGM ? (nM - fm) : WGM;
        pm = fm + ((wgid % nig) % gsz); pn = (wgid % nig) / gsz; return true;
    }
};
struct PlainSched : TileOrder {
    static constexpr bool KSPLIT = false;
    int akstep;
    __device__ __forceinline__ bool next(int i, Unit& u) const { int pm, pn; if (!tile(i, pm, pn)) return false; u.arow = pm * BM; u.brow = pn * BM; u.akoff = pn * akstep; u.orow = pm * BM; u.ocol = pn * BM; u.nt = 0; u.slab = -1; return true; }
};
struct MoeSched : TileOrder {
    static constexpr bool KSPLIT = false;
    int t1, t2, t3, t4, t5, t6, t7, ttot; int brows;
    __device__ __forceinline__ void set_tstart(const int (&ts)[9]) { t1 = ts[1]; t2 = ts[2]; t3 = ts[3]; t4 = ts[4]; t5 = ts[5]; t6 = ts[6]; t7 = ts[7]; ttot = ts[8]; }
    __device__ __forceinline__ int expert_of(int pm) const { return (pm >= t1) + (pm >= t2) + (pm >= t3) + (pm >= t4) + (pm >= t5) + (pm >= t6) + (pm >= t7); }
    __device__ __forceinline__ bool next(int i, Unit& u) const { int pm, pn; if (!tile(i, pm, pn)) return false;
        const int e = expert_of(pm);
        u.arow = pm * BM; u.brow = e * brows + pn * BM; u.akoff = 0; u.orow = pm * BM; u.ocol = pn * BM; u.nt = 0; u.slab = -1; return true; }
};
__device__ __forceinline__ int split_factor(int nwg, int G, int ktiles) { const int nleft = nwg % G; int S = 1;
#define PG8_TRY_S(v) if (nleft > 0 && (v) * nleft <= G && (ktiles % (2 * (v))) == 0 && ktiles / (v) >= 4) S = (v)
    PG8_TRY_S(2); PG8_TRY_S(4); PG8_TRY_S(7); PG8_TRY_S(8);
#undef PG8_TRY_S
    return S; }
struct MoeSplitSched : MoeSched {
    static constexpr bool KSPLIT = true;
    int nfull, nleft, S, ktiles;
    __device__ __forceinline__ void init2(int nM_, int nN_, int G_, int c_, int ktiles_) { init(nM_, nN_, G_, c_); ktiles = ktiles_; nfull = nwg / G; nleft = nwg - nfull * G; S = split_factor(nwg, G_, ktiles_); }
    __device__ __forceinline__ bool next(int i, Unit& u) const {
        const bool split = (S > 1) && (i >= nfull);
        const int lu = c / S, s = c - lu * S;
        const long L = split ? (long)nfull * G + lu : (long)i * G + c;
        if (L >= nwg || (split && (i > nfull || c >= nleft * S))) return false;
        int wgid = (int)L; { const int q = nwg / NXCD, r = nwg % NXCD, xcd = wgid % NXCD, off = wgid / NXCD; wgid = (xcd < r ? xcd * (q + 1) : r * (q + 1) + (xcd - r) * q) + off; }
        const int nig = WGM * nN, gid = wgid / nig, fm = gid * WGM, gsz = (nM - fm) < WGM ? (nM - fm) : WGM;
        const int pm = fm + ((wgid % nig) % gsz), pn = (wgid % nig) / gsz;
        const int e = expert_of(pm), ntp = ktiles / S;
        u.arow = pm * BM; u.brow = e * brows + pn * BM; u.nt = split ? ntp : 0; u.akoff = split ? s * ntp * BK : 0; u.orow = pm * BM; u.ocol = pn * BM; u.slab = split ? lu * S + s : -1; return true; }
};

struct EpiQKV0 {
    static constexpr bool PERM = true;
    bf16_t* O;
    __device__ __forceinline__ void operator()(const f32x4 (&acc)[2][2][4][2], const Unit& u, int wr, int wc, int fr, int fq) const {
        const int row0 = u.orow + wr * 64 + fr;
#pragma unroll
        for (int bj = 0; bj < 2; ++bj) {
            const int c = u.ocol + bj * HALF, ten = c >> 10, h = (c & 1023) >> 7;
#pragma unroll
            for (int ai = 0; ai < 2; ++ai)
#pragma unroll
                for (int m = 0; m < 4; ++m) { const int row = row0 + ai * HALF + m * 16, b = row >> 13, t = row & 8191;
                    bf16_t* p = O + ((((size_t)ten * 2 + b) * 8 + h) * 8192 + t) * 128 + wc * 32 + 8 * fq;
                    const f32x4 v0 = acc[ai][bj][m][0], v1 = acc[ai][bj][m][1];
                    u32x4 w; w.x = cvt_pk_bf16(v0[0], v0[1]); w.y = cvt_pk_bf16(v0[2], v0[3]); w.z = cvt_pk_bf16(v1[0], v1[1]); w.w = cvt_pk_bf16(v1[2], v1[3]);
                    *(u32x4*)p = w; }
        }
    }
};
struct EpiResF32 {
    static constexpr bool PERM = false;
    const float* res; float* out; int ldc; float alpha; float scale;
    __device__ __forceinline__ void operator()(const f32x4 (&acc)[2][2][4][2], const Unit& u, int wr, int wc, int fr, int fq) const {
        const int row0 = u.orow + wr * 64 + fr, col0 = u.ocol + wc * 32 + 4 * fq;
#pragma unroll
        for (int ai = 0; ai < 2; ++ai)
#pragma unroll
            for (int m = 0; m < 4; ++m) { const size_t off = (size_t)(row0 + ai * HALF + m * 16) * ldc + col0;
                f32x4 r[2][2];
#pragma unroll
                for (int bj = 0; bj < 2; ++bj)
#pragma unroll
                    for (int n = 0; n < 2; ++n) r[bj][n] = *(const f32x4*)(res + off + bj * HALF + n * 16);
#pragma unroll
                for (int bj = 0; bj < 2; ++bj)
#pragma unroll
                    for (int n = 0; n < 2; ++n) *(f32x4*)(out + off + bj * HALF + n * 16) = r[bj][n] * alpha + acc[ai][bj][m][n] * scale;
                asm volatile("" ::: "memory"); }
    }
};
struct EpiResLnF32 {
    static constexpr bool PERM = false;
    const float* res; float* out; int ldc; float alpha; float scale; const float* stat; const float* g; const float* b;
    __device__ __forceinline__ void operator()(const f32x4 (&acc)[2][2][4][2], const Unit& u, int wr, int wc, int fr, int fq) const {
        const int row0 = u.orow + wr * 64 + fr, col0 = u.ocol + wc * 32 + 4 * fq;
#pragma unroll
        for (int bj = 0; bj < 2; ++bj)
#pragma unroll
            for (int n = 0; n < 2; ++n) {
                const int col = col0 + bj * HALF + n * 16;
                const f32x4 gg = *(const f32x4*)(g + col), bb = *(const f32x4*)(b + col);
#pragma unroll
                for (int ai = 0; ai < 2; ++ai)
#pragma unroll
                    for (int m = 0; m < 4; ++m) { const int row = row0 + ai * HALF + m * 16; const size_t off = (size_t)row * ldc + col;
                        const float mean = stat[2 * (size_t)row], rstd = stat[2 * (size_t)row + 1];
                        const f32x4 r = *(const f32x4*)(res + off);
                        *(f32x4*)(out + off) = ((r - mean) * rstd * gg + bb) * alpha + acc[ai][bj][m][n] * scale; }
                asm volatile("" ::: "memory"); }
    }
};
struct EpiF32 {
    static constexpr bool PERM = false;
    float* out; int ldc;
    __device__ __forceinline__ void operator()(const f32x4 (&acc)[2][2][4][2], const Unit& u, int wr, int wc, int fr, int fq) const {
        const int row0 = u.orow + wr * 64 + fr, col0 = u.ocol + wc * 32 + 4 * fq;
#pragma unroll
        for (int ai = 0; ai < 2; ++ai)
#pragma unroll
            for (int m = 0; m < 4; ++m) { float* rowp = out + (size_t)(row0 + ai * HALF + m * 16) * ldc + col0;
#pragma unroll
                for (int bj = 0; bj < 2; ++bj)
#pragma unroll
                    for (int n = 0; n < 2; ++n) *(f32x4*)(rowp + bj * HALF + n * 16) = acc[ai][bj][m][n]; }
    }
};
struct EpiBf16 {
    static constexpr bool PERM = true;
    bf16_t* O0; int ld0; int split; bf16_t* O1; int ld1;
    __device__ __forceinline__ void operator()(const f32x4 (&acc)[2][2][4][2], const Unit& u, int wr, int wc, int fr, int fq) const {
        const int row0 = u.orow + wr * 64 + fr; bf16_t* base = O0; int ld = ld0, colt = u.ocol;
        if (colt >= split) { base = O1; ld = ld1; colt -= split; }
        const int col0 = colt + wc * 32 + 8 * fq;
#pragma unroll
        for (int ai = 0; ai < 2; ++ai)
#pragma unroll
            for (int m = 0; m < 4; ++m) { bf16_t* rowp = base + (size_t)(row0 + ai * HALF + m * 16) * ld + col0;
#pragma unroll
                for (int bj = 0; bj < 2; ++bj) { const f32x4 v0 = acc[ai][bj][m][0], v1 = acc[ai][bj][m][1];
                    u32x4 w; w.x = cvt_pk_bf16(v0[0], v0[1]); w.y = cvt_pk_bf16(v0[2], v0[3]); w.z = cvt_pk_bf16(v1[0], v1[1]); w.w = cvt_pk_bf16(v1[2], v1[3]);
                    *(u32x4*)(rowp + bj * HALF) = w; } }
    }
};
struct EpiYSlab {
    static constexpr bool PERM = true;
    bf16_t* O; int ld; float* slabs; unsigned* flags; int nN, S; float scale;
    __device__ __forceinline__ void operator()(const f32x4 (&acc)[2][2][4][2], const Unit& u, int wr, int wc, int fr, int fq) const {
        if (u.slab < 0) {
            const int row0 = u.orow + wr * 64 + fr, col0 = u.ocol + wc * 32 + 8 * fq;
#pragma unroll
            for (int ai = 0; ai < 2; ++ai)
#pragma unroll
                for (int m = 0; m < 4; ++m) { bf16_t* rowp = O + (size_t)(row0 + ai * HALF + m * 16) * ld + col0;
#pragma unroll
                    for (int bj = 0; bj < 2; ++bj) { const f32x4 v0 = acc[ai][bj][m][0] * scale, v1 = acc[ai][bj][m][1] * scale;
                        u32x4 w; w.x = cvt_pk_bf16(v0[0], v0[1]); w.y = cvt_pk_bf16(v0[2], v0[3]); w.z = cvt_pk_bf16(v1[0], v1[1]); w.w = cvt_pk_bf16(v1[2], v1[3]);
                        *(u32x4*)(rowp + bj * HALF) = w; } }
        } else {
            float* sl = slabs + (size_t)u.slab * 65536 + (size_t)(wr * 64 + fr) * 256 + wc * 32 + 8 * fq;
#pragma unroll
            for (int ai = 0; ai < 2; ++ai)
#pragma unroll
                for (int m = 0; m < 4; ++m)
#pragma unroll
                    for (int bj = 0; bj < 2; ++bj) { float* p = sl + (size_t)(ai * HALF + m * 16) * 256 + bj * HALF; *(f32x4*)p = acc[ai][bj][m][0] * scale; *(f32x4*)(p + 4) = acc[ai][bj][m][1] * scale; }
            if ((u.slab % S) == 0 && wr == 0 && wc == 0 && fr == 0 && fq == 0) flags[(u.orow >> 8) * nN + (u.ocol >> 8)] = (unsigned)u.slab + 1u;
        }
    }
};
typedef int v8i __attribute__((ext_vector_type(8)));
typedef int v8i_a16 __attribute__((ext_vector_type(8), aligned(16)));
__device__ __forceinline__ float quad_xor1(float v) { return __builtin_bit_cast(float, __builtin_amdgcn_mov_dpp(__builtin_bit_cast(int, v), 0xB1, 0xF, 0xF, true)); }
__device__ __forceinline__ float quad_xor2(float v) { return __builtin_bit_cast(float, __builtin_amdgcn_mov_dpp(__builtin_bit_cast(int, v), 0x4E, 0xF, 0xF, true)); }
__device__ __forceinline__ float quad_xor3(float v) { return __builtin_bit_cast(float, __builtin_amdgcn_mov_dpp(__builtin_bit_cast(int, v), 0x1B, 0xF, 0xF, true)); }
__device__ __forceinline__ unsigned pk4_fp8(float a, float b, float c, float d) { int w = __builtin_amdgcn_cvt_pk_fp8_f32(a, b, 0, false); w = __builtin_amdgcn_cvt_pk_fp8_f32(c, d, w, true); return (unsigned)w; }
__device__ __forceinline__ float silu_mul(float a, float b) { return a * __builtin_amdgcn_rcpf(1.0f + __builtin_amdgcn_exp2f(-1.4426950408889634f * a)) * b; }
struct EpiSwiGLU {
    static constexpr bool PERM = true;
    bf16_t* O; int ldc;
    __device__ __forceinline__ void operator()(const f32x4 (&acc)[2][2][4][2], const Unit& u, int wr, int wc, int fr, int fq) const {
        const int row0 = u.orow + wr * 64 + fr, col0 = (u.ocol >> 1) + wc * 32 + 8 * fq;
#pragma unroll
        for (int ai = 0; ai < 2; ++ai)
#pragma unroll
            for (int m = 0; m < 4; ++m) { bf16_t* rowp = O + (size_t)(row0 + ai * HALF + m * 16) * ldc + col0;
                const f32x4 g0 = acc[ai][0][m][0], g1 = acc[ai][0][m][1], u0 = acc[ai][1][m][0], u1 = acc[ai][1][m][1];
                u32x4 w; w.x = cvt_pk_bf16(silu_mul(g0[0], u0[0]), silu_mul(g0[1], u0[1])); w.y = cvt_pk_bf16(silu_mul(g0[2], u0[2]), silu_mul(g0[3], u0[3]));
                w.z = cvt_pk_bf16(silu_mul(g1[0], u1[0]), silu_mul(g1[1], u1[1])); w.w = cvt_pk_bf16(silu_mul(g1[2], u1[2]), silu_mul(g1[3], u1[3]));
                *(u32x4*)rowp = w; }
    }
};

struct Epi8 {
    static constexpr bool PERM = true;
    unsigned char* O; int ld; float scale;
    __device__ __forceinline__ void operator()(const f32x4 (&acc)[2][2][4][2], const Unit& u, int wr, int wc, int fr, int fq) const {
        const int row0 = u.orow + wr * 64 + fr, col0 = u.ocol + wc * 32 + 8 * fq;
#pragma unroll
        for (int ai = 0; ai < 2; ++ai)
#pragma unroll
            for (int m = 0; m < 4; ++m) { unsigned char* rowp = O + (size_t)(row0 + ai * HALF + m * 16) * ld + col0;
#pragma unroll
                for (int bj = 0; bj < 2; ++bj) { const f32x4 v0 = acc[ai][bj][m][0] * scale, v1 = acc[ai][bj][m][1] * scale;
                    u32x2 w; w.x = pk4_fp8(v0[0], v0[1], v0[2], v0[3]); w.y = pk4_fp8(v1[0], v1[1], v1[2], v1[3]); *(u32x2*)(rowp + bj * HALF) = w; } }
    }
};
struct EpiSwiGLU8 {
    static constexpr bool PERM = true;
    unsigned char* O; int ldc;
    __device__ __forceinline__ void operator()(const f32x4 (&acc)[2][2][4][2], const Unit& u, int wr, int wc, int fr, int fq) const {
        const int row0 = u.orow + wr * 64 + fr, col0 = (u.ocol >> 1) + wc * 32 + 8 * fq; constexpr float si = 1.0f / 64.0f;
#pragma unroll
        for (int ai = 0; ai < 2; ++ai)
#pragma unroll
            for (int m = 0; m < 4; ++m) { unsigned char* rowp = O + (size_t)(row0 + ai * HALF + m * 16) * ldc + col0;
                const f32x4 g0 = acc[ai][0][m][0] * si, g1 = acc[ai][0][m][1] * si, u0 = acc[ai][1][m][0] * (si * 8.0f), u1 = acc[ai][1][m][1] * (si * 8.0f);
                u32x2 w; w.x = pk4_fp8(silu_mul(g0[0], u0[0]), silu_mul(g0[1], u0[1]), silu_mul(g0[2], u0[2]), silu_mul(g0[3], u0[3]));
                w.y = pk4_fp8(silu_mul(g1[0], u1[0]), silu_mul(g1[1], u1[1]), silu_mul(g1[2], u1[2]), silu_mul(g1[3], u1[3]));
                *(u32x2*)rowp = w; }
    }
};
template <class Epi, class Sched, bool F8 = false>
__device__ __forceinline__ void gemm_phase(LAS unsigned char* lds, const Gemm g, const Sched& S, const Epi& E, const int tid) {
    const int wid = __builtin_amdgcn_readfirstlane(tid >> 6), lane = tid & 63, wr = wid >> 2, wc = wid & 3, fr = lane & 15, fq = lane >> 4;
    const int K = g.K, nt = K / BK;
    unsigned voffA[2], voffB[2];
#pragma unroll
    for (int i = 0; i < 2; ++i) { int R, C; stage_rc(tid * 16 + i * 8192, R, C); const int Rb = Epi::PERM ? ((R & ~31) + perm32(R & 31)) : R;
        voffA[i] = (unsigned)(R * g.lda + C) * 2u; voffB[i] = (unsigned)(Rb * g.ldb + C) * 2u; }
    const size_t kstep = (size_t)(BK * 2);
    const size_t hstepA = (size_t)HALF * g.lda * 2, hstepB = (size_t)HALF * g.ldb * 2;
    const unsigned ldsw = (unsigned)wid * 1024u;
    const int aoff = F8 ? lds_byte(wr * 64 + fr, fq * 16) : lds_byte(wr * 64 + fr, fq * 8), boff = F8 ? lds_byte(wc * 32 + fr, fq * 16) : lds_byte(wc * 32 + fr, fq * 8);
#define PG8_SA(b, h) (((b) * 2 + (h)) * HTB)
#define PG8_SB(b, h) ((4 + (b) * 2 + (h)) * HTB)
#define PG8_STAGE(bufoff, gbase, voff) do { _Pragma("unroll") for (int _i = 0; _i < 2; ++_i) \
        __builtin_amdgcn_global_load_lds((const unsigned*)((const char*)(gbase) + (voff)[_i]), (LAS unsigned*)(lds + (bufoff) + ldsw + _i * 8192), 16, 0, 0); } while (0)
#define PG8_LDA(dst, b, h) do { _Pragma("unroll") for (int m = 0; m < 4; ++m) { if constexpr (F8) { dst##8[m] = *(const LAS v8i_a16*)(lds + PG8_SA(b, h) + aoff + m * 2048); } \
        else { _Pragma("unroll") for (int k = 0; k < 2; ++k) dst[m][k] = *(const LAS bf16x8*)(lds + PG8_SA(b, h) + aoff + m * 2048 + k * 1024); } } } while (0)
#define PG8_LDB(dst, b, h) do { _Pragma("unroll") for (int n = 0; n < 2; ++n) { if constexpr (F8) { dst##8[n] = *(const LAS v8i_a16*)(lds + PG8_SB(b, h) + boff + n * 2048); } \
        else { _Pragma("unroll") for (int k = 0; k < 2; ++k) dst[n][k] = *(const LAS bf16x8*)(lds + PG8_SB(b, h) + boff + n * 2048 + k * 1024); } } } while (0)
#define PG8_MMA(ai, bj, At, Bt) do { __builtin_amdgcn_s_setprio(1); _Pragma("unroll") for (int m = 0; m < 4; ++m) _Pragma("unroll") for (int n = 0; n < 2; ++n) { if constexpr (F8) { \
            acc[ai][bj][m][n] = __builtin_amdgcn_mfma_scale_f32_16x16x128_f8f6f4(Bt##8[n], At##8[m], acc[ai][bj][m][n], 0, 0, 0, 0x7F7F7F7F, 0, 0x7F7F7F7F); \
        } else { _Pragma("unroll") for (int k = 0; k < 2; ++k) acc[ai][bj][m][n] = __builtin_amdgcn_mfma_f32_16x16x32_bf16(Bt[n][k], At[m][k], acc[ai][bj][m][n], 0, 0, 0); } } __builtin_amdgcn_s_setprio(0); } while (0)
#define PG8_WAIT_V(n) asm volatile("s_waitcnt vmcnt(" #n ")" ::: "memory")
#define PG8_WAIT_L(n) asm volatile("s_waitcnt lgkmcnt(" #n ")" ::: "memory")
#define PG8_BAR __builtin_amdgcn_s_barrier()
    Unit cur, nxt; int ui = 0;
    if (!S.next(0, cur)) return;
    f32x4 acc[2][2][4][2];
#pragma unroll
    for (int a = 0; a < 2; ++a)
#pragma unroll
        for (int b = 0; b < 2; ++b)
#pragma unroll
            for (int m = 0; m < 4; ++m)
#pragma unroll
                for (int n = 0; n < 2; ++n) acc[a][b][m][n] = (f32x4){0.f, 0.f, 0.f, 0.f};
    bf16x8 At[4][2], B0[2][2], B1[2][2]; v8i At8[4], B08[2], B18[2];
    const char* cA = (const char*)g.A + ((size_t)cur.arow * g.lda + cur.akoff) * 2; const char* cB = (const char*)g.Bt + ((size_t)cur.brow * g.ldb + (Sched::KSPLIT ? cur.akoff : 0)) * 2;
    PG8_STAGE(PG8_SB(0, 0), cB, voffB); PG8_STAGE(PG8_SB(0, 1), cB + hstepB, voffB); PG8_STAGE(PG8_SA(0, 0), cA, voffA); PG8_STAGE(PG8_SA(0, 1), cA + hstepA, voffA);
    if (wr == 1) PG8_BAR;
    PG8_WAIT_V(2); PG8_BAR;
    PG8_STAGE(PG8_SB(1, 0), cB + kstep, voffB); PG8_STAGE(PG8_SA(1, 0), cA + kstep, voffA); PG8_STAGE(PG8_SB(1, 1), cB + hstepB + kstep, voffB);
    PG8_WAIT_V(6); PG8_BAR;
    for (;;) {
        const bool has_next = S.next(ui + 1, nxt);
        const char* nA = has_next ? (const char*)g.A + ((size_t)nxt.arow * g.lda + nxt.akoff) * 2 : cA; const char* nB = has_next ? (const char*)g.Bt + ((size_t)nxt.brow * g.ldb + (Sched::KSPLIT ? nxt.akoff : 0)) * 2 : cB;
        const int ntc = (Sched::KSPLIT && cur.nt) ? cur.nt : nt;
        if constexpr (F8) {
#pragma unroll 1
            for (int t = 0; t < ntc; ++t) {
                const int b = t & 1; LAS unsigned char* lb = lds + b * (2 * HTB); LAS unsigned char* lo = lds + (b ^ 1) * (2 * HTB);
                const unsigned lbv = (unsigned)(uintptr_t)lb;
#define PG8_LDS32(dst, addr, imm) do { u32x4 lo_, hi_; asm volatile("ds_read_b128 %0, %2 offset:%3\n\tds_read_b128 %1, %2 offset:%4" : "=&v"(lo_), "=&v"(hi_) : "v"(addr), "i"(imm), "i"((imm) + 16) : "memory"); \
        dst = __builtin_bit_cast(v8i, __builtin_shufflevector(lo_, hi_, 0, 1, 2, 3, 4, 5, 6, 7)); } while (0)
                const char* s1 = (t + 1 < ntc) ? cA + (size_t)(t + 1) * kstep : nA + (size_t)(t + 1 - ntc) * kstep;
                const char* a2 = (t + 2 < ntc) ? cA + (size_t)(t + 2) * kstep : nA + (size_t)(t + 2 - ntc) * kstep;
                const char* b2 = (t + 2 < ntc) ? cB + (size_t)(t + 2) * kstep : nB + (size_t)(t + 2 - ntc) * kstep;
#define PG8_STAGE8(ldsdst, gbase, voff) do { _Pragma("unroll") for (int _i = 0; _i < 2; ++_i) \
        __builtin_amdgcn_global_load_lds((const unsigned*)((const char*)(gbase) + (voff)[_i]), (LAS unsigned*)((ldsdst) + ldsw + _i * 8192), 16, 0, 0); } while (0)
#pragma unroll
                for (int n = 0; n < 2; ++n) { PG8_LDS32(B08[n], lbv + (unsigned)(4 * HTB) + boff, n * 2048); PG8_LDS32(B18[n], lbv + (unsigned)(4 * HTB) + boff, HTB + n * 2048); }
                SBAR();
#pragma unroll
                for (int m = 0; m < 4; ++m) PG8_LDS32(At8[m], lbv + aoff, m * 2048);
                PG8_STAGE8(lo + HTB, s1 + hstepA, voffA);
                PG8_WAIT_V(8); PG8_WAIT_L(0); PG8_BAR; PG8_MMA(0, 0, At, B0); PG8_MMA(0, 1, At, B1); PG8_BAR; SBAR();
#pragma unroll
                for (int m = 0; m < 4; ++m) PG8_LDS32(At8[m], lbv + aoff, HTB + m * 2048);
                PG8_STAGE8(lb + 4 * HTB, b2, voffB); PG8_STAGE8(lb + 5 * HTB, b2 + hstepB, voffB); PG8_STAGE8(lb, a2, voffA);
                PG8_WAIT_V(8); PG8_WAIT_L(0); PG8_BAR; PG8_MMA(1, 0, At, B0); PG8_MMA(1, 1, At, B1); PG8_BAR; SBAR();
#undef PG8_STAGE8
#undef PG8_LDS32
            }
        } else
        for (int t = 0; t < ntc; t += 2) {
            const bool last = (t == ntc - 2);
            const char* a1 = cA + (size_t)(t + 1) * kstep;
            const char* a2 = last ? nA : cA + (size_t)(t + 2) * kstep; const char* b2 = last ? nB : cB + (size_t)(t + 2) * kstep;
            const char* a3 = a2 + kstep; const char* b3 = b2 + kstep;
            PG8_LDB(B0, 0, 0); PG8_LDB(B1, 0, 1); SBAR(); PG8_LDA(At, 0, 0); PG8_STAGE(PG8_SA(1, 1), a1 + hstepA, voffA);
            PG8_WAIT_V(8); PG8_WAIT_L(0); PG8_BAR; PG8_MMA(0, 0, At, B0); PG8_MMA(0, 1, At, B1); PG8_BAR; SBAR();
            PG8_LDA(At, 0, 1); PG8_STAGE(PG8_SB(0, 0), b2, voffB); PG8_STAGE(PG8_SB(0, 1), b2 + hstepB, voffB); PG8_STAGE(PG8_SA(0, 0), a2, voffA);
            PG8_WAIT_V(8); PG8_WAIT_L(0); PG8_BAR; PG8_MMA(1, 0, At, B0); PG8_MMA(1, 1, At, B1); PG8_BAR; SBAR();
            PG8_LDB(B0, 1, 0); PG8_LDB(B1, 1, 1); SBAR(); PG8_LDA(At, 1, 0); PG8_STAGE(PG8_SA(0, 1), a2 + hstepA, voffA);
            PG8_WAIT_V(8); PG8_WAIT_L(0); PG8_BAR; PG8_MMA(0, 0, At, B0); PG8_MMA(0, 1, At, B1); PG8_BAR; SBAR();
            PG8_LDA(At, 1, 1); PG8_STAGE(PG8_SB(1, 0), b3, voffB); PG8_STAGE(PG8_SB(1, 1), b3 + hstepB, voffB); PG8_STAGE(PG8_SA(1, 0), a3, voffA);
            PG8_WAIT_V(8); PG8_WAIT_L(0); PG8_BAR; PG8_MMA(1, 0, At, B0); PG8_MMA(1, 1, At, B1); PG8_BAR; SBAR();
        }
        if (wr == 0) PG8_BAR;
        { int t2 = tid; asm volatile("" : "+v"(t2));
          const int w2 = __builtin_amdgcn_readfirstlane(t2 >> 6), l2 = t2 & 63; E(acc, cur, w2 >> 2, w2 & 3, l2 & 15, l2 >> 4); }
        if (!has_next) break;
#pragma unroll
        for (int a = 0; a < 2; ++a)
#pragma unroll
            for (int b = 0; b < 2; ++b)
#pragma unroll
                for (int m = 0; m < 4; ++m)
#pragma unroll
                    for (int n = 0; n < 2; ++n) acc[a][b][m][n] = (f32x4){0.f, 0.f, 0.f, 0.f};
        cur = nxt; cA = nA; cB = nB; ++ui;
        if (wr == 1) PG8_BAR;
    }
    PG8_WAIT_V(0);
    PG8_BAR;
#undef PG8_SA
#undef PG8_SB
#undef PG8_STAGE
#undef PG8_LDA
#undef PG8_LDB
#undef PG8_MMA
#undef PG8_WAIT_V
#undef PG8_WAIT_L
#undef PG8_BAR
}
}
namespace att {
constexpr int D = 128, NW = 8, QBLK = 32, KVBLK = 64, QB = NW * QBLK;
constexpr int SHM_V = KVBLK * D * 2, SHM_K = KVBLK * D * 2;
constexpr int OFF_V = 0, OFF_K = 2 * SHM_V, OFF_WS = OFF_K + 2 * SHM_K, OFF_NCL = OFF_WS + NW * 64 * 4, OFF_LUT = OFF_NCL + (8192 + 256) * 4, OFF_KM = OFF_LUT + 1024, OFF_MISC = OFF_KM + 32 * 128 * 4, LDS_END = OFF_MISC + 256;
constexpr float SCALE = 0.08838834764831845f, LOG2E = 1.4426950408889634f, C2 = SCALE * LOG2E;
constexpr float THR2 = 8.f * LOG2E;
#define KSWZ(row, colB) ((row) * 256 + ((colB) ^ (((row) & 7) << 4)))
__device__ __forceinline__ int v_st(int k, int c) { const int kk = (k & ~0xC) | ((k & 4) << 1) | ((k & 8) >> 1); return ((kk >> 3) * 4 + (c >> 5)) * 512 + ((kk & 7) * 32 + (c & 31)) * 2; }
__device__ __forceinline__ int v_rd_base(int lane) { return ((lane & 3) << 3) | (((lane >> 2) & 3) << 6) | (((lane >> 4) & 1) << 5) | (((lane >> 5) & 1) << 8); }
constexpr int v_rd_off(int d0, int ks, int half) { return d0 * 512 + ks * 4096 + half * 2048; }
__device__ __forceinline__ int crow(int r, int hi) { return (r & 3) + 8 * (r >> 2) + 4 * hi; }
__device__ __forceinline__ bf16x8 load8(const bf16_t* p) { return *reinterpret_cast<const bf16x8*>(p); }

__device__ __forceinline__ void partialSM(f32x16& p0, f32x16& p1, float& m_reg, float& mn, float& alpha) {
    float pmax = p0[0];
#pragma unroll
    for (int r = 1; r < 16; ++r) pmax = fmaxf(pmax, p0[r]);
#pragma unroll
    for (int r = 0; r < 16; ++r) pmax = fmaxf(pmax, p1[r]);
    { auto rr = __builtin_amdgcn_permlane32_swap(__float_as_uint(pmax), __float_as_uint(pmax), false, false);
      pmax = fmaxf(__uint_as_float(rr[0]), __uint_as_float(rr[1])); }
    if (__builtin_expect(__all((pmax - m_reg) <= THR2), 1)) { mn = m_reg; alpha = 1.f; }
    else { mn = fmaxf(m_reg, pmax); alpha = __builtin_amdgcn_exp2f(m_reg - mn); m_reg = mn; }
#pragma unroll
    for (int r = 0; r < 16; ++r) p0[r] = p0[r] - mn;
#pragma unroll
    for (int r = 0; r < 16; ++r) p1[r] = p1[r] - mn;
#pragma unroll
    for (int r = 0; r < 16; ++r) p0[r] = __builtin_amdgcn_exp2f(p0[r]);
}
__device__ __forceinline__ void finishSM(f32x16& p0, f32x16& p1, float alpha, float& l_reg, bf16x8& pa0, bf16x8& pa1, bf16x8& pa2, bf16x8& pa3) {
#pragma unroll
    for (int r = 0; r < 16; ++r) p1[r] = __builtin_amdgcn_exp2f(p1[r]);
    float ps = 0;
#pragma unroll
    for (int r = 0; r < 16; ++r) ps += p0[r];
#pragma unroll
    for (int r = 0; r < 16; ++r) ps += p1[r];
    { auto rr = __builtin_amdgcn_permlane32_swap(__float_as_uint(ps), __float_as_uint(ps), false, false);
      ps = __uint_as_float(rr[0]) + __uint_as_float(rr[1]); }
    l_reg = l_reg * alpha + ps;
#define PK4(P, B_, OUT) do { unsigned a0 = cvt_pk_bf16(P[B_+0], P[B_+1]), a1 = cvt_pk_bf16(P[B_+2], P[B_+3]);                          \
        unsigned b0 = cvt_pk_bf16(P[B_+4], P[B_+5]), b1 = cvt_pk_bf16(P[B_+6], P[B_+7]);                                             \
        auto r0 = __builtin_amdgcn_permlane32_swap(a0, b0, false, false); auto r1 = __builtin_amdgcn_permlane32_swap(a1, b1, false, false); \
        u32x4 w = {r0[0], r1[0], r0[1], r1[1]}; OUT = *reinterpret_cast<bf16x8*>(&w); } while (0)
    PK4(p0, 0, pa0); PK4(p0, 8, pa1); PK4(p1, 0, pa2); PK4(p1, 8, pa3);
#undef PK4
}
template <int KB>
__device__ __forceinline__ void qkt(f32x16& p0, f32x16& p1, const char* K_lds, int r32, int hi, const bf16x8* qr) {
    p0 = f32x16{}; p1 = f32x16{};
    const char* kb[4];
#pragma unroll
    for (int dd = 0; dd < 4; ++dd) kb[dd] = K_lds + KB * SHM_K + KSWZ(r32, (dd * 16 + hi * 8) * 2);
#pragma unroll
    for (int d0 = 0; d0 < 8; ++d0) { const char* a = kb[d0 & 3] + (d0 >> 2) * 128;
        bf16x8 b0 = *reinterpret_cast<const bf16x8*>(a);
        bf16x8 b1 = *reinterpret_cast<const bf16x8*>(a + 32 * 256);
        p0 = __builtin_amdgcn_mfma_f32_32x32x16_bf16(b0, qr[d0], p0, 0, 0, 0);
        p1 = __builtin_amdgcn_mfma_f32_32x32x16_bf16(b1, qr[d0], p1, 0, 0, 0); }
}
template <int VB>
__device__ __forceinline__ void pv_tile(f32x16* o, int vb0, bf16x8 pa0, bf16x8 pa1, bf16x8 pa2, bf16x8 pa3) {
#define TRRD(dst, off) asm volatile("ds_read_b64_tr_b16 %0, %1 offset:%2" : "=&v"(dst) : "v"(vb0), "i"(off) : "memory")
#define PV_D0(d0) do { s16x4 l0, l1, l2, l3, h0, h1, h2, h3; constexpr int b_ = VB * SHM_V + v_rd_off(d0, 0, 0); \
        TRRD(l0, b_); TRRD(h0, b_ + 2048); TRRD(l1, b_ + 4096); TRRD(h1, b_ + 6144); TRRD(l2, b_ + 8192); TRRD(h2, b_ + 10240); TRRD(l3, b_ + 12288); TRRD(h3, b_ + 14336); \
        asm volatile("s_waitcnt lgkmcnt(0)" ::: "memory"); SBAR(); \
        o[d0] = __builtin_amdgcn_mfma_f32_32x32x16_bf16(pa0, (bf16x8){l0[0], l0[1], l0[2], l0[3], h0[0], h0[1], h0[2], h0[3]}, o[d0], 0, 0, 0);   \
        o[d0] = __builtin_amdgcn_mfma_f32_32x32x16_bf16(pa1, (bf16x8){l1[0], l1[1], l1[2], l1[3], h1[0], h1[1], h1[2], h1[3]}, o[d0], 0, 0, 0);   \
        o[d0] = __builtin_amdgcn_mfma_f32_32x32x16_bf16(pa2, (bf16x8){l2[0], l2[1], l2[2], l2[3], h2[0], h2[1], h2[2], h2[3]}, o[d0], 0, 0, 0);   \
        o[d0] = __builtin_amdgcn_mfma_f32_32x32x16_bf16(pa3, (bf16x8){l3[0], l3[1], l3[2], l3[3], h3[0], h3[1], h3[2], h3[3]}, o[d0], 0, 0, 0); } while (0)
    PV_D0(0); PV_D0(1); PV_D0(2); PV_D0(3);
#undef PV_D0
#undef TRRD
}

template <int VAR>
__device__ __forceinline__ void prep(f32x16& p0, f32x16& p1, int kb, int pos, int qlo, int hi, const LAS float* ncl, int nclbase, const LAS float* lut, unsigned selmask, float farL) {
    const float NEG = -__builtin_inff();
    if constexpr (VAR == 0) {
        if (kb + KVBLK - 1 > qlo) {
            const int dq = pos - kb - 4 * hi;
#pragma unroll
            for (int r = 0; r < 16; ++r) { const int c = (r & 3) + 8 * (r >> 2);
                if (dq - c < 0) p0[r] = NEG;
                if (dq - c - 32 < 0) p1[r] = NEG; }
        }
        const LAS float* nb = ncl + (kb - nclbase) + 4 * hi;
#pragma unroll
        for (int g = 0; g < 4; ++g) { const f32x4 b0 = *(const LAS f32x4*)(nb + 8 * g), b1 = *(const LAS f32x4*)(nb + 32 + 8 * g);
#pragma unroll
            for (int j = 0; j < 4; ++j) { p0[4 * g + j] = fmaf(p0[4 * g + j], C2, b0[j]); p1[4 * g + j] = fmaf(p1[4 * g + j], C2, b1[j]); }
            asm volatile("" ::: "memory"); }
    } else {
        const bool selb = (selmask >> (kb >> 8)) & 1u;
        if (kb + KVBLK - 1 + 128 <= qlo) {
            const float add = selb ? farL : NEG;
#pragma unroll
            for (int r = 0; r < 16; ++r) { p0[r] = fmaf(p0[r], C2, add); p1[r] = fmaf(p1[r], C2, add); }
        } else {
            const int dq = pos - kb - 4 * hi;
#pragma unroll
            for (int r = 0; r < 16; ++r) { const int c = (r & 3) + 8 * (r >> 2);
                const int d0 = dq - c, d1 = dq - c - 32;
                const float b0 = lut[d0 < 0 ? 0 : (d0 > 128 ? 128 : d0)], b1 = lut[d1 < 0 ? 0 : (d1 > 128 ? 128 : d1)];
                const float t0 = fmaf(p0[r], C2, b0), t1 = fmaf(p1[r], C2, b1);
                p0[r] = (d0 < 0 || !selb) ? NEG : t0; p1[r] = (d1 < 0 || !selb) ? NEG : t1;
                if ((r & 3) == 3) asm volatile("" ::: "memory"); }
        }
    }
}

template <int VAR, int OP>
__device__ __forceinline__ void attn_block(const bf16_t* Q, const bf16_t* Kh, const bf16_t* Vh, unsigned char* O, int P0, int j_lo, int j_hi, char* lds,
                                           const LAS float* ncl, int nclbase, const LAS float* lut, unsigned selmask, float farL, const bf16x8 (&qr)[8], const int tid) {
    const int wid = __builtin_amdgcn_readfirstlane(tid >> 6), lane = tid & 63, r32 = lane & 31, hi = lane >> 5;
    const int NT = j_hi - j_lo;
    const int qlo = P0 + wid * QBLK, pos = qlo + r32;
    char* V_lds = lds + OFF_V; char* K_lds = lds + OFF_K;
    float* ws = (float*)(lds + OFF_WS) + wid * 64; float* li_l = ws, * al_l = ws + 32;
    float m_reg = -1e30f, l_reg = 0; f32x16 o[4] = {};
    const int sr = tid >> 4, sc = (tid & 15) * 8, vst0 = v_st(sr, sc), vst1 = v_st(32 + sr, sc), kws = KSWZ(sr, sc * 2);
    const int vb0 = (int)(uintptr_t)V_lds + v_rd_base(lane);
    bf16x8 st_v0, st_v1, st_k0, st_k1;
#define ROW(p, k0, rr) ((p) + (size_t)((k0) + (rr)) * D + sc)
#define SLOAD_H(k0) do { st_v0 = load8(ROW(Vh, k0, sr)); st_v1 = load8(ROW(Vh, k0, 32 + sr)); st_k0 = load8(ROW(Kh, k0, sr)); st_k1 = load8(ROW(Kh, k0, 32 + sr)); } while (0)
#define SWRITE_HK(bf) do { *(bf16x8*)(K_lds + (bf) * SHM_K + kws) = st_k0; *(bf16x8*)(K_lds + (bf) * SHM_K + kws + 32 * 256) = st_k1; } while (0)
#define SWRITE_HV(bf) do { *(bf16x8*)(V_lds + (bf) * SHM_V + vst0) = st_v0; *(bf16x8*)(V_lds + (bf) * SHM_V + vst1) = st_v1; } while (0)
#define SWRITE_H(bf) do { SWRITE_HV(bf); SWRITE_HK(bf); } while (0)
#define RESC(a) do { if (__any((a) < 1.f)) { if (hi == 0) al_l[r32] = (a); asm volatile("s_waitcnt lgkmcnt(0)" ::: "memory");              \
                     for (int d_ = 0; d_ < 4; ++d_) for (int r = 0; r < 16; ++r) o[d_][r] *= al_l[crow(r, hi)]; } } while (0)
#define KBASE(t) ((j_lo + (t)) * KVBLK)
#define PREP(P0_, P1_, t) prep<VAR>(P0_, P1_, KBASE(t), pos, qlo, hi, ncl, nclbase, lut, selmask, farL)
    f32x16 pA0, pA1, pB0, pB1; float mnA, mnB, alA, alB; bf16x8 pa0, pa1, pa2, pa3;
    SLOAD_H(KBASE(0)); VM_WAIT(); SWRITE_H(0); SBAR();
    if (NT > 1) SLOAD_H(KBASE(1));
    __syncthreads();
    SBAR(); qkt<0>(pA0, pA1, K_lds, r32, hi, qr);
    PREP(pA0, pA1, 0); partialSM(pA0, pA1, m_reg, mnA, alA);
    if (NT > 1) { VM_WAIT(); SWRITE_H(1); }
    __syncthreads();
#define HALF_STEP(PX0, PX1, mnX, alX, PY0, PY1, alY, t, KB, VB, SB) do {                                                      \
        SBAR(); qkt<KB>(PX0, PX1, K_lds, r32, hi, qr);                                                                        \
        finishSM(PY0, PY1, alY, l_reg, pa0, pa1, pa2, pa3); SBAR();                                                           \
        if ((t) + 1 < NT) { SLOAD_H(KBASE((t) + 1)); SBAR(); }                                                                \
        pv_tile<VB>(o, vb0, pa0, pa1, pa2, pa3); PREP(PX0, PX1, (t)); partialSM(PX0, PX1, m_reg, mnX, alX);                   \
        __syncthreads();                                                                                                      \
        if ((t) + 1 < NT) { VM_WAIT(); SWRITE_H(SB); }                                                                        \
        RESC(alX); __syncthreads(); } while (0)
    for (int t = 1; t + 1 < NT; t += 2) {
        HALF_STEP(pB0, pB1, mnB, alB, pA0, pA1, alA, t, 1, 0, 0);
        HALF_STEP(pA0, pA1, mnA, alA, pB0, pB1, alB, t + 1, 0, 1, 1);
    }
    const bool even = (NT & 1) == 0;
    if (even) { SBAR(); qkt<1>(pB0, pB1, K_lds, r32, hi, qr); SBAR(); }
    finishSM(pA0, pA1, alA, l_reg, pa0, pa1, pa2, pa3); SBAR();
    pv_tile<0>(o, vb0, pa0, pa1, pa2, pa3);
    if (even) { PREP(pB0, pB1, NT - 1); partialSM(pB0, pB1, m_reg, mnB, alB); __syncthreads(); RESC(alB);
        finishSM(pB0, pB1, alB, l_reg, pa0, pa1, pa2, pa3); SBAR(); pv_tile<1>(o, vb0, pa0, pa1, pa2, pa3); }
    SBAR();
    if (hi == 0) li_l[r32] = l_reg; asm volatile("s_waitcnt lgkmcnt(0)" ::: "memory");
    float rli[16];
#pragma unroll
    for (int r = 0; r < 16; ++r) rli[r] = __builtin_amdgcn_rcpf(li_l[crow(r, hi)]);
    unsigned ob = (unsigned)((wid * QBLK + 4 * hi) * OP + r32);
    asm volatile("" : "+v"(ob));
    char* pb = (char*)O + ob;
#pragma unroll
    for (int r = 0; r < 16; ++r) { char* pr = pb + (size_t)((r & 3) + 8 * (r >> 2)) * OP;
#pragma unroll
        for (int d0 = 0; d0 < 4; ++d0) { const float v = o[d0][r] * (rli[r] * 16.0f);
            const float v1 = pg8::quad_xor1(v), v2 = pg8::quad_xor2(v), v3 = pg8::quad_xor3(v);
            if ((r32 & 3) == 0) *(unsigned*)(pr + d0 * 32) = pg8::pk4_fp8(v, v1, v2, v3); } }
    __syncthreads();
#undef ROW
#undef SLOAD_H
#undef SWRITE_HK
#undef SWRITE_HV
#undef SWRITE_H
#undef RESC
#undef KBASE
#undef PREP
#undef HALF_STEP
}
}
constexpr int NWAVES = 8, NTHREADS = 512;
constexpr int BATCH = 2, T = 8192, M = BATCH * T, DM = 2048;
constexpr int NQKV0 = 6144, WIN0_PITCH = 6152, FF0 = 5632, NIN1 = 1104, NIN1P = 1280, NQ1 = 9216, NEXP = 8, FFE = 7168;
constexpr int MAXROWS = 34816;
constexpr float ALPHA = 1.4142135623730951f;
constexpr float LN_EPS = 1e-5f, RMS_EPS = 1e-6f;
constexpr float LOG2E = 1.4426950408889634f;
constexpr size_t MiB = 1u << 20;
constexpr size_t WS_CTL = 0, CTL_ZERO_BYTES = 1 * MiB;
constexpr size_t WS_WIN0 = 2 * MiB, WS_WOUT0 = 26 * MiB, WS_WFF13 = 34 * MiB, WS_WFF2 = 78 * MiB, WS_WIN1 = 100 * MiB, WS_WQ1 = 105 * MiB, WS_WUV = 114 * MiB, WS_WOUT1 = 118 * MiB,
                 WS_WE13 = 126 * MiB, WS_WE2 = 574 * MiB, WS_XB = 798 * MiB, WS_SMALL = 862 * MiB, WS_BIG = 896 * MiB;
constexpr size_t SM_LOGF = WS_SMALL, SM_CL2 = SM_LOGF + (size_t)M * 8 * 4, SM_KMEAN = SM_CL2 + 16 * 8192 * 4, SM_QN = SM_KMEAN + 16 * 32 * 128 * 4, SM_KN = SM_QN + 16 * 32 * 4,
                 SM_WIDX = SM_KN + 16 * 32 * 4 + 3072, SM_KIDX = SM_WIDX + (size_t)M * 16 * 4, SM_RTE = SM_KIDX + (size_t)M * 64 * 2, SM_RTG = SM_RTE + (size_t)M * 2 * 4, SM_RTP = SM_RTG + (size_t)M * 2 * 4,
                 SM_ROW = SM_RTP + (size_t)M * 2 * 4, SM_SEL = SM_ROW + (size_t)M * 2 * 4, SM_STAT = SM_SEL + (size_t)M * 256 * 4, SM_END = SM_STAT + (size_t)M * 2 * 4;
static_assert(SM_END <= WS_BIG, "small region");
constexpr size_t B0_QKV = WS_BIG, B0_O = WS_BIG + 192 * MiB, B0_ACT = WS_BIG + 256 * MiB;
constexpr size_t B1_PROJ = WS_BIG, B1_CQN = WS_BIG + 80 * MiB, B1_CKVN = WS_BIG + 96 * MiB, B1_QIDX = WS_BIG + 112 * MiB, B1_QLAT = WS_BIG + 144 * MiB, B1_SC = WS_BIG + 400 * MiB, B1_OB = WS_BIG;
constexpr size_t SC_PER_BATCH = (size_t)16384 * (64 * 65 / 2);
static_assert(B1_SC + 2 * SC_PER_BATCH * 4 <= WS_BIG + 662 * MiB, "scores");
constexpr size_t B1_XG = WS_BIG, B1_H = WS_BIG + 136 * MiB, B1_Y = WS_BIG;
constexpr size_t B1_SLAB = WS_BIG + 614 * MiB;
constexpr size_t WS_NEED = WS_BIG + 680 * MiB;
constexpr int CW_BAR = 4096, CW_CNT = 8192, CW_QIDX = 12288, CW_QTOPK = 12352, CW_FLAG = 16384;
constexpr int LDS_BYTES = 147456, SCR_BYTES = 143360, MISC_OFF = SCR_BYTES;

struct Args { const float* in[28]; float* out; unsigned char* ws; int ph_lo, ph_hi; };
struct Ctx {
    LAS unsigned char* lds; unsigned char* ldsg; unsigned char* ws; float* out;
    int tid, lane, wave, G, bid;
};

__device__ __forceinline__ void transpose_item(const float* W, int ldw, int Nsrc, int Ndst, bf16_t* WT, int ldt, int koff, int mode, int row_off, int zero_koff, LAS float* scr, int item, int lane) {
    const int nblk = Ndst / 32, kb = item / nblk, nb = item % nblk, k0 = 64 * kb, n0 = 32 * nb;
    const int ncol = n0 + (lane & 31); const bool ok = ncol < Nsrc;
    float tv[32];
#pragma unroll
    for (int i = 0; i < 32; ++i) { const int kk = 2 * i + (lane >> 5); tv[i] = ok ? W[(size_t)(k0 + kk) * ldw + ncol] : 0.f; }
#pragma unroll
    for (int i = 0; i < 32; ++i) { const int kk = 2 * i + (lane >> 5); scr[kk * 33 + (lane & 31)] = tv[i]; }
    LDS_WAIT(); asm volatile("" ::: "memory");
    const int c = lane & 7;
#pragma unroll
    for (int j = 0; j < 4; ++j) { const int n = (lane >> 3) + 8 * j; const LAS float* s = scr + (8 * c) * 33 + n;
        u32x4 o; o.x = pk2(s[0 * 33], s[1 * 33]); o.y = pk2(s[2 * 33], s[3 * 33]); o.z = pk2(s[4 * 33], s[5 * 33]); o.w = pk2(s[6 * 33], s[7 * 33]);
        const int nn = n0 + n; const int drow = mode ? ((nn >> 7) * 256 + row_off + (nn & 127)) : (row_off + nn);
        *(GAS u32x4*)(WT + (size_t)drow * ldt + koff + k0 + 8 * c) = o;
        if (zero_koff >= 0) *(GAS u32x4*)(WT + (size_t)drow * ldt + zero_koff + k0 + 8 * c) = (u32x4){0u, 0u, 0u, 0u}; }
    LDS_WAIT(); asm volatile("" ::: "memory");
}

__device__ __forceinline__ void transpose_item8(const float* W, int ldw, int Ndst, unsigned char* WT, int ldt, int mode, int row_off, LAS float* scr, int item, int lane, int koff = 0, int zero_koff = -1) {
    const int nblk = Ndst / 32, kb = item / nblk, nb = item % nblk, k0 = 64 * kb, n0 = 32 * nb;
    const int ncol = n0 + (lane & 31);
    float tv[32];
#pragma unroll
    for (int i = 0; i < 32; ++i) { const int kk = 2 * i + (lane >> 5); tv[i] = W[(size_t)(k0 + kk) * ldw + ncol]; }
#pragma unroll
    for (int i = 0; i < 32; ++i) { const int kk = 2 * i + (lane >> 5); scr[kk * 33 + (lane & 31)] = tv[i] * 64.0f; }
    LDS_WAIT(); asm volatile("" ::: "memory");
    const int c = lane & 7;
#pragma unroll
    for (int j = 0; j < 4; ++j) { const int n = (lane >> 3) + 8 * j; const LAS float* s = scr + (8 * c) * 33 + n;
        u32x2 o; o.x = pg8::pk4_fp8(s[0 * 33], s[1 * 33], s[2 * 33], s[3 * 33]); o.y = pg8::pk4_fp8(s[4 * 33], s[5 * 33], s[6 * 33], s[7 * 33]);
        const int nn = n0 + n; const int drow = mode ? ((nn >> 7) * 256 + row_off + (nn & 127)) : (row_off + nn);
        *(GAS u32x2*)(WT + (size_t)drow * ldt + koff + k0 + 8 * c) = o;
        if (zero_koff >= 0) *(GAS u32x2*)(WT + (size_t)drow * ldt + zero_koff + k0 + 8 * c) = (u32x2){0u, 0u}; }
    LDS_WAIT(); asm volatile("" ::: "memory");
}
template <bool F8>
__device__ __forceinline__ void transpose_tile(const float* W, int ldw, int Nsrc, void* WTv, int ldt, int koff, int mode, int row_off, int zero_koff, int k0, int n0, LAS float* tile, int tid) {
    constexpr int KT = F8 ? 128 : 64, NI = KT / 8;
    const int wv = tid >> 6, ln = tid & 63;
    float v[NI][4];
#pragma unroll
    for (int i = 0; i < NI; ++i)
#pragma unroll
        for (int e = 0; e < 4; ++e) { const int col = ln + 64 * e; v[i][e] = (n0 + col) < Nsrc ? W[(size_t)(k0 + wv + 8 * i) * ldw + n0 + col] : 0.f; }
#pragma unroll
    for (int i = 0; i < NI; ++i)
#pragma unroll
        for (int e = 0; e < 4; ++e) tile[(wv + 8 * i) * 257 + ln + 64 * e] = v[i][e];
    __syncthreads();
    const int c = tid & 7;
#pragma unroll
    for (int j = 0; j < 4; ++j) { const int n = (tid >> 3) + 64 * j; const int nn = n0 + n; const int drow = mode ? ((nn >> 7) * 256 + row_off + (nn & 127)) : (row_off + nn);
        if constexpr (F8) { const LAS float* s = tile + (16 * c) * 257 + n; u32x4 o;
            o.x = pg8::pk4_fp8(s[0 * 257] * 64.f, s[1 * 257] * 64.f, s[2 * 257] * 64.f, s[3 * 257] * 64.f); o.y = pg8::pk4_fp8(s[4 * 257] * 64.f, s[5 * 257] * 64.f, s[6 * 257] * 64.f, s[7 * 257] * 64.f);
            o.z = pg8::pk4_fp8(s[8 * 257] * 64.f, s[9 * 257] * 64.f, s[10 * 257] * 64.f, s[11 * 257] * 64.f); o.w = pg8::pk4_fp8(s[12 * 257] * 64.f, s[13 * 257] * 64.f, s[14 * 257] * 64.f, s[15 * 257] * 64.f);
            *(GAS u32x4*)((unsigned char*)WTv + (size_t)drow * ldt + koff + k0 + 16 * c) = o; }
        else { const LAS float* s = tile + (8 * c) * 257 + n; u32x4 o;
            o.x = pk2(s[0 * 257], s[1 * 257]); o.y = pk2(s[2 * 257], s[3 * 257]); o.z = pk2(s[4 * 257], s[5 * 257]); o.w = pk2(s[6 * 257], s[7 * 257]);
            *(GAS u32x4*)((bf16_t*)WTv + (size_t)drow * ldt + koff + k0 + 8 * c) = o;
            if (zero_koff >= 0) *(GAS u32x4*)((bf16_t*)WTv + (size_t)drow * ldt + zero_koff + k0 + 8 * c) = (u32x4){0u, 0u, 0u, 0u}; } }
    __syncthreads();
}
struct ProIn { const float *x, *w_in0, *b_forget, *w_out0, *w1, *w3, *w2, *w_in1, *w_uq, *w_qidx, *w_uk, *w_uv, *w_out1, *e1, *e3, *e2; };
__device__ __forceinline__ void phase_prologue(const Ctx& F, const ProIn& I) {
    LAS float* scr = (LAS float*)(F.lds + F.wave * 8448);
    LAS float* wf = (LAS float*)(F.lds + 69632);
    const int gw = F.bid * NWAVES + F.wave, NGW = F.G * NWAVES;
    unsigned char* ws = F.ws;
    for (int i = F.tid; i < 8 * 2048; i += NTHREADS) { const int j = i & 7, k = i >> 3; wf[j * 2048 + k] = I.w_in0[(size_t)k * WIN0_PITCH + 6144 + j]; }
    __syncthreads();
    for (int m = gw; m < M; m += NGW) {
        const GAS f32x4* xr = (const GAS f32x4*)(I.x + (size_t)m * DM) + F.lane;
        f32x4 v[8];
#pragma unroll
        for (int j = 0; j < 8; ++j) v[j] = xr[64 * j];
        GAS u32x2* o8 = (GAS u32x2*)((bf16_t*)(ws + WS_XB) + (size_t)m * DM) + F.lane;
#pragma unroll
        for (int j = 0; j < 8; ++j) { u32x2 w; w.x = pk2(v[j][0], v[j][1]); w.y = pk2(v[j][2], v[j][3]); o8[64 * j] = w; }
        float z = 0.f;
#pragma unroll 1
        for (int h = 0; h < 8; ++h) { float s = 0.f;
#pragma unroll
            for (int j = 0; j < 8; ++j) { const f32x4 w = *(const LAS f32x4*)(wf + h * 2048 + 256 * j + 4 * F.lane); s += v[j][0] * w[0] + v[j][1] * w[1] + v[j][2] * w[2] + v[j][3] * w[3]; }
            s = wave_sum(s); z = (F.lane == h) ? s : z; }
        if (F.lane < 8) {
            z += I.b_forget[F.lane];
            const float lf = z >= 0.f ? -log1pf(expf(-z)) : z - log1pf(expf(z));
            ((float*)(ws + SM_LOGF))[(size_t)m * 8 + F.lane] = lf; }
    }
    __syncthreads();
    {
        LAS float* tile = (LAS float*)F.lds;
        unsigned char* const W_IN0 = ws + WS_WIN0; unsigned char* const W_OUT0 = ws + WS_WOUT0; unsigned char* const W_FF13 = ws + WS_WFF13; unsigned char* const W_FF2 = ws + WS_WFF2;
        unsigned char* const W_IN1 = ws + WS_WIN1; unsigned char* const W_Q1 = ws + WS_WQ1; unsigned char* const W_OUT1 = ws + WS_WOUT1;
        unsigned char* const W_E13 = ws + WS_WE13; unsigned char* const W_E2 = ws + WS_WE2;
        constexpr int T_IN0 = (2048 / 128) * (6144 / 128), T_SQ = (2048 / 128) * (2048 / 128), T_FF = (2048 / 128) * (FF0 / 128), T_FF2 = (FF0 / 128) * (2048 / 128), T_IN1 = (2048 / 128) * (NIN1P / 128),
                      T_QI = (512 / 128) * (1024 / 128), T_E = (2048 / 128) * (FFE / 128), T_E2 = (FFE / 128) * (2048 / 128);
        constexpr int TOT = 8 * (2 * T_E + T_E2) + 2 * T_FF + T_FF2 + T_IN0 + 2 * T_SQ + T_IN1 + T_QI;
#define TILE_DECODE(it_, Wp, ldw_, Nsrc_, Dp, ldt_, f8_, mode_, roff_, k0_, n0_) do { int r = (it_); \
            if (r < 8 * T_E) { const int e = r / T_E, rr = r % T_E, nb = FFE / 128; Wp = I.e1 + (size_t)e * 2048 * FFE; ldw_ = FFE; Nsrc_ = FFE; Dp = W_E13 + (size_t)e * 2 * FFE * 2048; ldt_ = 2048; f8_ = 1; mode_ = 1; roff_ = 0; k0_ = 128 * (rr / nb); n0_ = 128 * (rr % nb); break; } r -= 8 * T_E; \
            if (r < 8 * T_E) { const int e = r / T_E, rr = r % T_E, nb = FFE / 128; Wp = I.e3 + (size_t)e * 2048 * FFE; ldw_ = FFE; Nsrc_ = FFE; Dp = W_E13 + (size_t)e * 2 * FFE * 2048; ldt_ = 2048; f8_ = 1; mode_ = 1; roff_ = 128; k0_ = 128 * (rr / nb); n0_ = 128 * (rr % nb); break; } r -= 8 * T_E; \
            if (r < 8 * T_E2) { const int e = r / T_E2, rr = r % T_E2, nb = 2048 / 128; Wp = I.e2 + (size_t)e * FFE * 2048; ldw_ = 2048; Nsrc_ = 2048; Dp = W_E2 + (size_t)e * 2048 * FFE; ldt_ = FFE; f8_ = 1; mode_ = 0; roff_ = 0; k0_ = 128 * (rr / nb); n0_ = 128 * (rr % nb); break; } r -= 8 * T_E2; \
            if (r < T_FF) { const int nb = FF0 / 128; Wp = I.w1; ldw_ = FF0; Nsrc_ = FF0; Dp = W_FF13; ldt_ = 2048; f8_ = 1; mode_ = 1; roff_ = 0; k0_ = 128 * (r / nb); n0_ = 128 * (r % nb); break; } r -= T_FF; \
            if (r < T_FF) { const int nb = FF0 / 128; Wp = I.w3; ldw_ = FF0; Nsrc_ = FF0; Dp = W_FF13; ldt_ = 2048; f8_ = 1; mode_ = 1; roff_ = 128; k0_ = 128 * (r / nb); n0_ = 128 * (r % nb); break; } r -= T_FF; \
            if (r < T_FF2) { const int nb = 2048 / 128; Wp = I.w2; ldw_ = 2048; Nsrc_ = 2048; Dp = W_FF2; ldt_ = FF0; f8_ = 1; mode_ = 0; roff_ = 0; k0_ = 128 * (r / nb); n0_ = 128 * (r % nb); break; } r -= T_FF2; \
            if (r < T_IN0) { const int nb = 6144 / 128; Wp = I.w_in0; ldw_ = WIN0_PITCH; Nsrc_ = 6144; Dp = W_IN0; ldt_ = 2048; f8_ = 0; mode_ = 0; roff_ = 0; k0_ = 128 * (r / nb); n0_ = 128 * (r % nb); break; } r -= T_IN0; \
            if (r < T_SQ) { const int nb = 2048 / 128; Wp = I.w_out0; ldw_ = 2048; Nsrc_ = 2048; Dp = W_OUT0; ldt_ = 2048; f8_ = 1; mode_ = 0; roff_ = 0; k0_ = 128 * (r / nb); n0_ = 128 * (r % nb); break; } r -= T_SQ; \
            if (r < T_SQ) { const int nb = 2048 / 128; Wp = I.w_out1; ldw_ = 2048; Nsrc_ = 2048; Dp = W_OUT1; ldt_ = 2048; f8_ = 1; mode_ = 0; roff_ = 0; k0_ = 128 * (r / nb); n0_ = 128 * (r % nb); break; } r -= T_SQ; \
            if (r < T_IN1) { const int nb = NIN1P / 128; Wp = I.w_in1; ldw_ = NIN1; Nsrc_ = NIN1; Dp = W_IN1; ldt_ = 2048; f8_ = 0; mode_ = 0; roff_ = 0; k0_ = 128 * (r / nb); n0_ = 128 * (r % nb); break; } r -= T_IN1; \
            { const int nb = 1024 / 128; Wp = I.w_qidx; ldw_ = 1024; Nsrc_ = 1024; Dp = W_Q1; ldt_ = 512; f8_ = 0; mode_ = 0; roff_ = 8192; k0_ = 128 * (r / nb); n0_ = 128 * (r % nb); } } while (0)
        const int wv = F.wave, ln = F.lane, tid = F.tid;
        float v[16][2];
#define TILE_LOAD(it_) do { const float* Wp; unsigned char* Dp; int ldw_, Nsrc_, ldt_, f8_, mode_, roff_, k0_, n0_; TILE_DECODE(it_, Wp, ldw_, Nsrc_, Dp, ldt_, f8_, mode_, roff_, k0_, n0_); (void)Dp; (void)ldt_; (void)f8_; (void)mode_; (void)roff_; \
            _Pragma("unroll") for (int i = 0; i < 16; ++i) _Pragma("unroll") for (int e = 0; e < 2; ++e) { const int col = n0_ + ln + 64 * e; v[i][e] = col < Nsrc_ ? Wp[(size_t)(k0_ + wv + 8 * i) * ldw_ + col] : 0.f; } } while (0)
        int it = F.bid;
        if (it < TOT) {
            TILE_LOAD(it);
#pragma unroll
            for (int i = 0; i < 16; ++i) { tile[(wv + 8 * i) * 129 + ln] = v[i][0]; tile[(wv + 8 * i) * 129 + ln + 64] = v[i][1]; }
            __syncthreads();
            for (;;) {
                const int nx = it + F.G; const bool more = nx < TOT;
                if (more) TILE_LOAD(nx);
                { const float* Wp; unsigned char* Dp; int ldw_, Nsrc_, ldt_, f8_, mode_, roff_, k0_, n0_; TILE_DECODE(it, Wp, ldw_, Nsrc_, Dp, ldt_, f8_, mode_, roff_, k0_, n0_); (void)Wp; (void)ldw_; (void)Nsrc_;
                  if (f8_) { const int c = tid & 7;
#pragma unroll
                      for (int j = 0; j < 2; ++j) { const int n = (tid >> 3) + 64 * j, nn = n0_ + n; const int drow = mode_ ? ((nn >> 7) * 256 + roff_ + (nn & 127)) : (roff_ + nn);
                          const LAS float* s = tile + (16 * c) * 129 + n; u32x4 o;
                          o.x = pg8::pk4_fp8(s[0 * 129] * 64.f, s[1 * 129] * 64.f, s[2 * 129] * 64.f, s[3 * 129] * 64.f); o.y = pg8::pk4_fp8(s[4 * 129] * 64.f, s[5 * 129] * 64.f, s[6 * 129] * 64.f, s[7 * 129] * 64.f);
                          o.z = pg8::pk4_fp8(s[8 * 129] * 64.f, s[9 * 129] * 64.f, s[10 * 129] * 64.f, s[11 * 129] * 64.f); o.w = pg8::pk4_fp8(s[12 * 129] * 64.f, s[13 * 129] * 64.f, s[14 * 129] * 64.f, s[15 * 129] * 64.f);
                          *(GAS u32x4*)(Dp + (size_t)drow * ldt_ + k0_ + 16 * c) = o; } }
                  else { const int c = tid & 15;
#pragma unroll
                      for (int j = 0; j < 4; ++j) { const int n = (tid >> 4) + 32 * j, nn = n0_ + n; const int drow = roff_ + nn;
                          const LAS float* s = tile + (8 * c) * 129 + n; u32x4 o;
                          o.x = pk2(s[0 * 129], s[1 * 129]); o.y = pk2(s[2 * 129], s[3 * 129]); o.z = pk2(s[4 * 129], s[5 * 129]); o.w = pk2(s[6 * 129], s[7 * 129]);
                          *(GAS u32x4*)(Dp + ((size_t)drow * ldt_ + k0_ + 8 * c) * 2) = o; } } }
                if (!more) break;
                __syncthreads();
#pragma unroll
                for (int i = 0; i < 16; ++i) { tile[(wv + 8 * i) * 129 + ln] = v[i][0]; tile[(wv + 8 * i) * 129 + ln + 64] = v[i][1]; }
                __syncthreads();
                it = nx;
            }
        }
        __syncthreads();
#undef TILE_LOAD
#undef TILE_DECODE
        bf16_t* const W_UV = (bf16_t*)(ws + WS_WUV);
        { LAS float* scr = (LAS float*)(F.lds + F.wave * 8448); constexpr int I_UV = (512 / 64) * (128 / 32);
          for (int it = gw; it < 16 * I_UV; it += NGW) { const int h = it / I_UV, rr = it % I_UV;
              transpose_item8(I.w_uv + (size_t)h * 512 * 128, 128, 128, (unsigned char*)W_UV, 1024, 0, h * 128, scr, rr, F.lane, (h & 1) * 512, ((h & 1) ^ 1) * 512); } }
    }
    {
        const float* wuq = I.w_uq; const float* wuk = I.w_uk; bf16_t* WQ = (bf16_t*)(ws + WS_WQ1);
        constexpr float C2s = 0.08838834764831845f * LOG2E;
        const int l15 = F.lane & 15, l4 = F.lane >> 4;
        for (int it = gw; it < 16 * 16 * 16; it += NGW) {
            const int h = it >> 8, rt = (it >> 4) & 15, jt = it & 15;
            f32x4 acc[2][2] = {};
            const float* ap = wuk + ((size_t)h * 512 + rt * 32 + l15) * 128 + 4 * l4;
            const float* bp = wuq + (size_t)(jt * 32 + l15) * 2048 + h * 128 + 4 * l4;
#pragma unroll 2
            for (int J = 0; J < 8; ++J) {
                const f32x4 a0 = *(const f32x4*)(ap + 16 * J), a1 = *(const f32x4*)(ap + 16 * 128 + 16 * J), b0 = *(const f32x4*)(bp + 16 * J), b1 = *(const f32x4*)(bp + (size_t)16 * 2048 + 16 * J);
#pragma unroll
                for (int e = 0; e < 4; ++e) {
                    acc[0][0] = __builtin_amdgcn_mfma_f32_16x16x4f32(a0[e], b0[e], acc[0][0], 0, 0, 0); acc[0][1] = __builtin_amdgcn_mfma_f32_16x16x4f32(a0[e], b1[e], acc[0][1], 0, 0, 0);
                    acc[1][0] = __builtin_amdgcn_mfma_f32_16x16x4f32(a1[e], b0[e], acc[1][0], 0, 0, 0); acc[1][1] = __builtin_amdgcn_mfma_f32_16x16x4f32(a1[e], b1[e], acc[1][1], 0, 0, 0); }
            }
#pragma unroll
            for (int a = 0; a < 2; ++a)
#pragma unroll
                for (int b = 0; b < 2; ++b)
#pragma unroll
                    for (int e = 0; e < 4; ++e) { const int r = rt * 32 + a * 16 + l4 * 4 + e, j = jt * 32 + b * 16 + l15;
                        WQ[(size_t)(h * 512 + r) * 512 + j] = (bf16_t)f2bf(acc[a][b][e] * C2s); }
        }
    }
}

__device__ __forceinline__ void phase_pre0(const Ctx& F) {
    unsigned char* ws = F.ws;
    LAS float* red = (LAS float*)F.lds;
    for (int job = F.bid; job < 16 + 256; job += F.G) {
        if (job < 16) {
            const int b = job >> 3, h = job & 7; const float* lf = (const float*)(ws + SM_LOGF) + (size_t)b * T * 8 + h;
            float v[16]; float s = 0.f;
#pragma unroll
            for (int i = 0; i < 16; ++i) { s += lf[(size_t)(F.tid * 16 + i) * 8]; v[i] = s; }
            float inc = s;
#pragma unroll
            for (int o = 1; o < 64; o <<= 1) { const float t = __shfl_up(inc, o); if (F.lane >= o) inc += t; }
            if (F.lane == 63) red[F.wave] = inc;
            __syncthreads();
            float base = 0.f;
            for (int w = 0; w < F.wave; ++w) base += red[w];
            base += inc - s;
            float* cl = (float*)(ws + SM_CL2) + (size_t)job * 8192 + F.tid * 16;
#pragma unroll
            for (int i = 0; i < 16; ++i) cl[i] = (base + v[i]) * LOG2E;
            __syncthreads();
        } else {
            const int jj = job - 16;
            for (int half = 0; half < 2; ++half) {
                const int bh = jj >> 4, blk = (jj & 15) * 2 + half;
                const bf16_t* kA = (const bf16_t*)(ws + B0_QKV) + ((size_t)(1 * 16 + bh) * 8192 + blk * 256) * 128;
                const bf16_t* qB = (const bf16_t*)(ws + B0_QKV) + ((size_t)(3 * 16 + bh) * 8192 + blk * 256) * 128;
                const bf16_t* kB = (const bf16_t*)(ws + B0_QKV) + ((size_t)(4 * 16 + bh) * 8192 + blk * 256) * 128;
                const int rg = F.tid >> 4, c8 = F.tid & 15;
                float cs[8] = {0, 0, 0, 0, 0, 0, 0, 0}; float qm = 0.f, km = 0.f;
                for (int i = 0; i < 8; ++i) { const int row = rg * 8 + i;
                    const u32x4 a = *(const u32x4*)(kA + (size_t)row * 128 + c8 * 8), q = *(const u32x4*)(qB + (size_t)row * 128 + c8 * 8), k = *(const u32x4*)(kB + (size_t)row * 128 + c8 * 8);
                    float sq = 0.f, sk = 0.f;
#pragma unroll
                    for (int e = 0; e < 4; ++e) { cs[2 * e] += bflo(a[e]); cs[2 * e + 1] += bfhi(a[e]);
                        sq += bflo(q[e]) * bflo(q[e]) + bfhi(q[e]) * bfhi(q[e]); sk += bflo(k[e]) * bflo(k[e]) + bfhi(k[e]) * bfhi(k[e]); }
#pragma unroll
                    for (int o = 1; o < 16; o <<= 1) { sq += __shfl_xor(sq, o); sk += __shfl_xor(sk, o); }
                    qm = fmaxf(qm, sq); km = fmaxf(km, sk); }
#pragma unroll
                for (int e = 0; e < 8; ++e) red[rg * 128 + c8 * 8 + e] = cs[e];
                qm = wave_max(qm); km = wave_max(km);
                if (F.lane == 0) { red[4096 + F.wave] = qm; red[4096 + 8 + F.wave] = km; }
                __syncthreads();
                if (F.tid < 128) { float s = 0.f; for (int g = 0; g < 32; ++g) s += red[g * 128 + F.tid]; ((float*)(ws + SM_KMEAN))[((size_t)bh * 32 + blk) * 128 + F.tid] = s * (1.0f / 256.0f); }
                if (F.tid == 128) { float a = 0.f, k = 0.f; for (int w = 0; w < 8; ++w) { a = fmaxf(a, red[4096 + w]); k = fmaxf(k, red[4096 + 8 + w]); }
                    ((float*)(ws + SM_QN))[bh * 32 + blk] = a; ((float*)(ws + SM_KN))[bh * 32 + blk] = k; }
                __syncthreads();
            }
        }
    }
}

__device__ __forceinline__ int rel_bucket_dev(int n) {
    if (n < 16) return n;
    const int l = 16 + (int)(logf((float)n / 16.0f) / 2.0794415416798357f * 16.0f);
    return l > 31 ? 31 : l;
}

#define ATT_COMMON() \
    unsigned char* ws = F.ws; char* lds = (char*)F.ldsg; \
    const bf16_t* QKV = (const bf16_t*)(ws + B0_QKV); unsigned char* O = ws + B0_O; \
    LAS float* ncl = (LAS float*)(F.lds + att::OFF_NCL); LAS float* lut = (LAS float*)(F.lds + att::OFF_LUT); LAS float* kmL = (LAS float*)(F.lds + att::OFF_KM); LAS int* misc = (LAS int*)(F.lds + att::OFF_MISC); \
    const size_t TSTR = (size_t)16 * 8192 * 128; \
    const int tid0 = F.tid;
#define ATT_LANE() int tid = tid0; asm volatile("" : "+v"(tid)); const int wid = __builtin_amdgcn_readfirstlane(tid >> 6), lane = tid & 63, r32 = lane & 31, hi = lane >> 5;
__device__ __forceinline__ void phase_attn0_moba(const Ctx& F, const float* tab) {
    ATT_COMMON()
    for (int u = F.bid; u < 256; u += F.G) {
        const int bh = u >> 4, b = bh >> 3, h = bh & 7;
        for (int i = tid0; i < 129; i += NTHREADS) lut[i] = tab[rel_bucket_dev(i) * 16 + h] * LOG2E;
        const float farL = tab[31 * 16 + h] * LOG2E;
        for (int pass = 0; pass < 2; ++pass) {
            ATT_LANE()
            const int qb = pass ? 31 - (u & 15) : (u & 15), P0 = qb * 256;
            const bf16_t* Qp = QKV + 0 * TSTR + ((size_t)bh * 8192 + P0) * 128; const bf16_t* Kh = QKV + 1 * TSTR + (size_t)bh * 8192 * 128; const bf16_t* Vh = QKV + 2 * TSTR + (size_t)bh * 8192 * 128;
            for (int i = tid; i < qb * 128; i += NTHREADS) kmL[i] = ((const float*)(ws + SM_KMEAN))[(size_t)bh * 32 * 128 + i];
            bf16x8 qr[8];
#pragma unroll
            for (int d0 = 0; d0 < 8; ++d0) qr[d0] = att::load8(Qp + (size_t)(wid * 32 + r32) * 128 + d0 * 16 + hi * 8);
            __syncthreads();
            float g1 = -__builtin_inff(), g2 = g1, g3 = g1; int i1 = -1, i2 = -1, i3 = -1;
            for (int blk = 0; blk < qb; ++blk) {
                float g = 0.f; const LAS float* km = kmL + blk * 128 + hi * 8;
#pragma unroll
                for (int d0 = 0; d0 < 8; ++d0) { const f32x4 k0 = *(const LAS f32x4*)(km + d0 * 16), k1 = *(const LAS f32x4*)(km + d0 * 16 + 4); const u32x4 q = *reinterpret_cast<const u32x4*>(&qr[d0]);
                    g += bflo(q[0]) * k0[0] + bfhi(q[0]) * k0[1] + bflo(q[1]) * k0[2] + bfhi(q[1]) * k0[3] + bflo(q[2]) * k1[0] + bfhi(q[2]) * k1[1] + bflo(q[3]) * k1[2] + bfhi(q[3]) * k1[3]; }
                g += __shfl_xor(g, 32);
                if (g > g1) { g3 = g2; i3 = i2; g2 = g1; i2 = i1; g1 = g; i1 = blk; }
                else if (g > g2) { g3 = g2; i3 = i2; g2 = g; i2 = blk; }
                else if (g > g3) { g3 = g; i3 = blk; }
            }
            unsigned selmask = 1u << qb;
            if (i1 >= 0) selmask |= 1u << i1; if (i2 >= 0) selmask |= 1u << i2; if (i3 >= 0) selmask |= 1u << i3;
            att::attn_block<1, 2048>(Qp, Kh, Vh, O + ((size_t)b * 8192 + P0) * 2048 + h * 128, P0, 0, (P0 + 255) / 64 + 1, lds, ncl, 0, lut, selmask, farL, qr, tid);
        }
    }
}
__device__ __forceinline__ void phase_attn0_fox(const Ctx& F) {
    ATT_COMMON()
    for (int u = F.bid; u < 512; u += F.G) {
        ATT_LANE()
        const int bh = u >> 5, b = bh >> 3, h = bh & 7, qb = 31 - (u & 31), P0 = qb * 256;
        const float* cl2 = (const float*)(ws + SM_CL2) + (size_t)bh * 8192;
        const bf16_t* Qp = QKV + 3 * TSTR + ((size_t)bh * 8192 + P0) * 128; const bf16_t* Kh = QKV + 4 * TSTR + (size_t)bh * 8192 * 128; const bf16_t* Vh = QKV + 5 * TSTR + (size_t)bh * 8192 * 128;
        const float ref = cl2[P0];
        if (wid == 0) {
            float kmax = 0.f; for (int i = lane; i <= qb; i += 64) kmax = fmaxf(kmax, ((const float*)(ws + SM_KN))[bh * 32 + i]);
            kmax = wave_max(kmax);
            const float qmax = ((const float*)(ws + SM_QN))[bh * 32 + qb];
            const float B2 = (105.0f + 2.0f * sqrtf(qmax * kmax) * att::SCALE * 1.0001f) * LOG2E;
            const int ntile = P0 / 64; int first = ntile;
            for (int base = 0; base < ntile; base += 64) { const int J = base + lane; const bool need = (J < ntile) && (cl2[64 * J + 63] - ref <= B2);
                const unsigned long long bal = __ballot(need); if (bal) { first = base + __builtin_ctzll(bal); break; } }
            if (lane == 0) misc[0] = first;
        }
        bf16x8 qr[8];
#pragma unroll
        for (int d0 = 0; d0 < 8; ++d0) qr[d0] = att::load8(Qp + (size_t)(wid * 32 + r32) * 128 + d0 * 16 + hi * 8);
        __syncthreads();
        const int j_lo = __builtin_amdgcn_readfirstlane(misc[0]), nclbase = j_lo * 64;
        for (int k = nclbase + tid; k < P0 + 256; k += NTHREADS) ncl[k - nclbase] = ref - cl2[k];
        att::attn_block<0, 2048>(Qp, Kh, Vh, O + ((size_t)b * 8192 + P0) * 2048 + 1024 + h * 128, P0, j_lo, (P0 + 255) / 64 + 1, lds, ncl, nclbase, lut, 0u, 0.f, qr, tid);
    }
}

__device__ __forceinline__ void ln_row(const f32x4 (&v)[8], const float* g, const float* bta, int lane, f32x4 (&y)[8], float* stat = nullptr) {
    float s = 0.f;
#pragma unroll
    for (int j = 0; j < 8; ++j) s += (v[j][0] + v[j][1]) + (v[j][2] + v[j][3]);
    const float mean = wave_sum(s) * (1.f / DM); float s2 = 0.f;
#pragma unroll
    for (int j = 0; j < 8; ++j) { const f32x4 d = v[j] - mean; s2 += (d[0] * d[0] + d[1] * d[1]) + (d[2] * d[2] + d[3] * d[3]); }
    const float rstd = 1.0f / sqrtf(wave_sum(s2) * (1.f / DM) + LN_EPS);
    if (stat != nullptr && lane == 0) { stat[0] = mean; stat[1] = rstd; }
#pragma unroll
    for (int j = 0; j < 8; ++j) { const f32x4 gg = *(const f32x4*)(g + 256 * j + 4 * lane), bb = *(const f32x4*)(bta + 256 * j + 4 * lane); y[j] = (v[j] - mean) * rstd * gg + bb; }
}
template <bool OUT8>
__device__ __forceinline__ void phase_ln(const Ctx& F, const float* g, const float* bta) {
    const int gw = F.bid * NWAVES + F.wave, NGW = F.G * NWAVES;
    for (int m = gw; m < M; m += NGW) {
        GAS f32x4* xr = (GAS f32x4*)(F.out + (size_t)m * DM) + F.lane;
        f32x4 v[8], y[8];
#pragma unroll
        for (int j = 0; j < 8; ++j) v[j] = xr[64 * j];
        ln_row(v, g, bta, F.lane, y, (float*)(F.ws + SM_STAT) + 2 * (size_t)m);
        if constexpr (OUT8) { GAS unsigned* o8 = (GAS unsigned*)(F.ws + WS_XB + (size_t)m * DM) + F.lane;
#pragma unroll
            for (int j = 0; j < 8; ++j) o8[64 * j] = pg8::pk4_fp8(y[j][0], y[j][1], y[j][2], y[j][3]); }
        else { GAS u32x2* o8 = (GAS u32x2*)((bf16_t*)(F.ws + WS_XB) + (size_t)m * DM) + F.lane;
#pragma unroll
            for (int j = 0; j < 8; ++j) { u32x2 w; w.x = pk2(y[j][0], y[j][1]); w.y = pk2(y[j][2], y[j][3]); o8[64 * j] = w; } }
    }
}
__device__ __forceinline__ void phase_ln_router(const Ctx& F, const float* g, const float* bta, const float* router) {
    const int gw = F.bid * NWAVES + F.wave, NGW = F.G * NWAVES;
    LAS float* wr = (LAS float*)F.lds;
    LAS unsigned* lcnt = (LAS unsigned*)(F.lds + 65536);
    LAS unsigned* rec = (LAS unsigned*)(F.lds + 65536 + 64) + F.wave * 64;
    for (int i = F.tid; i < 8 * 2048; i += NTHREADS) { const int j = i & 7, k = i >> 3; wr[j * 2048 + k] = router[(size_t)k * 8 + j]; }
    if (F.tid < 16) lcnt[F.tid] = 0u;
    __syncthreads();
    unsigned* cnt = (unsigned*)(F.ws + WS_CTL) + CW_CNT;
    const int nrow = (M - gw + NGW - 1) / NGW;
    const bool local = nrow <= 64;
    f32x4 v[8], vn[8];
    if (gw < M) { const GAS f32x4* xr = (const GAS f32x4*)(F.out + (size_t)gw * DM) + F.lane;
#pragma unroll
        for (int j = 0; j < 8; ++j) v[j] = xr[64 * j]; }
    int ri = 0;
    for (int m = gw; m < M; m += NGW, ++ri) {
        const int mn = m + NGW;
        if (mn < M) { const GAS f32x4* xn = (const GAS f32x4*)(F.out + (size_t)mn * DM) + F.lane;
#pragma unroll
            for (int j = 0; j < 8; ++j) vn[j] = xn[64 * j]; }
        f32x4 y[8];
        ln_row(v, g, bta, F.lane, y, (float*)(F.ws + SM_STAT) + 2 * (size_t)m);
        GAS unsigned* o8 = (GAS unsigned*)(F.ws + WS_XB + (size_t)m * DM) + F.lane;
#pragma unroll
        for (int j = 0; j < 8; ++j) o8[64 * j] = pg8::pk4_fp8(y[j][0], y[j][1], y[j][2], y[j][3]);
        float mylg = 0.f;
#pragma unroll 1
        for (int e = 0; e < 8; ++e) { float s = 0.f;
#pragma unroll
            for (int j = 0; j < 8; ++j) { const f32x4 w = *(const LAS f32x4*)(wr + e * 2048 + 256 * j + 4 * F.lane); s += y[j][0] * w[0] + y[j][1] * w[1] + y[j][2] * w[2] + y[j][3] * w[3]; }
            s = wave_sum(s); mylg = (F.lane == e) ? s : mylg; }
        float lg[8];
#pragma unroll
        for (int e = 0; e < 8; ++e) lg[e] = __builtin_bit_cast(float, __builtin_amdgcn_readlane(__builtin_bit_cast(int, mylg), e));
        if (F.lane == 0) {
            int e0 = 0; float l0 = lg[0];
#pragma unroll
            for (int e = 1; e < 8; ++e) if (lg[e] > l0) { l0 = lg[e]; e0 = e; }
            int e1 = -1; float l1 = -__builtin_inff();
#pragma unroll
            for (int e = 0; e < 8; ++e) if (e != e0 && lg[e] > l1) { l1 = lg[e]; e1 = e; }
            const float ex = expf(l1 - l0), g0 = 1.0f / (1.0f + ex), g1 = ex / (1.0f + ex);
            int* rte = (int*)(F.ws + SM_RTE) + (size_t)m * 2; float* rtg = (float*)(F.ws + SM_RTG) + (size_t)m * 2;
            rte[0] = e0; rte[1] = e1; rtg[0] = g0; rtg[1] = g1;
            if (local) {
                const unsigned r0 = __hip_atomic_fetch_add(lcnt + e0, 1u, __ATOMIC_RELAXED, __HIP_MEMORY_SCOPE_WORKGROUP), r1 = __hip_atomic_fetch_add(lcnt + e1, 1u, __ATOMIC_RELAXED, __HIP_MEMORY_SCOPE_WORKGROUP);
                rec[ri] = (unsigned)e0 | ((unsigned)e1 << 4) | (r0 << 8) | (r1 << 20);
            } else {
                const unsigned p0 = __hip_atomic_fetch_add(cnt + 64 * e0, 1u, RLX_AGENT), p1 = __hip_atomic_fetch_add(cnt + 64 * e1, 1u, RLX_AGENT);
                int* rtp = (int*)(F.ws + SM_RTP) + (size_t)m * 2; rtp[0] = (int)p0; rtp[1] = (int)p1;
            }
        }
#pragma unroll
        for (int j = 0; j < 8; ++j) v[j] = vn[j];
    }
    __syncthreads();
    if (F.tid < 8) lcnt[8 + F.tid] = __hip_atomic_fetch_add(cnt + 64 * F.tid, lcnt[F.tid], RLX_AGENT);
    __syncthreads();
    if (local && F.lane < nrow) { const int m = gw + F.lane * NGW; const unsigned r = rec[F.lane];
        int* rtp = (int*)(F.ws + SM_RTP) + (size_t)m * 2;
        rtp[0] = (int)(lcnt[8 + (r & 15u)] + ((r >> 8) & 0xFFFu)); rtp[1] = (int)(lcnt[8 + ((r >> 4) & 15u)] + (r >> 20)); }
}
__device__ __forceinline__ void moe_tstart(const Ctx& F, int (&ts)[9]) {
    const unsigned* cnt = (const unsigned*)(F.ws + WS_CTL) + CW_CNT; int a = 0;
#pragma unroll
    for (int e = 0; e < 8; ++e) { ts[e] = a; a += ((int)__hip_atomic_load(cnt + 64 * e, RLX_AGENT) + 255) >> 8; }
    ts[8] = a;
}
__device__ __forceinline__ void phase_gather(const Ctx& F) {
    int ts[9]; moe_tstart(F, ts);
    const int gw = F.bid * NWAVES + F.wave, NGW = F.G * NWAVES;
    const int* rte = (const int*)(F.ws + SM_RTE); const int* rtp = (const int*)(F.ws + SM_RTP); int* rrow = (int*)(F.ws + SM_ROW);
    for (int a = gw; a < 2 * M; a += NGW) {
        const int m = a >> 1, e = rte[a], p = rtp[a]; int st = 0;
#pragma unroll
        for (int j = 0; j < 8; ++j) st = (e == j) ? ts[j] : st;
        const int row = st * 256 + p;
        const GAS u32x4* src = (const GAS u32x4*)(F.ws + WS_XB + (size_t)m * DM) + F.lane;
        GAS u32x4* dst = (GAS u32x4*)(F.ws + B1_XG + (size_t)row * DM) + F.lane;
#pragma unroll
        for (int j = 0; j < 2; ++j) dst[64 * j] = src[64 * j];
        if (F.lane == 0) rrow[a] = row;
    }
}
__device__ __forceinline__ void phase_final(const Ctx& F, const float* g, const float* bta, const int S, const float* gp, const float* bp) {
    const int gw = F.bid * NWAVES + F.wave, NGW = F.G * NWAVES;
    const int* rrow = (const int*)(F.ws + SM_ROW); const float* rtg = (const float*)(F.ws + SM_RTG); const bf16_t* Y = (const bf16_t*)(F.ws + B1_Y);
    const unsigned* flags = (const unsigned*)(F.ws + WS_CTL) + CW_FLAG; const float* slabs = (const float*)(F.ws + B1_SLAB);
    for (int m = gw; m < M; m += NGW) {
        GAS f32x4* xr = (GAS f32x4*)(F.out + (size_t)m * DM) + F.lane;
        const int r0 = rrow[2 * m], r1 = rrow[2 * m + 1]; const float g0 = rtg[2 * m], g1 = rtg[2 * m + 1];
        const float pmean = ((const float*)(F.ws + SM_STAT))[2 * (size_t)m], prstd = ((const float*)(F.ws + SM_STAT))[2 * (size_t)m + 1];
        int lz = F.lane; asm volatile("" : "+v"(lz));
        const float* gpl = gp + 4 * lz; const float* bpl = bp + 4 * lz;
        const GAS u32x2* y0 = (const GAS u32x2*)(Y + (size_t)r0 * DM) + F.lane; const GAS u32x2* y1 = (const GAS u32x2*)(Y + (size_t)r1 * DM) + F.lane;
        f32x4 v[8], y[8];
        const unsigned* fl0 = flags + (r0 >> 8) * 8; const unsigned* fl1 = flags + (r1 >> 8) * 8;
#pragma unroll
        for (int j = 0; j < 8; ++j) { const f32x4 x = (xr[64 * j] - pmean) * prstd * *(const f32x4*)(gpl + 256 * j) + *(const f32x4*)(bpl + 256 * j); f32x4 fa, fc;
            const unsigned f0 = fl0[j], f1 = fl1[j];
            if (f0 == 0u) { const u32x2 a = y0[64 * j]; fa = (f32x4){bflo(a.x), bfhi(a.x), bflo(a.y), bfhi(a.y)}; }
            else { const float* sp = slabs + (size_t)(f0 - 1u) * 65536 + (size_t)(r0 & 255) * 256 + 4 * F.lane; fa = *(const f32x4*)sp; for (int s = 1; s < S; ++s) fa = fa + *(const f32x4*)(sp + (size_t)s * 65536); fa = (f32x4){bf2f((unsigned short)f2bf(fa[0])), bf2f((unsigned short)f2bf(fa[1])), bf2f((unsigned short)f2bf(fa[2])), bf2f((unsigned short)f2bf(fa[3]))}; }
            if (f1 == 0u) { const u32x2 c = y1[64 * j]; fc = (f32x4){bflo(c.x), bfhi(c.x), bflo(c.y), bfhi(c.y)}; }
            else { const float* sp = slabs + (size_t)(f1 - 1u) * 65536 + (size_t)(r1 & 255) * 256 + 4 * F.lane; fc = *(const f32x4*)sp; for (int s = 1; s < S; ++s) fc = fc + *(const f32x4*)(sp + (size_t)s * 65536); fc = (f32x4){bf2f((unsigned short)f2bf(fc[0])), bf2f((unsigned short)f2bf(fc[1])), bf2f((unsigned short)f2bf(fc[2])), bf2f((unsigned short)f2bf(fc[3]))}; }
            v[j] = x * ALPHA + (fa * g0 + fc * g1); }
        ln_row(v, g, bta, F.lane, y);
#pragma unroll
        for (int j = 0; j < 8; ++j) xr[64 * j] = y[j];
    }
}
__device__ __forceinline__ void phase_norm1(const Ctx& F, const float* gq, const float* gk) {
    const int gw = F.bid * NWAVES + F.wave, NGW = F.G * NWAVES;
    const float* proj = (const float*)(F.ws + B1_PROJ);
    for (int m = gw; m < M; m += NGW) {
        const float* pr = proj + (size_t)m * NIN1P;
        const f32x4 q0 = *(const f32x4*)(pr + 8 * F.lane), q1 = *(const f32x4*)(pr + 8 * F.lane + 4), k0 = *(const f32x4*)(pr + 512 + 8 * F.lane), k1 = *(const f32x4*)(pr + 512 + 8 * F.lane + 4);
        float sq = q0[0] * q0[0] + q0[1] * q0[1] + q0[2] * q0[2] + q0[3] * q0[3] + q1[0] * q1[0] + q1[1] * q1[1] + q1[2] * q1[2] + q1[3] * q1[3];
        float sk = k0[0] * k0[0] + k0[1] * k0[1] + k0[2] * k0[2] + k0[3] * k0[3] + k1[0] * k1[0] + k1[1] * k1[1] + k1[2] * k1[2] + k1[3] * k1[3];
        sq = wave_sum(sq); sk = wave_sum(sk);
        const float rq = 1.0f / sqrtf(sq * (1.f / 512.f) + RMS_EPS), rk = 1.0f / sqrtf(sk * (1.f / 512.f) + RMS_EPS);
        const f32x4 gq0 = *(const f32x4*)(gq + 8 * F.lane), gq1 = *(const f32x4*)(gq + 8 * F.lane + 4), gk0 = *(const f32x4*)(gk + 8 * F.lane), gk1 = *(const f32x4*)(gk + 8 * F.lane + 4);
        const f32x4 a0 = q0 * rq * gq0, a1 = q1 * rq * gq1, c0 = k0 * rk * gk0, c1 = k1 * rk * gk1;
        u32x4 w; w.x = pk2(a0[0], a0[1]); w.y = pk2(a0[2], a0[3]); w.z = pk2(a1[0], a1[1]); w.w = pk2(a1[2], a1[3]);
        *((GAS u32x4*)((bf16_t*)(F.ws + B1_CQN) + (size_t)m * 512) + F.lane) = w;
        w.x = pk2(c0[0], c0[1]); w.y = pk2(c0[2], c0[3]); w.z = pk2(c1[0], c1[1]); w.w = pk2(c1[2], c1[3]);
        *((GAS u32x4*)((bf16_t*)(F.ws + B1_CKVN) + (size_t)m * 512) + F.lane) = w;
        if (F.lane < 32) { const float a = pr[1024 + 2 * F.lane], c = pr[1024 + 2 * F.lane + 1]; ((unsigned*)((bf16_t*)(F.ws + SM_KIDX) + (size_t)m * 64))[F.lane] = pk2(a, c); }
        else if (F.lane < 48) ((float*)(F.ws + SM_WIDX))[(size_t)m * 16 + (F.lane - 32)] = pr[1088 + (F.lane - 32)];
    }
}
__device__ __forceinline__ size_t sc_row_off(int b, int t) { const int qc = t >> 7; return (size_t)b * SC_PER_BATCH + (size_t)16384 * (qc * (qc + 1) / 2) + (size_t)(t & 127) * (128 * (qc + 1)); }

__device__ __forceinline__ float relu_f(float x) { const int b = __builtin_bit_cast(int, x); return __builtin_bit_cast(float, b > 0 ? b : 0); }
__device__ __forceinline__ void phase_index(const Ctx& F, float* SC) {
    const bf16_t* QI = (const bf16_t*)(F.ws + B1_QIDX); const bf16_t* KI = (const bf16_t*)(F.ws + SM_KIDX); const float* WI = (const float*)(F.ws + SM_WIDX);
    const int tid = F.tid, lane = F.lane, l15 = lane & 15, q4 = lane >> 4, wid = F.wave;
    LAS unsigned char* ktile = F.lds + 65536;
    const int skey = tid >> 3, sch = tid & 7; const unsigned st_off = (unsigned)(skey * 128 + ((sch ^ (skey & 7)) << 4));
    unsigned rd_off[4][2];
#pragma unroll
    for (int sg = 0; sg < 4; ++sg)
#pragma unroll
        for (int s = 0; s < 2; ++s) { const int k = sg * 16 + l15, c = s * 4 + q4; rd_off[sg][s] = (unsigned)(k * 128 + ((c ^ (k & 7)) << 4)); }
    unsigned* qhead = (unsigned*)(F.ws + WS_CTL) + CW_QIDX; LAS int* qslot = (LAS int*)(F.lds + 65536 + 16384);
    if (tid == 0) qslot[0] = (int)__hip_atomic_fetch_add(qhead, 1u, RLX_AGENT);
    __syncthreads();
    for (;;) {
        const int u = __builtin_amdgcn_readfirstlane(qslot[0]);
        if (u >= 576) break;
        int unext = 0; if (tid == 0) unext = (int)__hip_atomic_fetch_add(qhead, 1u, RLX_AGENT);
        const int v = 575 - u;
        const int b = v / 288, w = v % 288; int g = 0;
#pragma unroll
        for (int j = 1; j < 8; ++j) g += (w >= 4 * j * (j + 1)) ? 1 : 0;
        const int rem = w - 4 * g * (g + 1), qc = 8 * g + rem / (g + 1), ks = rem % (g + 1);
        const int k_lo = ks * 1024; int k_hi = k_lo + 1024; if (k_hi > 128 * (qc + 1)) k_hi = 128 * (qc + 1);
        const int pitch = 128 * (qc + 1), ntile = (k_hi - k_lo) >> 6;
        const bf16_t* kg = KI + ((size_t)b * T + k_lo + skey) * 64 + sch * 8;
#pragma unroll 1
        for (int pass = 0; pass < 4; ++pass) {
            const int t0 = qc * 128 + wid * 16 + pass * 4;
            bf16x8 af[4][2]; f32x4 wq[4];
#pragma unroll
            for (int i = 0; i < 4; ++i) { const size_t m = (size_t)b * T + t0 + i;
                af[i][0] = *(const bf16x8*)(QI + m * 1024 + l15 * 64 + q4 * 8); af[i][1] = *(const bf16x8*)(QI + m * 1024 + l15 * 64 + 32 + q4 * 8);
                wq[i] = *(const f32x4*)(WI + m * 16 + 4 * q4); }
            LAS float* stg = (LAS float*)(F.lds + wid * 8192) + lane; float* scp = SC + sc_row_off(b, t0) + k_lo;
            u32x4 kreg = *(const u32x4*)kg;
            *(LAS u32x4*)(ktile + st_off) = kreg;
            if (ntile > 1) kreg = *(const u32x4*)(kg + (size_t)64 * 64);
            __syncthreads();
#pragma unroll 1
            for (int ti = 0; ti < ntile; ++ti) {
                const LAS unsigned char* kt = ktile + (ti & 1) * 8192;
                bf16x8 bfr[4][2];
#pragma unroll
                for (int sg = 0; sg < 4; ++sg) { bfr[sg][0] = *(const LAS bf16x8*)(kt + rd_off[sg][0]); bfr[sg][1] = *(const LAS bf16x8*)(kt + rd_off[sg][1]); }
                if (ti + 1 < ntile) *(LAS u32x4*)(ktile + ((ti + 1) & 1) * 8192 + st_off) = kreg;
                if (ti + 2 < ntile) kreg = *(const u32x4*)(kg + (size_t)(ti + 2) * 64 * 64);
                f32x4 acc[4][4];
#pragma unroll
                for (int i = 0; i < 4; ++i)
#pragma unroll
                    for (int sg = 0; sg < 4; ++sg) acc[i][sg] = __builtin_amdgcn_mfma_f32_16x16x32_bf16(af[i][0], bfr[sg][0], (f32x4){0.f, 0.f, 0.f, 0.f}, 0, 0, 0);
#pragma unroll
                for (int i = 0; i < 4; ++i)
#pragma unroll
                    for (int sg = 0; sg < 4; ++sg) acc[i][sg] = __builtin_amdgcn_mfma_f32_16x16x32_bf16(af[i][1], bfr[sg][1], acc[i][sg], 0, 0, 0);
#pragma unroll
                for (int i = 0; i < 4; ++i) {
                    float part[4];
#pragma unroll
                    for (int sg = 0; sg < 4; ++sg) part[sg] = relu_f(acc[i][sg][0]) * wq[i][0] + relu_f(acc[i][sg][1]) * wq[i][1] + relu_f(acc[i][sg][2]) * wq[i][2] + relu_f(acc[i][sg][3]) * wq[i][3];
                    auto s0 = __builtin_amdgcn_permlane32_swap(__float_as_uint(part[0]), __float_as_uint(part[2]), false, false);
                    auto s1 = __builtin_amdgcn_permlane32_swap(__float_as_uint(part[1]), __float_as_uint(part[3]), false, false);
                    const float k0 = __uint_as_float(s0[0]) + __uint_as_float(s0[1]), k1 = __uint_as_float(s1[0]) + __uint_as_float(s1[1]);
                    auto s2 = __builtin_amdgcn_permlane16_swap(__float_as_uint(k0), __float_as_uint(k1), false, false);
                    stg[i * 512 + (ti & 7) * 64] = __uint_as_float(s2[0]) + __uint_as_float(s2[1]);
                }
                if ((ti & 7) == 7 || ti + 1 == ntile) {
                    LDS_WAIT(); asm volatile("" ::: "memory");
                    const int c0 = (ti & ~7) * 64, nc = (ti + 1) * 64 - c0;
#pragma unroll
                    for (int i = 0; i < 4; ++i) for (int k = 4 * lane; k < nc; k += 256) *(f32x4*)(scp + (size_t)i * pitch + c0 + k) = *(const LAS f32x4*)((LAS float*)(F.lds + wid * 8192) + i * 512 + k);
                    LDS_WAIT(); asm volatile("" ::: "memory"); }
                __syncthreads();
            }
        }
        if (tid == 0) qslot[0] = unext;
        __syncthreads();
    }
}

__device__ __forceinline__ int cnt_ge8(unsigned a0, unsigned a1, unsigned a2, unsigned a3, unsigned a4, unsigned a5, unsigned a6, unsigned a7, unsigned b) {
    unsigned long long m0, m1, m2, m3, m4, m5, m6, m7;
    asm("v_cmp_ge_u32_e64 %0, %8, %16\n\tv_cmp_ge_u32_e64 %1, %9, %16\n\tv_cmp_ge_u32_e64 %2, %10, %16\n\tv_cmp_ge_u32_e64 %3, %11, %16\n\t"
        "v_cmp_ge_u32_e64 %4, %12, %16\n\tv_cmp_ge_u32_e64 %5, %13, %16\n\tv_cmp_ge_u32_e64 %6, %14, %16\n\tv_cmp_ge_u32_e64 %7, %15, %16"
        : "=&s"(m0), "=&s"(m1), "=&s"(m2), "=&s"(m3), "=&s"(m4), "=&s"(m5), "=&s"(m6), "=&s"(m7)
        : "v"(a0), "v"(a1), "v"(a2), "v"(a3), "v"(a4), "v"(a5), "v"(a6), "v"(a7), "v"(b));
    return (__builtin_popcountll(m0) + __builtin_popcountll(m1)) + (__builtin_popcountll(m2) + __builtin_popcountll(m3)) + (__builtin_popcountll(m4) + __builtin_popcountll(m5)) + (__builtin_popcountll(m6) + __builtin_popcountll(m7));
}
__device__ __forceinline__ void phase_topk(const Ctx& F, const int reps) {
    const float* SC = (const float*)(F.ws + B1_SC); int* SEL = (int*)(F.ws + SM_SEL);
    const int lane = F.lane;
    LAS int* lst = (LAS int*)(F.lds + F.wave * 1024);
    unsigned* qhead = (unsigned*)(F.ws + WS_CTL) + CW_QTOPK;
    unsigned nxt = 0u; if (lane == 0) nxt = __hip_atomic_fetch_add(qhead, 1u, RLX_AGENT);
#pragma unroll 1
    for (;;) {
        const unsigned qi = (unsigned)__builtin_amdgcn_readfirstlane((int)nxt);
        if (qi >= (unsigned)(M * reps)) break;
        if (lane == 0) nxt = __hip_atomic_fetch_add(qhead, 1u, RLX_AGENT);
        const int qq = (int)(qi % (unsigned)M), b = qq & 1, t = 8191 - (qq >> 1), m = b * T + t; int* out = SEL + (size_t)m * 256;
        if (t < 256) {
#pragma unroll
            for (int j = 0; j < 4; ++j) { const int i = lane + 64 * j; out[i] = (i <= t) ? i : -1; }
            continue;
        }
        const float* row = SC + sc_row_off(b, t);
        const int nreg = (t >> 6) + 1;
        unsigned u[128];
#pragma unroll
        for (int gi = 0; gi < 8; ++gi) {
            if (gi * 16 < nreg) {
#pragma unroll
                for (int i = gi * 16; i < gi * 16 + 16; ++i) u[i] = __float_as_uint(row[lane + 64 * i]);
            } else {
#pragma unroll
                for (int i = gi * 16; i < gi * 16 + 16; ++i) u[i] = 0u;
            }
        }
#pragma unroll
        for (int gi = 0; gi < 8; ++gi) if (gi * 16 < nreg) {
#pragma unroll
            for (int i = gi * 16; i < gi * 16 + 16; ++i) { const int idx = lane + 64 * i; const unsigned bits = u[i]; const unsigned key = (bits & 0x80000000u) ? ~bits : (bits | 0x80000000u); u[i] = (idx <= t) ? key : 0u; }
        }
        bool done = false;
        if (nreg > 16) {
            unsigned Tl = 0u;
            for (int bit = 31; bit >= 0; --bit) { const unsigned cand = Tl | (1u << bit); int c = 0;
#pragma unroll
                for (int gi = 0; gi < 8; ++gi) if (gi * 16 < nreg) c += __builtin_popcountll(__ballot(u[gi * 16] >= cand)) + __builtin_popcountll(__ballot(u[gi * 16 + 8] >= cand));
                if (c >= 48) Tl = cand; }
            int call = 0;
#pragma unroll
            for (int gi = 0; gi < 8; ++gi) if (gi * 16 < nreg) {
#pragma unroll
                for (int i = gi * 16; i < gi * 16 + 16; i += 8) call += cnt_ge8(u[i], u[i + 1], u[i + 2], u[i + 3], u[i + 4], u[i + 5], u[i + 6], u[i + 7], Tl); }
            if (call >= 256 && call <= 1024) {
                LAS unsigned* keyL = (LAS unsigned*)(F.lds + 8192 + F.wave * 8192); LAS unsigned* idxL = keyL + 1024;
                int cb = 0;
#pragma unroll
                for (int gi = 0; gi < 8; ++gi) if (gi * 16 < nreg) {
#pragma unroll
                    for (int i = gi * 16; i < gi * 16 + 16; ++i) { const bool s = u[i] >= Tl; const unsigned long long sb = __ballot(s);
                        if (s) { const int p = cb + (int)__builtin_amdgcn_mbcnt_hi((unsigned)(sb >> 32), __builtin_amdgcn_mbcnt_lo((unsigned)sb, 0u)); keyL[p] = u[i]; idxL[p] = (unsigned)(lane + 64 * i); }
                        cb += __builtin_popcountll(sb); } }
                LDS_WAIT(); asm volatile("" ::: "memory");
                const int nc = (call + 63) >> 6;
                unsigned ck[16], ci[16];
#pragma unroll
                for (int j = 0; j < 16; ++j) { const int p = lane + 64 * j; const bool ok = (j < nc) && (p < call); ck[j] = ok ? keyL[p] : 0u; ci[j] = ok ? idxL[p] : 0u; }
                unsigned Tk = 0u; bool exact = false;
                for (int bit = 31; bit >= 0; --bit) { const unsigned cand = Tk | (1u << bit); int c = 0;
#pragma unroll
                    for (int j = 0; j < 16; ++j) if (j < nc) c += __builtin_popcountll(__ballot(ck[j] >= cand));
                    if (c >= 256) { Tk = cand; if (c == 256) { exact = true; break; } } }
                int need = 0;
                if (!exact) { int c = 0;
#pragma unroll
                    for (int j = 0; j < 16; ++j) if (j < nc) c += __builtin_popcountll(__ballot(ck[j] > Tk));
                    need = 256 - c; }
                int base = 0, eq_taken = 0;
#pragma unroll
                for (int j = 0; j < 16; ++j) if (j < nc) {
                    const bool eq = ck[j] == Tk; const unsigned long long eb = __ballot(eq && !exact);
                    const int rank = eq_taken + __builtin_popcountll(eb & ((1ull << lane) - 1ull)); eq_taken += __builtin_popcountll(eb);
                    const bool s = exact ? (ck[j] >= Tk) : ((ck[j] > Tk) || (eq && rank < need));
                    const unsigned long long sb = __ballot(s);
                    if (s) { const int pos = base + __builtin_popcountll(sb & ((1ull << lane) - 1ull)); if (pos < 256) lst[pos] = (int)ci[j]; }
                    base += __builtin_popcountll(sb); }
                done = true;
            }
        }
        if (!done) {
            unsigned Tk = 0u; bool exact = false;
            for (int bit = 31; bit >= 0; --bit) {
                const unsigned cand = Tk | (1u << bit); int c = 0;
    #pragma unroll
                for (int gi = 0; gi < 8; ++gi) if (gi * 16 < nreg) {
    #pragma unroll
                    for (int i = gi * 16; i < gi * 16 + 16; i += 8) c += cnt_ge8(u[i], u[i + 1], u[i + 2], u[i + 3], u[i + 4], u[i + 5], u[i + 6], u[i + 7], cand); }
                if (c >= 256) { Tk = cand; if (c == 256) { exact = true; break; } }
            }
            int need = 0;
            if (!exact) { int c = 0;
    #pragma unroll
                for (int gi = 0; gi < 8; ++gi) if (gi * 16 < nreg) {
    #pragma unroll
                    for (int i = gi * 16; i < gi * 16 + 16; ++i) c += __builtin_popcountll(__ballot(u[i] > Tk)); }
                need = 256 - c; }
            int base = 0;
            if (exact) {
    #pragma unroll
                for (int gi = 0; gi < 8; ++gi) if (gi * 16 < nreg) {
    #pragma unroll
                    for (int i = gi * 16; i < gi * 16 + 16; ++i) {
                        const bool s = u[i] >= Tk; const unsigned long long sb = __ballot(s);
                        if (s) lst[base + (int)__builtin_amdgcn_mbcnt_hi((unsigned)(sb >> 32), __builtin_amdgcn_mbcnt_lo((unsigned)sb, 0u))] = lane + 64 * i;
                        base += __builtin_popcountll(sb);
                    } }
            } else {
                int eq_taken = 0;
    #pragma unroll
                for (int gi = 0; gi < 8; ++gi) if (gi * 16 < nreg) {
    #pragma unroll
                    for (int i = gi * 16; i < gi * 16 + 16; ++i) {
                        const bool eq = u[i] == Tk; const unsigned long long eb = __ballot(eq);
                        const int rank = eq_taken + __builtin_popcountll(eb & ((1ull << lane) - 1ull)); eq_taken += __builtin_popcountll(eb);
                        const bool s = (u[i] > Tk) || (eq && rank < need);
                        const unsigned long long sb = __ballot(s);
                        if (s) { const int pos = base + __builtin_popcountll(sb & ((1ull << lane) - 1ull)); if (pos < 256) lst[pos] = lane + 64 * i; }
                        base += __builtin_popcountll(sb);
                    } }
            }
        }
        LDS_WAIT(); asm volatile("" ::: "memory");
        *(GAS u32x4*)(out + 4 * lane) = *(const LAS u32x4*)(lst + 4 * lane);
        LDS_WAIT(); asm volatile("" ::: "memory");
    }
}

__device__ __forceinline__ void quad_barrier(volatile LAS unsigned* cnt, unsigned& epoch, int lane) {
    asm volatile("s_waitcnt lgkmcnt(0)" ::: "memory");
    epoch += 4u;
    if (lane == 0) __hip_atomic_fetch_add((LAS unsigned*)cnt, 1u, __ATOMIC_RELAXED, __HIP_MEMORY_SCOPE_WORKGROUP);
    for (unsigned sp = 0; __builtin_amdgcn_readfirstlane(*cnt) < epoch && sp < (1u << 24); ++sp) __builtin_amdgcn_s_sleep(1);
    asm volatile("" ::: "memory");
}
__device__ __forceinline__ void quad_signal(volatile LAS unsigned* cnt4, int qt, unsigned value, int lane) {
    asm volatile("s_waitcnt lgkmcnt(0)" ::: "memory");
    if (lane == 0) cnt4[qt] = value;
}
__device__ __forceinline__ void quad_wait(volatile LAS unsigned* cnt4, unsigned target) {
    for (unsigned sp = 0; sp < (1u << 24); ++sp) {
        const u32x4 v = *(const volatile LAS u32x4*)cnt4;
        unsigned mn = v.x < v.y ? v.x : v.y; const unsigned m2 = v.z < v.w ? v.z : v.w; mn = mn < m2 ? mn : m2;
        if ((int)((unsigned)__builtin_amdgcn_readfirstlane(mn) - target) >= 0) break;
        __builtin_amdgcn_s_sleep(1); }
    asm volatile("" ::: "memory");
}
namespace dsa {
constexpr int OFF_ROWS = 0, OFF_XCH = 65536, OFF_SEL = OFF_XCH + 32768, OFF_LUT = OFF_SEL + 4096, OFF_AL = OFF_LUT + 129 * 16 * 4 + 64, OFF_QB = OFF_AL + 8 * 64 * 4, LDS_END = OFF_QB + 64;
__device__ __forceinline__ unsigned off_a(unsigned row, unsigned ch) { return 2048u * (row >> 3) + 512u * (ch >> 2) + 64u * (row & 7) + 16u * ((ch & 3) ^ ((row >> 2) & 3)); }
}
#ifndef SATTN_LMAP
#define SATTN_LMAP 1
#endif
template <int V>
__device__ __forceinline__ void phase_sattn(const Ctx& F, const float* tab, unsigned char* OL) {
    using namespace dsa;
    const bf16_t* CKV = (const bf16_t*)(F.ws + B1_CKVN); const bf16_t* QL = (const bf16_t*)(F.ws + B1_QLAT); const int* SEL = (const int*)(F.ws + SM_SEL);
    const int lane = F.lane, wid = F.wave, l15 = lane & 15, q4 = lane >> 4, slot = wid >> 2, qt = wid & 3;
    char* lds = (char*)F.ldsg;
    char* rows = lds + OFF_ROWS + wid * 8192;
    float* lut = (float*)(lds + OFF_LUT); float* alw = (float*)(lds + OFF_AL) + wid * 64;
    for (int i = F.tid; i < 129 * 16; i += NTHREADS) lut[i] = tab[rel_bucket_dev(i >> 4) * 16 + (i & 15)] * LOG2E;
    unsigned st_addr[2][4];
#pragma unroll
    for (int c = 0; c < 2; ++c)
#pragma unroll
        for (int s = 0; s < 4; ++s) st_addr[c][s] = off_a(8u * (l15 >> 2) + 4u * c + (l15 & 3), 4u * s + q4);
    unsigned wr_addr[2];
#if SATTN_LMAP == 2
#define WR_IMM(s_) (4096 * ((s_) >> 1) + 1024 * ((s_) & 1))
#pragma unroll
    for (int c = 0; c < 2; ++c) { const unsigned nl = lane >> 3; wr_addr[c] = off_a(8u * (nl >> 2) + 4u * c + (nl & 3), lane & 7); }
#else
#define WR_IMM(s_) (512 * (s_))
#pragma unroll
    for (int c = 0; c < 2; ++c) { const unsigned nl = lane >> 2; wr_addr[c] = off_a(8u * (nl >> 2) + 4u * c + (nl & 3), lane & 3); }
#endif
    unsigned tr_base[2][2];
    { const unsigned q = (lane & 15) >> 2, p = lane & 3;
#pragma unroll
      for (int c1 = 0; c1 < 2; ++c1)
#pragma unroll
          for (int t = 0; t < 2; ++t) tr_base[c1][t] = (unsigned)(uintptr_t)rows + off_a(8u * q4 + 4u * t + q, 2u * c1 + (p >> 1)) + 8u * (p & 1); }
    __syncthreads();
    volatile LAS unsigned* pcnt = (volatile LAS unsigned*)(F.lds + OFF_QB) + slot * 8; volatile LAS unsigned* ccnt = pcnt + 4;
    if (F.tid < 16) ((LAS unsigned*)(F.lds + OFF_QB))[F.tid] = 0u;
    const int per = (M + F.G - 1) / F.G;
    int* sellb = (int*)(lds + OFF_SEL);
    bf16x8 bq[4];
    const bool xmap = (F.G == 256) && (per == 64);
    const int xb = (F.bid >> 2) & 1, xj = ((F.bid >> 3) << 2) | (F.bid & 3);
#define QUERY_OF(it_) (xmap ? (xb * T + ((it_) + slot) * 128 + xj) : (F.bid * per + (it_) + slot))
    { const int m0 = QUERY_OF(0); const int mm0 = m0 < M ? m0 : M - 1;
      if (qt == 0) *(u32x4*)(sellb + slot * 256 + 4 * lane) = *(const u32x4*)(SEL + (size_t)mm0 * 256 + 4 * lane);
#pragma unroll
      for (int s = 0; s < 4; ++s) bq[s] = *(const bf16x8*)(QL + (size_t)mm0 * 8192 + l15 * 512 + qt * 128 + 32 * s + 8 * q4); }
    __syncthreads();
    if (slot == 1) { for (int i = 0; i < 12; ++i) __builtin_amdgcn_s_sleep(64); }
    for (int it = 0; it < per; it += 2) {
        const int par = (it >> 1) & 1;
        const int m = QUERY_OF(it); const bool live = m < M;
        const int mm = live ? m : M - 1; const int b = mm >> 13, t = mm & 8191;
        const int* sell = sellb + (par * 2 + slot) * 256;
        int mn = QUERY_OF(it + 2); if (it + 2 >= per || mn >= M) mn = mm;
        u32x4 seln = {0u, 0u, 0u, 0u}; bf16x8 bqn[4];
        bf16x8 afn[2][4];
#if SATTN_LMAP == 2
#define LOAD_ROWS(dst, step_) do { _Pragma("unroll") for (int c = 0; c < 2; ++c) { _Pragma("unroll") for (int h2 = 0; h2 < 2; ++h2) { int kidx = sell[(step_) * 32 + c * 16 + 8 * h2 + (lane >> 3)]; kidx = kidx < 0 ? 0 : kidx; \
            const bf16_t* rp = CKV + ((size_t)b * T + kidx) * 512 + qt * 128 + 8 * (lane & 7); dst[c][2 * h2] = *(const bf16x8*)rp; dst[c][2 * h2 + 1] = *(const bf16x8*)(rp + 64); } } } while (0)
#else
#define LOAD_ROWS(dst, step_) do { _Pragma("unroll") for (int c = 0; c < 2; ++c) { int kidx = sell[(step_) * 32 + c * 16 + (lane >> 2)]; kidx = kidx < 0 ? 0 : kidx; \
            const bf16_t* rp = CKV + ((size_t)b * T + kidx) * 512 + qt * 128 + 8 * (lane & 3); _Pragma("unroll") for (int s = 0; s < 4; ++s) dst[c][s] = *(const bf16x8*)(rp + 32 * s); } } while (0)
#endif
        LOAD_ROWS(afn, 0);
        f32x4 o[8];
#pragma unroll
        for (int cb = 0; cb < 8; ++cb) o[cb] = (f32x4){0.f, 0.f, 0.f, 0.f};
        float m_run = -1e30f, l_run = 0.f;
        s16x4 v0[8], v1[8];
        const unsigned gbase = (unsigned)(it >> 1) * 8u;
#pragma unroll 1
        for (int step = 0; step <= 8; ++step) {
            if (step < 8) {
#pragma unroll
                for (int c = 0; c < 2; ++c)
#pragma unroll
                    for (int s = 0; s < 4; ++s) *(bf16x8*)(rows + wr_addr[c] + WR_IMM(s)) = afn[c][s];
                if (step < 7) LOAD_ROWS(afn, step + 1);
                if (step == 6) {
                    if (qt == 0) seln = *(const u32x4*)(SEL + (size_t)mn * 256 + 4 * lane);
#pragma unroll
                    for (int s = 0; s < 4; ++s) bqn[s] = *(const bf16x8*)(QL + (size_t)mn * 8192 + l15 * 512 + qt * 128 + 32 * s + 8 * q4); }
                f32x4 sp[2]; bf16x8 af[2][4];
#pragma unroll
                for (int c = 0; c < 2; ++c) { sp[c] = (f32x4){0.f, 0.f, 0.f, 0.f};
#pragma unroll
                    for (int s = 0; s < 4; ++s) af[c][s] = *(const bf16x8*)(rows + st_addr[c][s]);
#pragma unroll
                    for (int s = 0; s < 4; ++s) sp[c] = __builtin_amdgcn_mfma_f32_16x16x32_bf16(af[c][s], bq[s], sp[c], 0, 0, 0); }
                const unsigned g = gbase + (unsigned)step;
                if (g >= 2u) quad_wait(ccnt, g - 1u);
                if (step == 7 && qt == 0) *(u32x4*)(sellb + ((par ^ 1) * 2 + slot) * 256 + 4 * lane) = seln;
                f32x4* xch = (f32x4*)(lds + OFF_XCH) + (size_t)(step & 1) * 1024;
                xch[(wid * 2 + 0) * 64 + lane] = sp[0]; xch[(wid * 2 + 1) * 64 + lane] = sp[1];
                quad_signal(pcnt, qt, g + 1u, lane);
            }
            if (step > 0) {
                const int ps = step - 1;
                quad_wait(pcnt, gbase + (unsigned)ps + 1u);
                const f32x4* xch = (const f32x4*)(lds + OFF_XCH) + (size_t)(ps & 1) * 1024;
                f32x4 st[2];
#pragma unroll
                for (int c = 0; c < 2; ++c) { st[c] = xch[((slot * 4 + 0) * 2 + c) * 64 + lane] + xch[((slot * 4 + 1) * 2 + c) * 64 + lane] + xch[((slot * 4 + 2) * 2 + c) * 64 + lane] + xch[((slot * 4 + 3) * 2 + c) * 64 + lane]; }
                quad_signal(ccnt, qt, gbase + (unsigned)ps + 1u, lane);
                float pmax = -__builtin_inff();
#pragma unroll
                for (int c = 0; c < 2; ++c) { const u32x4 kk = *(const u32x4*)(sell + ps * 32 + c * 16 + 4 * q4);
                    float bv[4];
#pragma unroll
                    for (int j = 0; j < 4; ++j) { int d = t - (int)kk[j]; d = d < 0 ? 0 : (d > 128 ? 128 : d); bv[j] = lut[d * 16 + l15]; }
                    asm volatile("" : "+v"(bv[0]), "+v"(bv[1]), "+v"(bv[2]), "+v"(bv[3]));
#pragma unroll
                    for (int j = 0; j < 4; ++j) { const int kidx = (int)kk[j]; const bool ok = (kidx >= 0) && (kidx <= t);
                        const float v = ok ? st[c][j] + bv[j] : -__builtin_inff(); st[c][j] = v; pmax = fmaxf(pmax, v); } }
                { auto r16 = __builtin_amdgcn_permlane16_swap(__float_as_uint(pmax), __float_as_uint(pmax), false, false); pmax = fmaxf(__uint_as_float(r16[0]), __uint_as_float(r16[1]));
                  auto r32 = __builtin_amdgcn_permlane32_swap(__float_as_uint(pmax), __float_as_uint(pmax), false, false); pmax = fmaxf(__uint_as_float(r32[0]), __uint_as_float(r32[1])); }
                float alpha = 1.f;
                if (!__all((pmax - m_run) <= att::THR2)) { const float mnew = fmaxf(m_run, pmax); alpha = __builtin_amdgcn_exp2f(m_run - mnew); m_run = mnew;
                    if (q4 == 0) alw[l15] = alpha;
                    LDS_WAIT(); asm volatile("" ::: "memory");
                    const f32x4 a4 = *(const f32x4*)(alw + 4 * q4);
#pragma unroll
                    for (int cb = 0; cb < 8; ++cb) o[cb] = o[cb] * a4; }
                float ps_ = 0.f; unsigned pk[4];
#pragma unroll
                for (int c = 0; c < 2; ++c) { float p0 = __builtin_amdgcn_exp2f(st[c][0] - m_run), p1 = __builtin_amdgcn_exp2f(st[c][1] - m_run), p2 = __builtin_amdgcn_exp2f(st[c][2] - m_run), p3 = __builtin_amdgcn_exp2f(st[c][3] - m_run);
                    ps_ += (p0 + p1) + (p2 + p3); pk[2 * c] = cvt_pk_bf16(p0, p1); pk[2 * c + 1] = cvt_pk_bf16(p2, p3); }
                l_run = l_run * alpha + ps_;
                const u32x4 pw = {pk[0], pk[1], pk[2], pk[3]}; const bf16x8 pa = *reinterpret_cast<const bf16x8*>(&pw);
                asm volatile("s_waitcnt lgkmcnt(0)" ::: "memory");
#pragma unroll
                for (int cb = 0; cb < 8; ++cb)
                    o[cb] = __builtin_amdgcn_mfma_f32_16x16x32_bf16(pa, (bf16x8){v0[cb][0], v0[cb][1], v0[cb][2], v0[cb][3], v1[cb][0], v1[cb][1], v1[cb][2], v1[cb][3]}, o[cb], 0, 0, 0);
            }
            if (step < 8) {
#pragma unroll
                for (int cb = 0; cb < 8; ++cb) {
                    asm volatile("ds_read_b64_tr_b16 %0, %1 offset:%2" : "=&v"(v0[cb]) : "v"(tr_base[cb & 1][0]), "i"(512 * (cb >> 1)) : "memory");
                    asm volatile("ds_read_b64_tr_b16 %0, %1 offset:%2" : "=&v"(v1[cb]) : "v"(tr_base[cb & 1][1]), "i"(512 * (cb >> 1)) : "memory"); }
            }
        }
#undef LOAD_ROWS
        float l = l_run;
        { auto r16 = __builtin_amdgcn_permlane16_swap(__float_as_uint(l), __float_as_uint(l), false, false); l = __uint_as_float(r16[0]) + __uint_as_float(r16[1]);
          auto r32 = __builtin_amdgcn_permlane32_swap(__float_as_uint(l), __float_as_uint(l), false, false); l = __uint_as_float(r32[0]) + __uint_as_float(r32[1]); }
        if (q4 == 0) alw[16 + l15] = 1.0f / l;
        LDS_WAIT(); asm volatile("" ::: "memory");
        const f32x4 r4 = *(const f32x4*)(alw + 16 + 4 * q4);
        if (live) {
#pragma unroll
            for (int cb = 0; cb < 8; ++cb)
#pragma unroll
                for (int e = 0; e < 4; ++e) { const float v = o[cb][e] * (r4[e] * 16.0f); const float v1_ = pg8::quad_xor1(v), v2_ = pg8::quad_xor2(v), v3_ = pg8::quad_xor3(v);
                    if ((lane & 3) == 0) *(unsigned*)(OL + (size_t)m * 8192 + (4 * q4 + e) * 512 + qt * 128 + 16 * cb + l15) = pg8::pk4_fp8(v, v1_, v2_, v3_); }
        }
#pragma unroll
        for (int s = 0; s < 4; ++s) bq[s] = bqn[s];
    }
    __syncthreads();
}
#ifndef MK_PER_PHASE
#define MK_PER_PHASE 0
#endif
constexpr int NPHASE = 22;
#ifndef REPEAT_MASK
#define REPEAT_MASK 0ull
#endif
#define REP(k) ((int)(((unsigned long long)(REPEAT_MASK) >> (k)) & 1ull))
__global__ void __launch_bounds__(NTHREADS, 2) fwd(Args args) {
    extern __shared__ __attribute__((aligned(16))) unsigned char lds_raw[];
    const int wave_s = __builtin_amdgcn_readfirstlane((int)threadIdx.x >> 6);
#define MKCTX(F) Ctx F; { int t_ = (int)__builtin_amdgcn_mbcnt_hi(~0u, __builtin_amdgcn_mbcnt_lo(~0u, 0u)); asm volatile("" : "+v"(t_)); t_ |= wave_s << 6; F.lds = (LAS unsigned char*)lds_raw; F.ldsg = lds_raw; F.ws = args.ws; F.out = args.out; \
        F.tid = t_; F.lane = t_ & 63; F.wave = __builtin_amdgcn_readfirstlane(t_ >> 6); F.G = gridDim.x; F.bid = blockIdx.x; }
    volatile LAS unsigned* MISC = (volatile LAS unsigned*)((LAS unsigned char*)lds_raw + MISC_OFF);
    for (int u = (int)threadIdx.x; u < (LDS_BYTES - MISC_OFF) / 4; u += NTHREADS) ((LAS unsigned*)((LAS unsigned char*)lds_raw + MISC_OFF))[u] = 0u;
    __syncthreads();
    const int lo = args.ph_lo, hi = args.ph_hi;
    XcdBarrier bar; bar.bar = (unsigned*)(args.ws + WS_CTL) + CW_BAR; bar.x = 0; bar.st = nullptr;
    #define LEADER() (wave_s == 0 && __builtin_amdgcn_mbcnt_hi(~0u, __builtin_amdgcn_mbcnt_lo(~0u, 0u)) == 0u)
    if (hi - lo > 1) bar = xcd_barrier_post((unsigned*)(args.ws + WS_CTL) + CW_BAR, MISC + 8, LEADER());
#ifdef ONLY_PHASE
#define IN(k) ((k) == ONLY_PHASE && lo <= (k) && (k) < hi)
#else
#define IN(k) (lo <= (k) && (k) < hi)
#endif
#define SEAM(k) do { if (IN(k) && IN((k) + 1)) xcd_barrier(bar, LEADER()); } while (0)
    unsigned char* ws = args.ws;
    bf16_t* XB = (bf16_t*)(ws + WS_XB);

    if (IN(0)) for (int rep_ = 0; rep_ <= REP(0); ++rep_) { if (rep_) xcd_barrier(bar, LEADER()); MKCTX(F); const ProIn I{args.in[0], args.in[2], args.in[3], args.in[4], args.in[7], args.in[8], args.in[9], args.in[12], args.in[15], args.in[16], args.in[17], args.in[18], args.in[19], args.in[23], args.in[24], args.in[25]}; phase_prologue(F, I); } SEAM(0);
    if (IN(1)) for (int rep_ = 0; rep_ <= REP(1); ++rep_) { if (rep_) xcd_barrier(bar, LEADER()); MKCTX(F);
        pg8::Gemm g{XB, (const bf16_t*)(ws + WS_WIN0), 2048, 2048, 2048}; pg8::PlainSched S; S.init(M / 256, NQKV0 / 256, F.G, F.bid); S.akstep = 0;
        pg8::EpiQKV0 E{(bf16_t*)(ws + B0_QKV)}; pg8::gemm_phase(F.lds, g, S, E, F.tid); } SEAM(1);
    if (IN(2)) for (int rep_ = 0; rep_ <= REP(2); ++rep_) { if (rep_) xcd_barrier(bar, LEADER()); MKCTX(F); phase_pre0(F); } SEAM(2);
    if (IN(3)) { for (int rep_ = 0; rep_ <= REP(3); ++rep_) { if (rep_) xcd_barrier(bar, LEADER()); MKCTX(F); phase_attn0_moba(F, args.in[1]); } for (int rep_ = 0; rep_ <= REP(22); ++rep_) { if (rep_) xcd_barrier(bar, LEADER()); MKCTX(F); phase_attn0_fox(F); } } SEAM(3);
    if (IN(4)) for (int rep_ = 0; rep_ <= REP(4); ++rep_) { if (rep_) xcd_barrier(bar, LEADER()); MKCTX(F);
        pg8::Gemm g{(const bf16_t*)(ws + B0_O), (const bf16_t*)(ws + WS_WOUT0), 1024, 1024, 1024}; pg8::PlainSched S; S.init(M / 256, DM / 256, F.G, F.bid); S.akstep = 0;
        pg8::EpiResF32 E{args.in[0], args.out, DM, ALPHA, 1.0f / 1024.0f}; pg8::gemm_phase<pg8::EpiResF32, pg8::PlainSched, true>(F.lds, g, S, E, F.tid); } SEAM(4);
    if (IN(5)) for (int rep_ = 0; rep_ <= REP(5); ++rep_) { if (rep_) xcd_barrier(bar, LEADER()); MKCTX(F); phase_ln<true>(F, args.in[5], args.in[6]); } SEAM(5);
    if (IN(6)) for (int rep_ = 0; rep_ <= REP(6); ++rep_) { if (rep_) xcd_barrier(bar, LEADER()); MKCTX(F);
        pg8::Gemm g{XB, (const bf16_t*)(ws + WS_WFF13), 1024, 1024, 1024}; pg8::PlainSched S; S.init(M / 256, 2 * FF0 / 256, F.G, F.bid); S.akstep = 0;
        pg8::EpiSwiGLU8 E{ws + B0_ACT, FF0}; pg8::gemm_phase<pg8::EpiSwiGLU8, pg8::PlainSched, true>(F.lds, g, S, E, F.tid); } SEAM(6);
    if (IN(7)) for (int rep_ = 0; rep_ <= REP(7); ++rep_) { if (rep_) xcd_barrier(bar, LEADER()); MKCTX(F);
        pg8::Gemm g{(const bf16_t*)(ws + B0_ACT), (const bf16_t*)(ws + WS_WFF2), FF0 / 2, FF0 / 2, FF0 / 2}; pg8::PlainSched S; S.init(M / 256, DM / 256, F.G, F.bid); S.akstep = 0;
        pg8::EpiResLnF32 E{args.out, args.out, DM, ALPHA, 1.0f / 512.0f, (const float*)(ws + SM_STAT), args.in[5], args.in[6]}; pg8::gemm_phase<pg8::EpiResLnF32, pg8::PlainSched, true>(F.lds, g, S, E, F.tid); } SEAM(7);
    if (IN(8)) for (int rep_ = 0; rep_ <= REP(8); ++rep_) { if (rep_) xcd_barrier(bar, LEADER()); MKCTX(F); phase_ln<false>(F, args.in[10], args.in[11]); } SEAM(8);
    if (IN(9)) for (int rep_ = 0; rep_ <= REP(9); ++rep_) { if (rep_) xcd_barrier(bar, LEADER()); MKCTX(F);
        pg8::Gemm g{XB, (const bf16_t*)(ws + WS_WIN1), 2048, 2048, 2048}; pg8::PlainSched S; S.init(M / 256, NIN1P / 256, F.G, F.bid); S.akstep = 0;
        pg8::EpiF32 E{(float*)(ws + B1_PROJ), NIN1P}; pg8::gemm_phase(F.lds, g, S, E, F.tid); } SEAM(9);
    if (IN(10)) for (int rep_ = 0; rep_ <= REP(10); ++rep_) { if (rep_) xcd_barrier(bar, LEADER()); MKCTX(F); phase_norm1(F, args.in[13], args.in[14]); } SEAM(10);
    if (IN(11)) for (int rep_ = 0; rep_ <= REP(11); ++rep_) { if (rep_) xcd_barrier(bar, LEADER()); MKCTX(F);
        pg8::Gemm g{(const bf16_t*)(ws + B1_CQN), (const bf16_t*)(ws + WS_WQ1), 512, 512, 512}; pg8::PlainSched S; S.init(M / 256, NQ1 / 256, F.G, F.bid); S.akstep = 0;
        pg8::EpiBf16 E{(bf16_t*)(ws + B1_QLAT), 8192, 8192, (bf16_t*)(ws + B1_QIDX), 1024}; pg8::gemm_phase(F.lds, g, S, E, F.tid); } SEAM(11);
    if (IN(12)) for (int rep_ = 0; rep_ <= REP(12); ++rep_) { if (rep_) xcd_barrier(bar, LEADER()); MKCTX(F); phase_index(F, (float*)(ws + B1_SC)); } SEAM(12);
    if (IN(13)) { MKCTX(F); phase_topk(F, 1 + REP(13)); } SEAM(13);
    if (IN(14)) for (int rep_ = 0; rep_ <= REP(14); ++rep_) { if (rep_) xcd_barrier(bar, LEADER()); MKCTX(F); phase_sattn<0>(F, args.in[1], ws + B1_SC); }
#ifdef SATTN_PROBE
    if (IN(14)) { xcd_barrier(bar, LEADER()); MKCTX(F); phase_sattn<SATTN_PROBE>(F, args.in[1], ws + B1_SC); }
#endif
    SEAM(14);
    if (IN(15)) for (int rep_ = 0; rep_ <= REP(15); ++rep_) { if (rep_) xcd_barrier(bar, LEADER()); MKCTX(F);
        pg8::Gemm g{(const bf16_t*)(ws + B1_SC), (const bf16_t*)(ws + WS_WUV), 4096, 512, 512}; pg8::PlainSched S; S.init(M / 256, DM / 256, F.G, F.bid); S.akstep = 512;
        pg8::Epi8 E{ws + B1_OB, DM, 1.0f / 64.0f}; pg8::gemm_phase<pg8::Epi8, pg8::PlainSched, true>(F.lds, g, S, E, F.tid); } SEAM(15);
    if (IN(16)) for (int rep_ = 0; rep_ <= REP(16); ++rep_) { if (rep_) xcd_barrier(bar, LEADER()); MKCTX(F);
        pg8::Gemm g{(const bf16_t*)(ws + B1_OB), (const bf16_t*)(ws + WS_WOUT1), 1024, 1024, 1024}; pg8::PlainSched S; S.init(M / 256, DM / 256, F.G, F.bid); S.akstep = 0;
        pg8::EpiResLnF32 E{args.out, args.out, DM, ALPHA, 1.0f / 1024.0f, (const float*)(ws + SM_STAT), args.in[10], args.in[11]}; pg8::gemm_phase<pg8::EpiResLnF32, pg8::PlainSched, true>(F.lds, g, S, E, F.tid); } SEAM(16);
    if (IN(17)) for (int rep_ = 0; rep_ <= REP(17); ++rep_) { if (rep_) xcd_barrier(bar, LEADER()); MKCTX(F); phase_ln_router(F, args.in[20], args.in[21], args.in[22]); } SEAM(17);
    if (IN(18)) for (int rep_ = 0; rep_ <= REP(18); ++rep_) { if (rep_) xcd_barrier(bar, LEADER()); MKCTX(F); phase_gather(F); } SEAM(18);
    if (IN(19)) for (int rep_ = 0; rep_ <= REP(19); ++rep_) { if (rep_) xcd_barrier(bar, LEADER()); MKCTX(F);
        int ts_[9]; moe_tstart(F, ts_); pg8::MoeSched S; S.set_tstart(ts_); S.brows = 2 * FFE; S.init(ts_[8], 2 * FFE / 256, F.G, F.bid);
        pg8::Gemm g{(const bf16_t*)(ws + B1_XG), (const bf16_t*)(ws + WS_WE13), 1024, 1024, 1024};
        pg8::EpiSwiGLU8 E{ws + B1_H, FFE}; pg8::gemm_phase<pg8::EpiSwiGLU8, pg8::MoeSched, true>(F.lds, g, S, E, F.tid); } SEAM(19);
    if (IN(20)) for (int rep_ = 0; rep_ <= REP(20); ++rep_) { if (rep_) xcd_barrier(bar, LEADER()); MKCTX(F);
        int ts_[9]; moe_tstart(F, ts_); pg8::MoeSplitSched S; S.set_tstart(ts_); S.brows = DM; S.init2(ts_[8], DM / 256, F.G, F.bid, FFE / 128);
        pg8::Gemm g{(const bf16_t*)(ws + B1_H), (const bf16_t*)(ws + WS_WE2), FFE / 2, FFE / 2, FFE / 2};
        pg8::EpiYSlab E{(bf16_t*)(ws + B1_Y), DM, (float*)(ws + B1_SLAB), (unsigned*)(ws + WS_CTL) + CW_FLAG, DM / 256, S.S, 1.0f / 512.0f}; pg8::gemm_phase<pg8::EpiYSlab, pg8::MoeSplitSched, true>(F.lds, g, S, E, F.tid); } SEAM(20);
    if (IN(21)) for (int rep_ = 0; rep_ <= REP(21); ++rep_) { if (rep_) xcd_barrier(bar, LEADER()); MKCTX(F); int ts_[9]; moe_tstart(F, ts_); phase_final(F, args.in[26], args.in[27], pg8::split_factor(ts_[8] * (DM / 256), F.G, FFE / 128), args.in[20], args.in[21]); }
#undef IN
#undef SEAM
}

extern "C" void kernel_launch(void* const* d_in, const int* in_sizes, int n_in, void* d_out, int out_size, void* d_ws, size_t ws_size, hipStream_t stream) {
    static int grid = 0;
    if (grid == 0) {
        if (n_in != 28 || out_size != M * DM || ws_size < WS_NEED) { fprintf(stderr, "kernel_launch: unexpected shapes (n_in %d, out %d, ws %zu < %zu)\n", n_in, out_size, ws_size, (size_t)WS_NEED); grid = -1; return; }
        int dev = 0, cus = 0, per_cu = 0;
        if (hipGetDevice(&dev) != hipSuccess || hipDeviceGetAttribute(&cus, hipDeviceAttributeMultiprocessorCount, dev) != hipSuccess) { grid = -1; return; }
        if (hipFuncSetAttribute((const void*)fwd, hipFuncAttributeMaxDynamicSharedMemorySize, LDS_BYTES) != hipSuccess) { fprintf(stderr, "kernel_launch: hipFuncSetAttribute failed\n"); grid = -1; return; }
        if (hipOccupancyMaxActiveBlocksPerMultiprocessor(&per_cu, (const void*)fwd, NTHREADS, LDS_BYTES) != hipSuccess || per_cu < 1) fprintf(stderr, "kernel_launch: occupancy query reports %d\n", per_cu);
        (void)hipGetLastError();
        grid = cus;
    }
    if (grid < 0) return;
    if (hipMemsetAsync((char*)d_ws + WS_CTL, 0, CTL_ZERO_BYTES, stream) != hipSuccess) return;
    Args a{};
    for (int i = 0; i < 28; ++i) a.in[i] = (const float*)d_in[i];
    a.out = (float*)d_out; a.ws = (unsigned char*)d_ws;
#if MK_PER_PHASE
    for (int p = 0; p < NPHASE; ++p) { a.ph_lo = p; a.ph_hi = p + 1; hipLaunchKernelGGL(fwd, dim3(grid), dim3(NTHREADS), LDS_BYTES, stream, a); }
#else
    a.ph_lo = 0; a.ph_hi = NPHASE; hipLaunchKernelGGL(fwd, dim3(grid), dim3(NTHREADS), LDS_BYTES, stream, a);
#endif
}
```

```cpp
#include <hip/hip_runtime.h>
#include <cstdint>
#include <cstdio>

#define GAS __attribute__((address_space(1)))
#define LAS __attribute__((address_space(3)))
typedef unsigned short bf16_t;
typedef short bf16x8 __attribute__((ext_vector_type(8)));
typedef short s16x4 __attribute__((ext_vector_type(4)));
typedef float f32x2 __attribute__((ext_vector_type(2)));
typedef float f32x4 __attribute__((ext_vector_type(4)));
typedef float f32x16 __attribute__((ext_vector_type(16)));
typedef unsigned u32x2 __attribute__((ext_vector_type(2)));
typedef unsigned u32x4 __attribute__((ext_vector_type(4)));
typedef GAS unsigned gu32;
#define RLX_AGENT __ATOMIC_RELAXED, __HIP_MEMORY_SCOPE_AGENT
#define LDS_WAIT() asm volatile("s_waitcnt lgkmcnt(0)" ::: "memory")
#define VM_WAIT() asm volatile("s_waitcnt vmcnt(0)" ::: "memory")
#define SBAR() __builtin_amdgcn_sched_barrier(0)

__device__ __forceinline__ unsigned cvt_pk_bf16(float lo, float hi) { unsigned r; asm volatile("v_cvt_pk_bf16_f32 %0, %1, %2" : "=v"(r) : "v"(lo), "v"(hi)); return r; }
__device__ __forceinline__ unsigned f2bf(float f) { unsigned u = __builtin_bit_cast(unsigned, f); return (u + 0x7fffu + ((u >> 16) & 1u)) >> 16; }
__device__ __forceinline__ unsigned pk2(float lo, float hi) { return f2bf(lo) | (f2bf(hi) << 16); }
__device__ __forceinline__ float bf2f(unsigned short b) { return __builtin_bit_cast(float, ((unsigned)b) << 16); }
__device__ __forceinline__ float bflo(unsigned w) { return __builtin_bit_cast(float, w << 16); }
__device__ __forceinline__ float bfhi(unsigned w) { return __builtin_bit_cast(float, w & 0xffff0000u); }
#define WAVE_DPP(v, ctrl) __builtin_bit_cast(float, __builtin_amdgcn_mov_dpp(__builtin_bit_cast(int, v), ctrl, 0xF, 0xF, true))
#define WAVE_DPP_ROWS(old_, v, ctrl, rmask) __builtin_bit_cast(float, __builtin_amdgcn_update_dpp(__builtin_bit_cast(int, old_), __builtin_bit_cast(int, v), ctrl, rmask, 0xF, false))
__device__ __forceinline__ float wave_sum(float v) {
    v += WAVE_DPP(v, 0xB1);
    v += WAVE_DPP(v, 0x4E);
    v += WAVE_DPP(v, 0x141);
    v += WAVE_DPP(v, 0x140);
    v += WAVE_DPP_ROWS(0.0f, v, 0x142, 0xA);
    v += WAVE_DPP_ROWS(0.0f, v, 0x143, 0xC);
    return __builtin_bit_cast(float, __builtin_amdgcn_readlane(__builtin_bit_cast(int, v), 63));
}
__device__ __forceinline__ float wave_max(float v) {
    v = fmaxf(v, WAVE_DPP(v, 0xB1)); v = fmaxf(v, WAVE_DPP(v, 0x4E)); v = fmaxf(v, WAVE_DPP(v, 0x141)); v = fmaxf(v, WAVE_DPP(v, 0x140));
    v = fmaxf(v, WAVE_DPP_ROWS(v, v, 0x142, 0xA)); v = fmaxf(v, WAVE_DPP_ROWS(v, v, 0x143, 0xC));
    return __builtin_bit_cast(float, __builtin_amdgcn_readlane(__builtin_bit_cast(int, v), 63));
}

#define XB_TMO      128
#define XB_XCNT(j)  (256  + 64 * (j))
#define XB_XSUB(j)  (1280 + 64 * (j))
#define XB_XGEN(j)  (2304 + 64 * (j))
#define XB_TOP      3328
#define XB_TOPGEN   3392
#define XCD_BAR_WORDS 3456
#define XB_SPIN_CAP (1u << 18)
__device__ __forceinline__ unsigned xb_ld(unsigned* p)              { return __hip_atomic_load(p, __ATOMIC_RELAXED, __HIP_MEMORY_SCOPE_AGENT); }
__device__ __forceinline__ unsigned xb_add(unsigned* p, unsigned v) { return __hip_atomic_fetch_add(p, v, __ATOMIC_RELAXED, __HIP_MEMORY_SCOPE_AGENT); }
__device__ __forceinline__ unsigned xb_xcc_id() { return (unsigned)__builtin_amdgcn_s_getreg((3 << 11) | 20) & 0xFu; }
#define XB_SPIN(cond, bar) do { unsigned _sp = 0; while (cond) { __builtin_amdgcn_s_sleep(1); \
    if ((++_sp & 255u) == 0u) { if (xb_ld(&(bar)[XB_TMO])) break; if (_sp > XB_SPIN_CAP) { atomicAdd(&(bar)[XB_TMO], 1u); break; } } } } while (0)
struct XcdBarrier { unsigned* bar; unsigned x; volatile LAS unsigned* st; };
__device__ __forceinline__ XcdBarrier xcd_barrier_post(unsigned* bar, volatile LAS unsigned* st, bool leader) {
    XcdBarrier b; b.bar = bar; b.x = xb_xcc_id(); b.st = st;
    if (leader) (void)xb_add(&bar[XB_XCNT(b.x)], 1u);
    return b;
}
__device__ __forceinline__ void xcd_barrier_complete(unsigned* bar, unsigned x, unsigned& nloc, unsigned& nx) {
    const unsigned G = gridDim.x * gridDim.y * gridDim.z;
    unsigned sum, cnt, mine, sp = 0u;
    for (;;) {
        sum = 0u; cnt = 0u; mine = 0u;
#pragma unroll
        for (unsigned j = 0; j < 16; ++j) { const unsigned c = xb_ld(&bar[XB_XCNT(j)]); sum += c; cnt += (c > 0u) ? 1u : 0u; mine = (j == x) ? c : mine; }
        if (sum == G) break;
        __builtin_amdgcn_s_sleep(1);
        if ((++sp & 255u) == 0u) { if (xb_ld(&bar[XB_TMO])) break; if (sp > XB_SPIN_CAP) { atomicAdd(&bar[XB_TMO], 1u); break; } }
    }
    nloc = mine > 0u ? mine : 1u; nx = cnt > 0u ? cnt : 1u;
}
__device__ __forceinline__ void xcd_barrier(const XcdBarrier& b, bool leader) {
    asm volatile("s_waitcnt vmcnt(0)" ::: "memory");
    __syncthreads();
    if (leader) {
        unsigned* bar = b.bar;
        __builtin_amdgcn_s_waitcnt(0);
        unsigned nloc = b.st[0], nx = b.st[1];
        if (nloc == 0u) { xcd_barrier_complete(bar, b.x, nloc, nx); b.st[0] = nloc; b.st[1] = nx; }
        const unsigned old = xb_add(&bar[XB_XSUB(b.x)], 1u);
        const unsigned gen = old / nloc;
        if (old + 1u == (gen + 1u) * nloc) {
            __builtin_amdgcn_fence(__ATOMIC_RELEASE, "agent");
            asm volatile("s_waitcnt vmcnt(0)" ::: "memory");
            const unsigned og = xb_add(&bar[XB_TOP], 1u);
            const unsigned tg = og / nx;
            if (og + 1u == (tg + 1u) * nx) xb_add(&bar[XB_TOPGEN], 1u);
            else XB_SPIN(xb_ld(&bar[XB_TOPGEN]) == tg, bar);
            __builtin_amdgcn_fence(__ATOMIC_ACQUIRE, "agent");
            xb_add(&bar[XB_XGEN(b.x)], 1u);
            asm volatile("s_waitcnt vmcnt(0)" ::: "memory");
        } else {
            XB_SPIN(xb_ld(&bar[XB_XGEN(b.x)]) == gen, bar);
            __builtin_amdgcn_fence(__ATOMIC_ACQUIRE, "agent");
            asm volatile("s_waitcnt vmcnt(0)" ::: "memory");
        }
    }
    __syncthreads();
}

namespace pg8 {
constexpr int BM = 256, BK = 64, HALF = 128, HTB = HALF * BK * 2, STAGE_BYTES = 8 * HTB, NXCD = 8, WGM = 8;
__host__ __device__ __forceinline__ int lds_byte(int r, int c) { const int st = (r >> 4) * 2 + (c >> 5), rr = r & 15, cc = c & 31, ob = rr * 64 + cc * 2; return st * 1024 + (ob ^ (((ob >> 9) & 1) << 5)); }
__host__ __device__ __forceinline__ void stage_rc(int b, int& R, int& C) { const int st = b / 1024, sb = b % 1024, swz = sb ^ (((sb >> 9) & 1) << 5); R = (st >> 1) * 16 + swz / 64; C = (st & 1) * 32 + (swz % 64) / 2; }
__host__ __device__ __forceinline__ int perm32(int rho) { const int n = rho >> 4, i = rho & 15; return 8 * (i >> 2) + 4 * n + (i & 3); }

struct Unit { int arow, brow, akoff, orow, ocol, nt, slab; };
struct Gemm { const bf16_t* A; const bf16_t* Bt; int lda, ldb, K; };

struct TileOrder {
    int nM, nN, nwg, G, c;
    __device__ __forceinline__ void init(int nM_, int nN_, int G_, int c_) { nM = nM_; nN = nN_; nwg = nM * nN; G = G_; c = c_; }
    __device__ __forceinline__ bool tile(int i, int& pm, int& pn) const {
        const long L = (long)i * G + c; if (L >= nwg) return false;
        int wgid = (int)L; { const int q = nwg / NXCD, r = nwg % NXCD, xcd = wgid % NXCD, off = wgid / NXCD; wgid = (xcd < r ? xcd * (q + 1) : r * (q + 1) + (xcd - r) * q) + off; }
        const int nig = WGM * nN, gid = wgid / nig, fm = gid * WGM, gsz = (nM - fm) < WGM ? (nM - fm) : WGM;
        pm = fm + ((wgid % nig) % gsz); pn = (wgid % nig) / gsz; return true;
    }
};
struct PlainSched : TileOrder {
    static constexpr bool KSPLIT = false;
    int akstep;
    __device__ __forceinline__ bool next(int i, Unit& u) const { int pm, pn; if (!tile(i, pm, pn)) return false; u.arow = pm * BM; u.brow = pn * BM; u.akoff = pn * akstep; u.orow = pm * BM; u.ocol = pn * BM; u.nt = 0; u.slab = -1; return true; }
};
struct MoeSched : TileOrder {
    static constexpr bool KSPLIT = false;
    int t1, t2, t3, t4, t5, t6, t7, ttot; int brows;
    __device__ __forceinline__ void set_tstart(const int (&ts)[9]) { t1 = ts[1]; t2 = ts[2]; t3 = ts[3]; t4 = ts[4]; t5 = ts[5]; t6 = ts[6]; t7 = ts[7]; ttot = ts[8]; }
    __device__ __forceinline__ int expert_of(int pm) const { return (pm >= t1) + (pm >= t2) + (pm >= t3) + (pm >= t4) + (pm >= t5) + (pm >= t6) + (pm >= t7); }
    __device__ __forceinline__ bool next(int i, Unit& u) const { int pm, pn; if (!tile(i, pm, pn)) return false;
        const int e = expert_of(pm);
        u.arow = pm * BM; u.brow = e * brows + pn * BM; u.akoff = 0; u.orow = pm * BM; u.ocol = pn * BM; u.nt = 0; u.slab = -1; return true; }
};
__device__ __forceinline__ int split_factor(int nwg, int G, int ktiles) { const int nleft = nwg % G; int S = 1;
#define PG8_TRY_S(v) if (nleft > 0 && (v) * nleft <= G && (ktiles % (2 * (v))) == 0 && ktiles / (v) >= 4) S = (v)
    PG8_TRY_S(2); PG8_TRY_S(4); PG8_TRY_S(7); PG8_TRY_S(8);
#undef PG8_TRY_S
    return S; }
struct MoeSplitSched : MoeSched {
    static constexpr bool KSPLIT = true;
    int nfull, nleft, S, ktiles;
    __device__ __forceinline__ void init2(int nM_, int nN_, int G_, int c_, int ktiles_) { init(nM_, nN_, G_, c_); ktiles = ktiles_; nfull = nwg / G; nleft = nwg - nfull * G; S = split_factor(nwg, G_, ktiles_); }
    __device__ __forceinline__ bool next(int i, Unit& u) const {
        const bool split = (S > 1) && (i >= nfull);
        const int lu = c / S, s = c - lu * S;
        const long L = split ? (long)nfull * G + lu : (long)i * G + c;
        if (L >= nwg || (split && (i > nfull || c >= nleft * S))) return false;
        int wgid = (int)L; { const int q = nwg / NXCD, r = nwg % NXCD, xcd = wgid % NXCD, off = wgid / NXCD; wgid = (xcd < r ? xcd * (q + 1) : r * (q + 1) + (xcd - r) * q) + off; }
        const int nig = WGM * nN, gid = wgid / nig, fm = gid * WGM, gsz = (nM - fm) < WGM ? (nM - fm) : WGM;
        const int pm = fm + ((wgid % nig) % gsz), pn = (wgid % nig) / gsz;
        const int e = expert_of(pm), ntp = ktiles / S;
        u.arow = pm * BM; u.brow = e * brows + pn * BM; u.nt = split ? ntp : 0; u.akoff = split ? s * ntp * BK : 0; u.orow = pm * BM; u.ocol = pn * BM; u.slab = split ? lu * S + s : -1; return true; }
};

struct EpiQKV0 {
    static constexpr bool PERM = true;
    bf16_t* O;
    __device__ __forceinline__ void operator()(const f32x4 (&acc)[2][2][4][2], const Unit& u, int wr, int wc, int fr, int fq) const {
        const int row0 = u.orow + wr * 64 + fr;
#pragma unroll
        for (int bj = 0; bj < 2; ++bj) {
            const int c = u.ocol + bj * HALF, ten = c >> 10, h = (c & 1023) >> 7;
#pragma unroll
            for (int ai = 0; ai < 2; ++ai)
#pragma unroll
                for (int m = 0; m < 4; ++m) { const int row = row0 + ai * HALF + m * 16, b = row >> 13, t = row & 8191;
                    bf16_t* p = O + ((((size_t)ten * 2 + b) * 8 + h) * 8192 + t) * 128 + wc * 32 + 8 * fq;
                    const f32x4 v0 = acc[ai][bj][m][0], v1 = acc[ai][bj][m][1];
                    u32x4 w; w.x = cvt_pk_bf16(v0[0], v0[1]); w.y = cvt_pk_bf16(v0[2], v0[3]); w.z = cvt_pk_bf16(v1[0], v1[1]); w.w = cvt_pk_bf16(v1[2], v1[3]);
                    *(u32x4*)p = w; }
        }
    }
};
struct EpiResF32 {
    static constexpr bool PERM = false;
    const float* res; float* out; int ldc; float alpha; float scale;
    __device__ __forceinline__ void operator()(const f32x4 (&acc)[2][2][4][2], const Unit& u, int wr, int wc, int fr, int fq) const {
        const int row0 = u.orow + wr * 64 + fr, col0 = u.ocol + wc * 32 + 4 * fq;
#pragma unroll
        for (int ai = 0; ai < 2; ++ai)
#pragma unroll
            for (int m = 0; m < 4; ++m) { const size_t off = (size_t)(row0 + ai * HALF + m * 16) * ldc + col0;
                f32x4 r[2][2];
#pragma unroll
                for (int bj = 0; bj < 2; ++bj)
#pragma unroll
                    for (int n = 0; n < 2; ++n) r[bj][n] = *(const f32x4*)(res + off + bj * HALF + n * 16);
#pragma unroll
                for (int bj = 0; bj < 2; ++bj)
#pragma unroll
                    for (int n = 0; n < 2; ++n) *(f32x4*)(out + off + bj * HALF + n * 16) = r[bj][n] * alpha + acc[ai][bj][m][n] * scale;
                asm volatile("" ::: "memory"); }
    }
};
struct EpiResLnF32 {
    static constexpr bool PERM = false;
    const float* res; float* out; int ldc; float alpha; float scale; const float* stat; const float* g; const float* b;
    __device__ __forceinline__ void operator()(const f32x4 (&acc)[2][2][4][2], const Unit& u, int wr, int wc, int fr, int fq) const {
        const int row0 = u.orow + wr * 64 + fr, col0 = u.ocol + wc * 32 + 4 * fq;
#pragma unroll
        for (int bj = 0; bj < 2; ++bj)
#pragma unroll
            for (int n = 0; n < 2; ++n) {
                const int col = col0 + bj * HALF + n * 16;
                const f32x4 gg = *(const f32x4*)(g + col), bb = *(const f32x4*)(b + col);
#pragma unroll
                for (int ai = 0; ai < 2; ++ai)
#pragma unroll
                    for (int m = 0; m < 4; ++m) { const int row = row0 + ai * HALF + m * 16; const size_t off = (size_t)row * ldc + col;
                        const float mean = stat[2 * (size_t)row], rstd = stat[2 * (size_t)row + 1];
                        const f32x4 r = *(const f32x4*)(res + off);
                        *(f32x4*)(out + off) = ((r - mean) * rstd * gg + bb) * alpha + acc[ai][bj][m][n] * scale; }
                asm volatile("" ::: "memory"); }
    }
};
struct EpiF32 {
    static constexpr bool PERM = false;
    float* out; int ldc;
    __device__ __forceinline__ void operator()(const f32x4 (&acc)[2][2][4][2], const Unit& u, int wr, int wc, int fr, int fq) const {
        const int row0 = u.orow + wr * 64 + fr, col0 = u.ocol + wc * 32 + 4 * fq;
#pragma unroll
        for (int ai = 0; ai < 2; ++ai)
#pragma unroll
            for (int m = 0; m < 4; ++m) { float* rowp = out + (size_t)(row0 + ai * HALF + m * 16) * ldc + col0;
#pragma unroll
                for (int bj = 0; bj < 2; ++bj)
#pragma unroll
                    for (int n = 0; n < 2; ++n) *(f32x4*)(rowp + bj * HALF + n * 16) = acc[ai][bj][m][n]; }
    }
};
struct EpiBf16 {
    static constexpr bool PERM = true;
    bf16_t* O0; int ld0; int split; bf16_t* O1; int ld1;
    __device__ __forceinline__ void operator()(const f32x4 (&acc)[2][2][4][2], const Unit& u, int wr, int wc, int fr, int fq) const {
        const int row0 = u.orow + wr * 64 + fr; bf16_t* base = O0; int ld = ld0, colt = u.ocol;
        if (colt >= split) { base = O1; ld = ld1; colt -= split; }
        const int col0 = colt + wc * 32 + 8 * fq;
#pragma unroll
        for (int ai = 0; ai < 2; ++ai)
#pragma unroll
            for (int m = 0; m < 4; ++m) { bf16_t* rowp = base + (size_t)(row0 + ai * HALF + m * 16) * ld + col0;
#pragma unroll
                for (int bj = 0; bj < 2; ++bj) { const f32x4 v0 = acc[ai][bj][m][0], v1 = acc[ai][bj][m][1];
                    u32x4 w; w.x = cvt_pk_bf16(v0[0], v0[1]); w.y = cvt_pk_bf16(v0[2], v0[3]); w.z = cvt_pk_bf16(v1[0], v1[1]); w.w = cvt_pk_bf16(v1[2], v1[3]);
                    *(u32x4*)(rowp + bj * HALF) = w; } }
    }
};
struct EpiYSlab {
    static constexpr bool PERM = true;
    bf16_t* O; int ld; float* slabs; unsigned* flags; int nN, S; float scale;
    __device__ __forceinline__ void operator()(const f32x4 (&acc)[2][2][4][2], const Unit& u, int wr, int wc, int fr, int fq) const {
        if (u.slab < 0) {
            const int row0 = u.orow + wr * 64 + fr, col0 = u.ocol + wc * 32 + 8 * fq;
#pragma unroll
            for (int ai = 0; ai < 2; ++ai)
#pragma unroll
                for (int m = 0; m < 4; ++m) { bf16_t* rowp = O + (size_t)(row0 + ai * HALF + m * 16) * ld + col0;
#pragma unroll
                    for (int bj = 0; bj < 2; ++bj) { const f32x4 v0 = acc[ai][bj][m][0] * scale, v1 = acc[ai][bj][m][1] * scale;
                        u32x4 w; w.x = cvt_pk_bf16(v0[0], v0[1]); w.y = cvt_pk_bf16(v0[2], v0[3]); w.z = cvt_pk_bf16(v1[0], v1[1]); w.w = cvt_pk_bf16(v1[2], v1[3]);
                        *(u32x4*)(rowp + bj * HALF) = w; } }
        } else {
            float* sl = slabs + (size_t)u.slab * 65536 + (size_t)(wr * 64 + fr) * 256 + wc * 32 + 8 * fq;
#pragma unroll
            for (int ai = 0; ai < 2; ++ai)
#pragma unroll
                for (int m = 0; m < 4; ++m)
#pragma unroll
                    for (int bj = 0; bj < 2; ++bj) { float* p = sl + (size_t)(ai * HALF + m * 16) * 256 + bj * HALF; *(f32x4*)p = acc[ai][bj][m][0] * scale; *(f32x4*)(p + 4) = acc[ai][bj][m][1] * scale; }
            if ((u.slab % S) == 0 && wr == 0 && wc == 0 && fr == 0 && fq == 0) flags[(u.orow >> 8) * nN + (u.ocol >> 8)] = (unsigned)u.slab + 1u;
        }
    }
};
typedef int v8i __attribute__((ext_vector_type(8)));
typedef int v8i_a16 __attribute__((ext_vector_type(8), aligned(16)));
__device__ __forceinline__ float quad_xor1(float v) { return __builtin_bit_cast(float, __builtin_amdgcn_mov_dpp(__builtin_bit_cast(int, v), 0xB1, 0xF, 0xF, true)); }
__device__ __forceinline__ float quad_xor2(float v) { return __builtin_bit_cast(float, __builtin_amdgcn_mov_dpp(__builtin_bit_cast(int, v), 0x4E, 0xF, 0xF, true)); }
__device__ __forceinline__ float quad_xor3(float v) { return __builtin_bit_cast(float, __builtin_amdgcn_mov_dpp(__builtin_bit_cast(int, v), 0x1B, 0xF, 0xF, true)); }
__device__ __forceinline__ unsigned pk4_fp8(float a, float b, float c, float d) { int w = __builtin_amdgcn_cvt_pk_fp8_f32(a, b, 0, false); w = __builtin_amdgcn_cvt_pk_fp8_f32(c, d, w, true); return (unsigned)w; }
__device__ __forceinline__ float silu_mul(float a, float b) { return a * __builtin_amdgcn_rcpf(1.0f + __builtin_amdgcn_exp2f(-1.4426950408889634f * a)) * b; }
struct EpiSwiGLU {
    static constexpr bool PERM = true;
    bf16_t* O; int ldc;
    __device__ __forceinline__ void operator()(const f32x4 (&acc)[2][2][4][2], const Unit& u, int wr, int wc, int fr, int fq) const {
        const int row0 = u.orow + wr * 64 + fr, col0 = (u.ocol >> 1) + wc * 32 + 8 * fq;
#pragma unroll
        for (int ai = 0; ai < 2; ++ai)
#pragma unroll
            for (int m = 0; m < 4; ++m) { bf16_t* rowp = O + (size_t)(row0 + ai * HALF + m * 16) * ldc + col0;
                const f32x4 g0 = acc[ai][0][m][0], g1 = acc[ai][0][m][1], u0 = acc[ai][1][m][0], u1 = acc[ai][1][m][1];
                u32x4 w; w.x = cvt_pk_bf16(silu_mul(g0[0], u0[0]), silu_mul(g0[1], u0[1])); w.y = cvt_pk_bf16(silu_mul(g0[2], u0[2]), silu_mul(g0[3], u0[3]));
                w.z = cvt_pk_bf16(silu_mul(g1[0], u1[0]), silu_mul(g1[1], u1[1])); w.w = cvt_pk_bf16(silu_mul(g1[2], u1[2]), silu_mul(g1[3], u1[3]));
                *(u32x4*)rowp = w; }
    }
};

struct Epi8 {
    static constexpr bool PERM = true;
    unsigned char* O; int ld; float scale;
    __device__ __forceinline__ void operator()(const f32x4 (&acc)[2][2][4][2], const Unit& u, int wr, int wc, int fr, int fq) const {
        const int row0 = u.orow + wr * 64 + fr, col0 = u.ocol + wc * 32 + 8 * fq;
#pragma unroll
        for (int ai = 0; ai < 2; ++ai)
#pragma unroll
            for (int m = 0; m < 4; ++m) { unsigned char* rowp = O + (size_t)(row0 + ai * HALF + m * 16) * ld + col0;
#pragma unroll
                for (int bj = 0; bj < 2; ++bj) { const f32x4 v0 = acc[ai][bj][m][0] * scale, v1 = acc[ai][bj][m][1] * scale;
                    u32x2 w; w.x = pk4_fp8(v0[0], v0[1], v0[2], v0[3]); w.y = pk4_fp8(v1[0], v1[1], v1[2], v1[3]); *(u32x2*)(rowp + bj * HALF) = w; } }
    }
};
struct EpiSwiGLU8 {
    static constexpr bool PERM = true;
    unsigned char* O; int ldc;
    __device__ __forceinline__ void operator()(const f32x4 (&acc)[2][2][4][2], const Unit& u, int wr, int wc, int fr, int fq) const {
        const int row0 = u.orow + wr * 64 + fr, col0 = (u.ocol >> 1) + wc * 32 + 8 * fq; constexpr float si = 1.0f / 64.0f;
#pragma unroll
        for (int ai = 0; ai < 2; ++ai)
#pragma unroll
            for (int m = 0; m < 4; ++m) { unsigned char* rowp = O + (size_t)(row0 + ai * HALF + m * 16) * ldc + col0;
                const f32x4 g0 = acc[ai][0][m][0] * si, g1 = acc[ai][0][m][1] * si, u0 = acc[ai][1][m][0] * (si * 8.0f), u1 = acc[ai][1][m][1] * (si * 8.0f);
                u32x2 w; w.x = pk4_fp8(silu_mul(g0[0], u0[0]), silu_mul(g0[1], u0[1]), silu_mul(g0[2], u0[2]), silu_mul(g0[3], u0[3]));
                w.y = pk4_fp8(silu_mul(g1[0], u1[0]), silu_mul(g1[1], u1[1]), silu_mul(g1[2], u1[2]), silu_mul(g1[3], u1[3]));
                *(u32x2*)rowp = w; }
    }
};
template <class Epi, class Sched, bool F8 = false>
__device__ __forceinline__ void gemm_phase(LAS unsigned char* lds, const Gemm g, const Sched& S, const Epi& E, const int tid) {
    const int wid = __builtin_amdgcn_readfirstlane(tid >> 6), lane = tid & 63, wr = wid >> 2, wc = wid & 3, fr = lane & 15, fq = lane >> 4;
    const int K = g.K, nt = K / BK;
    unsigned voffA[2], voffB[2];
#pragma unroll
    for (int i = 0; i < 2; ++i) { int R, C; stage_rc(tid * 16 + i * 8192, R, C); const int Rb = Epi::PERM ? ((R & ~31) + perm32(R & 31)) : R;
        voffA[i] = (unsigned)(R * g.lda + C) * 2u; voffB[i] = (unsigned)(Rb * g.ldb + C) * 2u; }
    const size_t kstep = (size_t)(BK * 2);
    const size_t hstepA = (size_t)HALF * g.lda * 2, hstepB = (size_t)HALF * g.ldb * 2;
    const unsigned ldsw = (unsigned)wid * 1024u;
    const int aoff = F8 ? lds_byte(wr * 64 + fr, fq * 16) : lds_byte(wr * 64 + fr, fq * 8), boff = F8 ? lds_byte(wc * 32 + fr, fq * 16) : lds_byte(wc * 32 + fr, fq * 8);
#define PG8_SA(b, h) (((b) * 2 + (h)) * HTB)
#define PG8_SB(b, h) ((4 + (b) * 2 + (h)) * HTB)
#define PG8_STAGE(bufoff, gbase, voff) do { _Pragma("unroll") for (int _i = 0; _i < 2; ++_i) \
        __builtin_amdgcn_global_load_lds((const unsigned*)((const char*)(gbase) + (voff)[_i]), (LAS unsigned*)(lds + (bufoff) + ldsw + _i * 8192), 16, 0, 0); } while (0)
#define PG8_LDA(dst, b, h) do { _Pragma("unroll") for (int m = 0; m < 4; ++m) { if constexpr (F8) { dst##8[m] = *(const LAS v8i_a16*)(lds + PG8_SA(b, h) + aoff + m * 2048); } \
        else { _Pragma("unroll") for (int k = 0; k < 2; ++k) dst[m][k] = *(const LAS bf16x8*)(lds + PG8_SA(b, h) + aoff + m * 2048 + k * 1024); } } } while (0)
#define PG8_LDB(dst, b, h) do { _Pragma("unroll") for (int n = 0; n < 2; ++n) { if constexpr (F8) { dst##8[n] = *(const LAS v8i_a16*)(lds + PG8_SB(b, h) + boff + n * 2048); } \
        else { _Pragma("unroll") for (int k = 0; k < 2; ++k) dst[n][k] = *(const LAS bf16x8*)(lds + PG8_SB(b, h) + boff + n * 2048 + k * 1024); } } } while (0)
#define PG8_MMA(ai, bj, At, Bt) do { __builtin_amdgcn_s_setprio(1); _Pragma("unroll") for (int m = 0; m < 4; ++m) _Pragma("unroll") for (int n = 0; n < 2; ++n) { if constexpr (F8) { \
            acc[ai][bj][m][n] = __builtin_amdgcn_mfma_scale_f32_16x16x128_f8f6f4(Bt##8[n], At##8[m], acc[ai][bj][m][n], 0, 0, 0, 0x7F7F7F7F, 0, 0x7F7F7F7F); \
        } else { _Pragma("unroll") for (int k = 0; k < 2; ++k) acc[ai][bj][m][n] = __builtin_amdgcn_mfma_f32_16x16x32_bf16(Bt[n][k], At[m][k], acc[ai][bj][m][n], 0, 0, 0); } } __builtin_amdgcn_s_setprio(0); } while (0)
#define PG8_WAIT_V(n) asm volatile("s_waitcnt vmcnt(" #n ")" ::: "memory")
#define PG8_WAIT_L(n) asm volatile("s_waitcnt lgkmcnt(" #n ")" ::: "memory")
#define PG8_BAR __builtin_amdgcn_s_barrier()
    Unit cur, nxt; int ui = 0;
    if (!S.next(0, cur)) return;
    f32x4 acc[2][2][4][2];
#pragma unroll
    for (int a = 0; a < 2; ++a)
#pragma unroll
        for (int b = 0; b < 2; ++b)
#pragma unroll
            for (int m = 0; m < 4; ++m)
#pragma unroll
                for (int n = 0; n < 2; ++n) acc[a][b][m][n] = (f32x4){0.f, 0.f, 0.f, 0.f};
    bf16x8 At[4][2], B0[2][2], B1[2][2]; v8i At8[4], B08[2], B18[2];
    const char* cA = (const char*)g.A + ((size_t)cur.arow * g.lda + cur.akoff) * 2; const char* cB = (const char*)g.Bt + ((size_t)cur.brow * g.ldb + (Sched::KSPLIT ? cur.akoff : 0)) * 2;
    PG8_STAGE(PG8_SB(0, 0), cB, voffB); PG8_STAGE(PG8_SB(0, 1), cB + hstepB, voffB); PG8_STAGE(PG8_SA(0, 0), cA, voffA); PG8_STAGE(PG8_SA(0, 1), cA + hstepA, voffA);
    if (wr == 1) PG8_BAR;
    PG8_WAIT_V(2); PG8_BAR;
    PG8_STAGE(PG8_SB(1, 0), cB + kstep, voffB); PG8_STAGE(PG8_SA(1, 0), cA + kstep, voffA); PG8_STAGE(PG8_SB(1, 1), cB + hstepB + kstep, voffB);
    PG8_WAIT_V(6); PG8_BAR;
    for (;;) {
        const bool has_next = S.next(ui + 1, nxt);
        const char* nA = has_next ? (const char*)g.A + ((size_t)nxt.arow * g.lda + nxt.akoff) * 2 : cA; const char* nB = has_next ? (const char*)g.Bt + ((size_t)nxt.brow * g.ldb + (Sched::KSPLIT ? nxt.akoff : 0)) * 2 : cB;
        const int ntc = (Sched::KSPLIT && cur.nt) ? cur.nt : nt;
        if constexpr (F8) {
#pragma unroll 1
            for (int t = 0; t < ntc; ++t) {
                const int b = t & 1; LAS unsigned char* lb = lds + b * (2 * HTB); LAS unsigned char* lo = lds + (b ^ 1) * (2 * HTB);
                const unsigned lbv = (unsigned)(uintptr_t)lb;
#define PG8_LDS32(dst, addr, imm) do { u32x4 lo_, hi_; asm volatile("ds_read_b128 %0, %2 offset:%3\n\tds_read_b128 %1, %2 offset:%4" : "=&v"(lo_), "=&v"(hi_) : "v"(addr), "i"(imm), "i"((imm) + 16) : "memory"); \
        dst = __builtin_bit_cast(v8i, __builtin_shufflevector(lo_, hi_, 0, 1, 2, 3, 4, 5, 6, 7)); } while (0)
                const char* s1 = (t + 1 < ntc) ? cA + (size_t)(t + 1) * kstep : nA + (size_t)(t + 1 - ntc) * kstep;
                const char* a2 = (t + 2 < ntc) ? cA + (size_t)(t + 2) * kstep : nA + (size_t)(t + 2 - ntc) * kstep;
                const char* b2 = (t + 2 < ntc) ? cB + (size_t)(t + 2) * kstep : nB + (size_t)(t + 2 - ntc) * kstep;
#define PG8_STAGE8(ldsdst, gbase, voff) do { _Pragma("unroll") for (int _i = 0; _i < 2; ++_i) \
        __builtin_amdgcn_global_load_lds((const unsigned*)((const char*)(gbase) + (voff)[_i]), (LAS unsigned*)((ldsdst) + ldsw + _i * 8192), 16, 0, 0); } while (0)
#pragma unroll
                for (int n = 0; n < 2; ++n) { PG8_LDS32(B08[n], lbv + (unsigned)(4 * HTB) + boff, n * 2048); PG8_LDS32(B18[n], lbv + (unsigned)(4 * HTB) + boff, HTB + n * 2048); }
                SBAR();
#pragma unroll
                for (int m = 0; m < 4; ++m) PG8_LDS32(At8[m], lbv + aoff, m * 2048);
                PG8_STAGE8(lo + HTB, s1 + hstepA, voffA);
                PG8_WAIT_V(8); PG8_WAIT_L(0); PG8_BAR; PG8_MMA(0, 0, At, B0); PG8_MMA(0, 1, At, B1); PG8_BAR; SBAR();
#pragma unroll
                for (int m = 0; m < 4; ++m) PG8_LDS32(At8[m], lbv + aoff, HTB + m * 2048);
                PG8_STAGE8(lb + 4 * HTB, b2, voffB); PG8_STAGE8(lb + 5 * HTB, b2 + hstepB, voffB); PG8_STAGE8(lb, a2, voffA);
                PG8_WAIT_V(8); PG8_WAIT_L(0); PG8_BAR; PG8_MMA(1, 0, At, B0); PG8_MMA(1, 1, At, B1); PG8_BAR; SBAR();
#undef PG8_STAGE8
#undef PG8_LDS32
            }
        } else
        for (int t = 0; t < ntc; t += 2) {
            const bool last = (t == ntc - 2);
            const char* a1 = cA + (size_t)(t + 1) * kstep;
            const char* a2 = last ? nA : cA + (size_t)(t + 2) * kstep; const char* b2 = last ? nB : cB + (size_t)(t + 2) * kstep;
            const char* a3 = a2 + kstep; const char* b3 = b2 + kstep;
            PG8_LDB(B0, 0, 0); PG8_LDB(B1, 0, 1); SBAR(); PG8_LDA(At, 0, 0); PG8_STAGE(PG8_SA(1, 1), a1 + hstepA, voffA);
            PG8_WAIT_V(8); PG8_WAIT_L(0); PG8_BAR; PG8_MMA(0, 0, At, B0); PG8_MMA(0, 1, At, B1); PG8_BAR; SBAR();
            PG8_LDA(At, 0, 1); PG8_STAGE(PG8_SB(0, 0), b2, voffB); PG8_STAGE(PG8_SB(0, 1), b2 + hstepB, voffB); PG8_STAGE(PG8_SA(0, 0), a2, voffA);
            PG8_WAIT_V(8); PG8_WAIT_L(0); PG8_BAR; PG8_MMA(1, 0, At, B0); PG8_MMA(1, 1, At, B1); PG8_BAR; SBAR();
            PG8_LDB(B0, 1, 0); PG8_LDB(B1, 1, 1); SBAR(); PG8_LDA(At, 1, 0); PG8_STAGE(PG8_SA(0, 1), a2 + hstepA, voffA);
            PG8_WAIT_V(8); PG8_WAIT_L(0); PG8_BAR; PG8_MMA(0, 0, At, B0); PG8_MMA(0, 1, At, B1); PG8_BAR; SBAR();
            PG8_LDA(At, 1, 1); PG8_STAGE(PG8_SB(1, 0), b3, voffB); PG8_STAGE(PG8_SB(1, 1), b3 + hstepB, voffB); PG8_STAGE(PG8_SA(1, 0), a3, voffA);
            PG8_WAIT_V(8); PG8_WAIT_L(0); PG8_BAR; PG8_MMA(1, 0, At, B0); PG8_MMA(1, 1, At, B1); PG8_BAR; SBAR();
        }
        if (wr == 0) PG8_BAR;
        { int t2 = tid; asm volatile("" : "+v"(t2));
          const int w2 = __builtin_amdgcn_readfirstlane(t2 >> 6), l2 = t2 & 63; E(acc, cur, w2 >> 2, w2 & 3, l2 & 15, l2 >> 4); }
        if (!has_next) break;
#pragma unroll
        for (int a = 0; a < 2; ++a)
#pragma unroll
            for (int b = 0; b < 2; ++b)
#pragma unroll
                for (int m = 0; m < 4; ++m)
#pragma unroll
                    for (int n = 0; n < 2; ++n) acc[a][b][m][n] = (f32x4){0.f, 0.f, 0.f, 0.f};
        cur = nxt; cA = nA; cB = nB; ++ui;
        if (wr == 1) PG8_BAR;
    }
    PG8_WAIT_V(0);
    PG8_BAR;
#undef PG8_SA
#undef PG8_SB
#undef PG8_STAGE
#undef PG8_LDA
#undef PG8_LDB
#undef PG8_MMA
#undef PG8_WAIT_V
#undef PG8_WAIT_L
#undef PG8_BAR
}
}
namespace att {
constexpr int D = 128, NW = 8, QBLK = 32, KVBLK = 64, QB = NW * QBLK;
constexpr int SHM_V = KVBLK * D * 2, SHM_K = KVBLK * D * 2;
constexpr int OFF_V = 0, OFF_K = 2 * SHM_V, OFF_WS = OFF_K + 2 * SHM_K, OFF_NCL = OFF_WS + NW * 64 * 4, OFF_LUT = OFF_NCL + (8192 + 256) * 4, OFF_KM = OFF_LUT + 1024, OFF_MISC = OFF_KM + 32 * 128 * 4, LDS_END = OFF_MISC + 256;
constexpr float SCALE = 0.08838834764831845f, LOG2E = 1.4426950408889634f, C2 = SCALE * LOG2E;
constexpr float THR2 = 8.f * LOG2E;
#define KSWZ(row, colB) ((row) * 256 + ((colB) ^ (((row) & 7) << 4)))
__device__ __forceinline__ int v_st(int k, int c) { const int kk = (k & ~0xC) | ((k & 4) << 1) | ((k & 8) >> 1); return ((kk >> 3) * 4 + (c >> 5)) * 512 + ((kk & 7) * 32 + (c & 31)) * 2; }
__device__ __forceinline__ int v_rd_base(int lane) { return ((lane & 3) << 3) | (((lane >> 2) & 3) << 6) | (((lane >> 4) & 1) << 5) | (((lane >> 5) & 1) << 8); }
constexpr int v_rd_off(int d0, int ks, int half) { return d0 * 512 + ks * 4096 + half * 2048; }
__device__ __forceinline__ int crow(int r, int hi) { return (r & 3) + 8 * (r >> 2) + 4 * hi; }
__device__ __forceinline__ bf16x8 load8(const bf16_t* p) { return *reinterpret_cast<const bf16x8*>(p); }

__device__ __forceinline__ void partialSM(f32x16& p0, f32x16& p1, float& m_reg, float& mn, float& alpha) {
    float pmax = p0[0];
#pragma unroll
    for (int r = 1; r < 16; ++r) pmax = fmaxf(pmax, p0[r]);
#pragma unroll
    for (int r = 0; r < 16; ++r) pmax = fmaxf(pmax, p1[r]);
    { auto rr = __builtin_amdgcn_permlane32_swap(__float_as_uint(pmax), __float_as_uint(pmax), false, false);
      pmax = fmaxf(__uint_as_float(rr[0]), __uint_as_float(rr[1])); }
    if (__builtin_expect(__all((pmax - m_reg) <= THR2), 1)) { mn = m_reg; alpha = 1.f; }
    else { mn = fmaxf(m_reg, pmax); alpha = __builtin_amdgcn_exp2f(m_reg - mn); m_reg = mn; }
#pragma unroll
    for (int r = 0; r < 16; ++r) p0[r] = p0[r] - mn;
#pragma unroll
    for (int r = 0; r < 16; ++r) p1[r] = p1[r] - mn;
#pragma unroll
    for (int r = 0; r < 16; ++r) p0[r] = __builtin_amdgcn_exp2f(p0[r]);
}
__device__ __forceinline__ void finishSM(f32x16& p0, f32x16& p1, float alpha, float& l_reg, bf16x8& pa0, bf16x8& pa1, bf16x8& pa2, bf16x8& pa3) {
#pragma unroll
    for (int r = 0; r < 16; ++r) p1[r] = __builtin_amdgcn_exp2f(p1[r]);
    float ps = 0;
#pragma unroll
    for (int r = 0; r < 16; ++r) ps += p0[r];
#pragma unroll
    for (int r = 0; r < 16; ++r) ps += p1[r];
    { auto rr = __builtin_amdgcn_permlane32_swap(__float_as_uint(ps), __float_as_uint(ps), false, false);
      ps = __uint_as_float(rr[0]) + __uint_as_float(rr[1]); }
    l_reg = l_reg * alpha + ps;
#define PK4(P, B_, OUT) do { unsigned a0 = cvt_pk_bf16(P[B_+0], P[B_+1]), a1 = cvt_pk_bf16(P[B_+2], P[B_+3]);                          \
        unsigned b0 = cvt_pk_bf16(P[B_+4], P[B_+5]), b1 = cvt_pk_bf16(P[B_+6], P[B_+7]);                                             \
        auto r0 = __builtin_amdgcn_permlane32_swap(a0, b0, false, false); auto r1 = __builtin_amdgcn_permlane32_swap(a1, b1, false, false); \
        u32x4 w = {r0[0], r1[0], r0[1], r1[1]}; OUT = *reinterpret_cast<bf16x8*>(&w); } while (0)
    PK4(p0, 0, pa0); PK4(p0, 8, pa1); PK4(p1, 0, pa2); PK4(p1, 8, pa3);
#undef PK4
}
template <int KB>
__device__ __forceinline__ void qkt(f32x16& p0, f32x16& p1, const char* K_lds, int r32, int hi, const bf16x8* qr) {
    p0 = f32x16{}; p1 = f32x16{};
    const char* kb[4];
#pragma unroll
    for (int dd = 0; dd < 4; ++dd) kb[dd] = K_lds + KB * SHM_K + KSWZ(r32, (dd * 16 + hi * 8) * 2);
#pragma unroll
    for (int d0 = 0; d0 < 8; ++d0) { const char* a = kb[d0 & 3] + (d0 >> 2) * 128;
        bf16x8 b0 = *reinterpret_cast<const bf16x8*>(a);
        bf16x8 b1 = *reinterpret_cast<const bf16x8*>(a + 32 * 256);
        p0 = __builtin_amdgcn_mfma_f32_32x32x16_bf16(b0, qr[d0], p0, 0, 0, 0);
        p1 = __builtin_amdgcn_mfma_f32_32x32x16_bf16(b1, qr[d0], p1, 0, 0, 0); }
}
template <int VB>
__device__ __forceinline__ void pv_tile(f32x16* o, int vb0, bf16x8 pa0, bf16x8 pa1, bf16x8 pa2, bf16x8 pa3) {
#define TRRD(dst, off) asm volatile("ds_read_b64_tr_b16 %0, %1 offset:%2" : "=&v"(dst) : "v"(vb0), "i"(off) : "memory")
#define PV_D0(d0) do { s16x4 l0, l1, l2, l3, h0, h1, h2, h3; constexpr int b_ = VB * SHM_V + v_rd_off(d0, 0, 0); \
        TRRD(l0, b_); TRRD(h0, b_ + 2048); TRRD(l1, b_ + 4096); TRRD(h1, b_ + 6144); TRRD(l2, b_ + 8192); TRRD(h2, b_ + 10240); TRRD(l3, b_ + 12288); TRRD(h3, b_ + 14336); \
        asm volatile("s_waitcnt lgkmcnt(0)" ::: "memory"); SBAR(); \
        o[d0] = __builtin_amdgcn_mfma_f32_32x32x16_bf16(pa0, (bf16x8){l0[0], l0[1], l0[2], l0[3], h0[0], h0[1], h0[2], h0[3]}, o[d0], 0, 0, 0);   \
        o[d0] = __builtin_amdgcn_mfma_f32_32x32x16_bf16(pa1, (bf16x8){l1[0], l1[1], l1[2], l1[3], h1[0], h1[1], h1[2], h1[3]}, o[d0], 0, 0, 0);   \
        o[d0] = __builtin_amdgcn_mfma_f32_32x32x16_bf16(pa2, (bf16x8){l2[0], l2[1], l2[2], l2[3], h2[0], h2[1], h2[2], h2[3]}, o[d0], 0, 0, 0);   \
        o[d0] = __builtin_amdgcn_mfma_f32_32x32x16_bf16(pa3, (bf16x8){l3[0], l3[1], l3[2], l3[3], h3[0], h3[1], h3[2], h3[3]}, o[d0], 0, 0, 0); } while (0)
    PV_D0(0); PV_D0(1); PV_D0(2); PV_D0(3);
#undef PV_D0
#undef TRRD
}

template <int VAR>
__device__ __forceinline__ void prep(f32x16& p0, f32x16& p1, int kb, int pos, int qlo, int hi, const LAS float* ncl, int nclbase, const LAS float* lut, unsigned selmask, float farL) {
    const float NEG = -__builtin_inff();
    if constexpr (VAR == 0) {
        if (kb + KVBLK - 1 > qlo) {
            const int dq = pos - kb - 4 * hi;
#pragma unroll
            for (int r = 0; r < 16; ++r) { const int c = (r & 3) + 8 * (r >> 2);
                if (dq - c < 0) p0[r] = NEG;
                if (dq - c - 32 < 0) p1[r] = NEG; }
        }
        const LAS float* nb = ncl + (kb - nclbase) + 4 * hi;
#pragma unroll
        for (int g = 0; g < 4; ++g) { const f32x4 b0 = *(const LAS f32x4*)(nb + 8 * g), b1 = *(const LAS f32x4*)(nb + 32 + 8 * g);
#pragma unroll
            for (int j = 0; j < 4; ++j) { p0[4 * g + j] = fmaf(p0[4 * g + j], C2, b0[j]); p1[4 * g + j] = fmaf(p1[4 * g + j], C2, b1[j]); }
            asm volatile("" ::: "memory"); }
    } else {
        const bool selb = (selmask >> (kb >> 8)) & 1u;
        if (kb + KVBLK - 1 + 128 <= qlo) {
            const float add = selb ? farL : NEG;
#pragma unroll
            for (int r = 0; r < 16; ++r) { p0[r] = fmaf(p0[r], C2, add); p1[r] = fmaf(p1[r], C2, add); }
        } else {
            const int dq = pos - kb - 4 * hi;
#pragma unroll
            for (int r = 0; r < 16; ++r) { const int c = (r & 3) + 8 * (r >> 2);
                const int d0 = dq - c, d1 = dq - c - 32;
                const float b0 = lut[d0 < 0 ? 0 : (d0 > 128 ? 128 : d0)], b1 = lut[d1 < 0 ? 0 : (d1 > 128 ? 128 : d1)];
                const float t0 = fmaf(p0[r], C2, b0), t1 = fmaf(p1[r], C2, b1);
                p0[r] = (d0 < 0 || !selb) ? NEG : t0; p1[r] = (d1 < 0 || !selb) ? NEG : t1;
                if ((r & 3) == 3) asm volatile("" ::: "memory"); }
        }
    }
}

template <int VAR, int OP>
__device__ __forceinline__ void attn_block(const bf16_t* Q, const bf16_t* Kh, const bf16_t* Vh, unsigned char* O, int P0, int j_lo, int j_hi, char* lds,
                                           const LAS float* ncl, int nclbase, const LAS float* lut, unsigned selmask, float farL, const bf16x8 (&qr)[8], const int tid) {
    const int wid = __builtin_amdgcn_readfirstlane(tid >> 6), lane = tid & 63, r32 = lane & 31, hi = lane >> 5;
    const int NT = j_hi - j_lo;
    const int qlo = P0 + wid * QBLK, pos = qlo + r32;
    char* V_lds = lds + OFF_V; char* K_lds = lds + OFF_K;
    float* ws = (float*)(lds + OFF_WS) + wid * 64; float* li_l = ws, * al_l = ws + 32;
    float m_reg = -1e30f, l_reg = 0; f32x16 o[4] = {};
    const int sr = tid >> 4, sc = (tid & 15) * 8, vst0 = v_st(sr, sc), vst1 = v_st(32 + sr, sc), kws = KSWZ(sr, sc * 2);
    const int vb0 = (int)(uintptr_t)V_lds + v_rd_base(lane);
    bf16x8 st_v0, st_v1, st_k0, st_k1;
#define ROW(p, k0, rr) ((p) + (size_t)((k0) + (rr)) * D + sc)
#define SLOAD_H(k0) do { st_v0 = load8(ROW(Vh, k0, sr)); st_v1 = load8(ROW(Vh, k0, 32 + sr)); st_k0 = load8(ROW(Kh, k0, sr)); st_k1 = load8(ROW(Kh, k0, 32 + sr)); } while (0)
#define SWRITE_HK(bf) do { *(bf16x8*)(K_lds + (bf) * SHM_K + kws) = st_k0; *(bf16x8*)(K_lds + (bf) * SHM_K + kws + 32 * 256) = st_k1; } while (0)
#define SWRITE_HV(bf) do { *(bf16x8*)(V_lds + (bf) * SHM_V + vst0) = st_v0; *(bf16x8*)(V_lds + (bf) * SHM_V + vst1) = st_v1; } while (0)
#define SWRITE_H(bf) do { SWRITE_HV(bf); SWRITE_HK(bf); } while (0)
#define RESC(a) do { if (__any((a) < 1.f)) { if (hi == 0) al_l[r32] = (a); asm volatile("s_waitcnt lgkmcnt(0)" ::: "memory");              \
                     for (int d_ = 0; d_ < 4; ++d_) for (int r = 0; r < 16; ++r) o[d_][r] *= al_l[crow(r, hi)]; } } while (0)
#define KBASE(t) ((j_lo + (t)) * KVBLK)
#define PREP(P0_, P1_, t) prep<VAR>(P0_, P1_, KBASE(t), pos, qlo, hi, ncl, nclbase, lut, selmask, farL)
    f32x16 pA0, pA1, pB0, pB1; float mnA, mnB, alA, alB; bf16x8 pa0, pa1, pa2, pa3;
    SLOAD_H(KBASE(0)); VM_WAIT(); SWRITE_H(0); SBAR();
    if (NT > 1) SLOAD_H(KBASE(1));
    __syncthreads();
    SBAR(); qkt<0>(pA0, pA1, K_lds, r32, hi, qr);
    PREP(pA0, pA1, 0); partialSM(pA0, pA1, m_reg, mnA, alA);
    if (NT > 1) { VM_WAIT(); SWRITE_H(1); }
    __syncthreads();
#define HALF_STEP(PX0, PX1, mnX, alX, PY0, PY1, alY, t, KB, VB, SB) do {                                                      \
        SBAR(); qkt<KB>(PX0, PX1, K_lds, r32, hi, qr);                                                                        \
        finishSM(PY0, PY1, alY, l_reg, pa0, pa1, pa2, pa3); SBAR();                                                           \
        if ((t) + 1 < NT) { SLOAD_H(KBASE((t) + 1)); SBAR(); }                                                                \
        pv_tile<VB>(o, vb0, pa0, pa1, pa2, pa3); PREP(PX0, PX1, (t)); partialSM(PX0, PX1, m_reg, mnX, alX);                   \
        __syncthreads();                                                                                                      \
        if ((t) + 1 < NT) { VM_WAIT(); SWRITE_H(SB); }                                                                        \
        RESC(alX); __syncthreads(); } while (0)
    for (int t = 1; t + 1 < NT; t += 2) {
        HALF_STEP(pB0, pB1, mnB, alB, pA0, pA1, alA, t, 1, 0, 0);
        HALF_STEP(pA0, pA1, mnA, alA, pB0, pB1, alB, t + 1, 0, 1, 1);
    }
    const bool even = (NT & 1) == 0;
    if (even) { SBAR(); qkt<1>(pB0, pB1, K_lds, r32, hi, qr); SBAR(); }
    finishSM(pA0, pA1, alA, l_reg, pa0, pa1, pa2, pa3); SBAR();
    pv_tile<0>(o, vb0, pa0, pa1, pa2, pa3);
    if (even) { PREP(pB0, pB1, NT - 1); partialSM(pB0, pB1, m_reg, mnB, alB); __syncthreads(); RESC(alB);
        finishSM(pB0, pB1, alB, l_reg, pa0, pa1, pa2, pa3); SBAR(); pv_tile<1>(o, vb0, pa0, pa1, pa2, pa3); }
    SBAR();
    if (hi == 0) li_l[r32] = l_reg; asm volatile("s_waitcnt lgkmcnt(0)" ::: "memory");
    float rli[16];
#pragma unroll
    for (int r = 0; r < 16; ++r) rli[r] = __builtin_amdgcn_rcpf(li_l[crow(r, hi)]);
    unsigned ob = (unsigned)((wid * QBLK + 4 * hi) * OP + r32);
    asm volatile("" : "+v"(ob));
    char* pb = (char*)O + ob;
#pragma unroll
    for (int r = 0; r < 16; ++r) { char* pr = pb + (size_t)((r & 3) + 8 * (r >> 2)) * OP;
#pragma unroll
        for (int d0 = 0; d0 < 4; ++d0) { const float v = o[d0][r] * (rli[r] * 16.0f);
            const float v1 = pg8::quad_xor1(v), v2 = pg8::quad_xor2(v), v3 = pg8::quad_xor3(v);
            if ((r32 & 3) == 0) *(unsigned*)(pr + d0 * 32) = pg8::pk4_fp8(v, v1, v2, v3); } }
    __syncthreads();
#undef ROW
#undef SLOAD_H
#undef SWRITE_HK
#undef SWRITE_HV
#undef SWRITE_H
#undef RESC
#undef KBASE
#undef PREP
#undef HALF_STEP
}
}
constexpr int NWAVES = 8, NTHREADS = 512;
constexpr int BATCH = 2, T = 8192, M = BATCH * T, DM = 2048;
constexpr int NQKV0 = 6144, WIN0_PITCH = 6152, FF0 = 5632, NIN1 = 1104, NIN1P = 1280, NQ1 = 9216, NEXP = 8, FFE = 7168;
constexpr int MAXROWS = 34816;
constexpr float ALPHA = 1.4142135623730951f;
constexpr float LN_EPS = 1e-5f, RMS_EPS = 1e-6f;
constexpr float LOG2E = 1.4426950408889634f;
constexpr size_t MiB = 1u << 20;
constexpr size_t WS_CTL = 0, CTL_ZERO_BYTES = 1 * MiB;
constexpr size_t WS_WIN0 = 2 * MiB, WS_WOUT0 = 26 * MiB, WS_WFF13 = 34 * MiB, WS_WFF2 = 78 * MiB, WS_WIN1 = 100 * MiB, WS_WQ1 = 105 * MiB, WS_WUV = 114 * MiB, WS_WOUT1 = 118 * MiB,
                 WS_WE13 = 126 * MiB, WS_WE2 = 574 * MiB, WS_XB = 798 * MiB, WS_SMALL = 862 * MiB, WS_BIG = 896 * MiB;
constexpr size_t SM_LOGF = WS_SMALL, SM_CL2 = SM_LOGF + (size_t)M * 8 * 4, SM_KMEAN = SM_CL2 + 16 * 8192 * 4, SM_QN = SM_KMEAN + 16 * 32 * 128 * 4, SM_KN = SM_QN + 16 * 32 * 4,
                 SM_WIDX = SM_KN + 16 * 32 * 4 + 3072, SM_KIDX = SM_WIDX + (size_t)M * 16 * 4, SM_RTE = SM_KIDX + (size_t)M * 64 * 2, SM_RTG = SM_RTE + (size_t)M * 2 * 4, SM_RTP = SM_RTG + (size_t)M * 2 * 4,
                 SM_ROW = SM_RTP + (size_t)M * 2 * 4, SM_SEL = SM_ROW + (size_t)M * 2 * 4, SM_STAT = SM_SEL + (size_t)M * 256 * 4, SM_END = SM_STAT + (size_t)M * 2 * 4;
static_assert(SM_END <= WS_BIG, "small region");
constexpr size_t B0_QKV = WS_BIG, B0_O = WS_BIG + 192 * MiB, B0_ACT = WS_BIG + 256 * MiB;
constexpr size_t B1_PROJ = WS_BIG, B1_CQN = WS_BIG + 80 * MiB, B1_CKVN = WS_BIG + 96 * MiB, B1_QIDX = WS_BIG + 112 * MiB, B1_QLAT = WS_BIG + 144 * MiB, B1_SC = WS_BIG + 400 * MiB, B1_OB = WS_BIG;
constexpr size_t SC_PER_BATCH = (size_t)16384 * (64 * 65 / 2);
static_assert(B1_SC + 2 * SC_PER_BATCH * 4 <= WS_BIG + 662 * MiB, "scores");
constexpr size_t B1_XG = WS_BIG, B1_H = WS_BIG + 136 * MiB, B1_Y = WS_BIG;
constexpr size_t B1_SLAB = WS_BIG + 614 * MiB;
constexpr size_t WS_NEED = WS_BIG + 680 * MiB;
constexpr int CW_BAR = 4096, CW_CNT = 8192, CW_QIDX = 12288, CW_QTOPK = 12352, CW_FLAG = 16384;
constexpr int LDS_BYTES = 147456, SCR_BYTES = 143360, MISC_OFF = SCR_BYTES;

struct Args { const float* in[28]; float* out; unsigned char* ws; int ph_lo, ph_hi; };
struct Ctx {
    LAS unsigned char* lds; unsigned char* ldsg; unsigned char* ws; float* out;
    int tid, lane, wave, G, bid;
};

__device__ __forceinline__ void transpose_item(const float* W, int ldw, int Nsrc, int Ndst, bf16_t* WT, int ldt, int koff, int mode, int row_off, int zero_koff, LAS float* scr, int item, int lane) {
    const int nblk = Ndst / 32, kb = item / nblk, nb = item % nblk, k0 = 64 * kb, n0 = 32 * nb;
    const int ncol = n0 + (lane & 31); const bool ok = ncol < Nsrc;
    float tv[32];
#pragma unroll
    for (int i = 0; i < 32; ++i) { const int kk = 2 * i + (lane >> 5); tv[i] = ok ? W[(size_t)(k0 + kk) * ldw + ncol] : 0.f; }
#pragma unroll
    for (int i = 0; i < 32; ++i) { const int kk = 2 * i + (lane >> 5); scr[kk * 33 + (lane & 31)] = tv[i]; }
    LDS_WAIT(); asm volatile("" ::: "memory");
    const int c = lane & 7;
#pragma unroll
    for (int j = 0; j < 4; ++j) { const int n = (lane >> 3) + 8 * j; const LAS float* s = scr + (8 * c) * 33 + n;
        u32x4 o; o.x = pk2(s[0 * 33], s[1 * 33]); o.y = pk2(s[2 * 33], s[3 * 33]); o.z = pk2(s[4 * 33], s[5 * 33]); o.w = pk2(s[6 * 33], s[7 * 33]);
        const int nn = n0 + n; const int drow = mode ? ((nn >> 7) * 256 + row_off + (nn & 127)) : (row_off + nn);
        *(GAS u32x4*)(WT + (size_t)drow * ldt + koff + k0 + 8 * c) = o;
        if (zero_koff >= 0) *(GAS u32x4*)(WT + (size_t)drow * ldt + zero_koff + k0 + 8 * c) = (u32x4){0u, 0u, 0u, 0u}; }
    LDS_WAIT(); asm volatile("" ::: "memory");
}

__device__ __forceinline__ void transpose_item8(const float* W, int ldw, int Ndst, unsigned char* WT, int ldt, int mode, int row_off, LAS float* scr, int item, int lane, int koff = 0, int zero_koff = -1) {
    const int nblk = Ndst / 32, kb = item / nblk, nb = item % nblk, k0 = 64 * kb, n0 = 32 * nb;
    const int ncol = n0 + (lane & 31);
    float tv[32];
#pragma unroll
    for (int i = 0; i < 32; ++i) { const int kk = 2 * i + (lane >> 5); tv[i] = W[(size_t)(k0 + kk) * ldw + ncol]; }
#pragma unroll
    for (int i = 0; i < 32; ++i) { const int kk = 2 * i + (lane >> 5); scr[kk * 33 + (lane & 31)] = tv[i] * 64.0f; }
    LDS_WAIT(); asm volatile("" ::: "memory");
    const int c = lane & 7;
#pragma unroll
    for (int j = 0; j < 4; ++j) { const int n = (lane >> 3) + 8 * j; const LAS float* s = scr + (8 * c) * 33 + n;
        u32x2 o; o.x = pg8::pk4_fp8(s[0 * 33], s[1 * 33], s[2 * 33], s[3 * 33]); o.y = pg8::pk4_fp8(s[4 * 33], s[5 * 33], s[6 * 33], s[7 * 33]);
        const int nn = n0 + n; const int drow = mode ? ((nn >> 7) * 256 + row_off + (nn & 127)) : (row_off + nn);
        *(GAS u32x2*)(WT + (size_t)drow * ldt + koff + k0 + 8 * c) = o;
        if (zero_koff >= 0) *(GAS u32x2*)(WT + (size_t)drow * ldt + zero_koff + k0 + 8 * c) = (u32x2){0u, 0u}; }
    LDS_WAIT(); asm volatile("" ::: "memory");
}
template <bool F8>
__device__ __forceinline__ void transpose_tile(const float* W, int ldw, int Nsrc, void* WTv, int ldt, int koff, int mode, int row_off, int zero_koff, int k0, int n0, LAS float* tile, int tid) {
    constexpr int KT = F8 ? 128 : 64, NI = KT / 8;
    const int wv = tid >> 6, ln = tid & 63;
    float v[NI][4];
#pragma unroll
    for (int i = 0; i < NI; ++i)
#pragma unroll
        for (int e = 0; e < 4; ++e) { const int col = ln + 64 * e; v[i][e] = (n0 + col) < Nsrc ? W[(size_t)(k0 + wv + 8 * i) * ldw + n0 + col] : 0.f; }
#pragma unroll
    for (int i = 0; i < NI; ++i)
#pragma unroll
        for (int e = 0; e < 4; ++e) tile[(wv + 8 * i) * 257 + ln + 64 * e] = v[i][e];
    __syncthreads();
    const int c = tid & 7;
#pragma unroll
    for (int j = 0; j < 4; ++j) { const int n = (tid >> 3) + 64 * j; const int nn = n0 + n; const int drow = mode ? ((nn >> 7) * 256 + row_off + (nn & 127)) : (row_off + nn);
        if constexpr (F8) { const LAS float* s = tile + (16 * c) * 257 + n; u32x4 o;
            o.x = pg8::pk4_fp8(s[0 * 257] * 64.f, s[1 * 257] * 64.f, s[2 * 257] * 64.f, s[3 * 257] * 64.f); o.y = pg8::pk4_fp8(s[4 * 257] * 64.f, s[5 * 257] * 64.f, s[6 * 257] * 64.f, s[7 * 257] * 64.f);
            o.z = pg8::pk4_fp8(s[8 * 257] * 64.f, s[9 * 257] * 64.f, s[10 * 257] * 64.f, s[11 * 257] * 64.f); o.w = pg8::pk4_fp8(s[12 * 257] * 64.f, s[13 * 257] * 64.f, s[14 * 257] * 64.f, s[15 * 257] * 64.f);
            *(GAS u32x4*)((unsigned char*)WTv + (size_t)drow * ldt + koff + k0 + 16 * c) = o; }
        else { const LAS float* s = tile + (8 * c) * 257 + n; u32x4 o;
            o.x = pk2(s[0 * 257], s[1 * 257]); o.y = pk2(s[2 * 257], s[3 * 257]); o.z = pk2(s[4 * 257], s[5 * 257]); o.w = pk2(s[6 * 257], s[7 * 257]);
            *(GAS u32x4*)((bf16_t*)WTv + (size_t)drow * ldt + koff + k0 + 8 * c) = o;
            if (zero_koff >= 0) *(GAS u32x4*)((bf16_t*)WTv + (size_t)drow * ldt + zero_koff + k0 + 8 * c) = (u32x4){0u, 0u, 0u, 0u}; } }
    __syncthreads();
}
struct ProIn { const float *x, *w_in0, *b_forget, *w_out0, *w1, *w3, *w2, *w_in1, *w_uq, *w_qidx, *w_uk, *w_uv, *w_out1, *e1, *e3, *e2; };
__device__ __forceinline__ void phase_prologue(const Ctx& F, const ProIn& I) {
    LAS float* scr = (LAS float*)(F.lds + F.wave * 8448);
    LAS float* wf = (LAS float*)(F.lds + 69632);
    const int gw = F.bid * NWAVES + F.wave, NGW = F.G * NWAVES;
    unsigned char* ws = F.ws;
    for (int i = F.tid; i < 8 * 2048; i += NTHREADS) { const int j = i & 7, k = i >> 3; wf[j * 2048 + k] = I.w_in0[(size_t)k * WIN0_PITCH + 6144 + j]; }
    __syncthreads();
    for (int m = gw; m < M; m += NGW) {
        const GAS f32x4* xr = (const GAS f32x4*)(I.x + (size_t)m * DM) + F.lane;
        f32x4 v[8];
#pragma unroll
        for (int j = 0; j < 8; ++j) v[j] = xr[64 * j];
        GAS u32x2* o8 = (GAS u32x2*)((bf16_t*)(ws + WS_XB) + (size_t)m * DM) + F.lane;
#pragma unroll
        for (int j = 0; j < 8; ++j) { u32x2 w; w.x = pk2(v[j][0], v[j][1]); w.y = pk2(v[j][2], v[j][3]); o8[64 * j] = w; }
        float z = 0.f;
#pragma unroll 1
        for (int h = 0; h < 8; ++h) { float s = 0.f;
#pragma unroll
            for (int j = 0; j < 8; ++j) { const f32x4 w = *(const LAS f32x4*)(wf + h * 2048 + 256 * j + 4 * F.lane); s += v[j][0] * w[0] + v[j][1] * w[1] + v[j][2] * w[2] + v[j][3] * w[3]; }
            s = wave_sum(s); z = (F.lane == h) ? s : z; }
        if (F.lane < 8) {
            z += I.b_forget[F.lane];
            const float lf = z >= 0.f ? -log1pf(expf(-z)) : z - log1pf(expf(z));
            ((float*)(ws + SM_LOGF))[(size_t)m * 8 + F.lane] = lf; }
    }
    __syncthreads();
    {
        LAS float* tile = (LAS float*)F.lds;
        unsigned char* const W_IN0 = ws + WS_WIN0; unsigned char* const W_OUT0 = ws + WS_WOUT0; unsigned char* const W_FF13 = ws + WS_WFF13; unsigned char* const W_FF2 = ws + WS_WFF2;
        unsigned char* const W_IN1 = ws + WS_WIN1; unsigned char* const W_Q1 = ws + WS_WQ1; unsigned char* const W_OUT1 = ws + WS_WOUT1;
        unsigned char* const W_E13 = ws + WS_WE13; unsigned char* const W_E2 = ws + WS_WE2;
        constexpr int T_IN0 = (2048 / 128) * (6144 / 128), T_SQ = (2048 / 128) * (2048 / 128), T_FF = (2048 / 128) * (FF0 / 128), T_FF2 = (FF0 / 128) * (2048 / 128), T_IN1 = (2048 / 128) * (NIN1P / 128),
                      T_QI = (512 / 128) * (1024 / 128), T_E = (2048 / 128) * (FFE / 128), T_E2 = (FFE / 128) * (2048 / 128);
        constexpr int TOT = 8 * (2 * T_E + T_E2) + 2 * T_FF + T_FF2 + T_IN0 + 2 * T_SQ + T_IN1 + T_QI;
#define TILE_DECODE(it_, Wp, ldw_, Nsrc_, Dp, ldt_, f8_, mode_, roff_, k0_, n0_) do { int r = (it_); \
            if (r < 8 * T_E) { const int e = r / T_E, rr = r % T_E, nb = FFE / 128; Wp = I.e1 + (size_t)e * 2048 * FFE; ldw_ = FFE; Nsrc_ = FFE; Dp = W_E13 + (size_t)e * 2 * FFE * 2048; ldt_ = 2048; f8_ = 1; mode_ = 1; roff_ = 0; k0_ = 128 * (rr / nb); n0_ = 128 * (rr % nb); break; } r -= 8 * T_E; \
            if (r < 8 * T_E) { const int e = r / T_E, rr = r % T_E, nb = FFE / 128; Wp = I.e3 + (size_t)e * 2048 * FFE; ldw_ = FFE; Nsrc_ = FFE; Dp = W_E13 + (size_t)e * 2 * FFE * 2048; ldt_ = 2048; f8_ = 1; mode_ = 1; roff_ = 128; k0_ = 128 * (rr / nb); n0_ = 128 * (rr % nb); break; } r -= 8 * T_E; \
            if (r < 8 * T_E2) { const int e = r / T_E2, rr = r % T_E2, nb = 2048 / 128; Wp = I.e2 + (size_t)e * FFE * 2048; ldw_ = 2048; Nsrc_ = 2048; Dp = W_E2 + (size_t)e * 2048 * FFE; ldt_ = FFE; f8_ = 1; mode_ = 0; roff_ = 0; k0_ = 128 * (rr / nb); n0_ = 128 * (rr % nb); break; } r -= 8 * T_E2; \
            if (r < T_FF) { const int nb = FF0 / 128; Wp = I.w1; ldw_ = FF0; Nsrc_ = FF0; Dp = W_FF13; ldt_ = 2048; f8_ = 1; mode_ = 1; roff_ = 0; k0_ = 128 * (r / nb); n0_ = 128 * (r % nb); break; } r -= T_FF; \
            if (r < T_FF) { const int nb = FF0 / 128; Wp = I.w3; ldw_ = FF0; Nsrc_ = FF0; Dp = W_FF13; ldt_ = 2048; f8_ = 1; mode_ = 1; roff_ = 128; k0_ = 128 * (r / nb); n0_ = 128 * (r % nb); break; } r -= T_FF; \
            if (r < T_FF2) { const int nb = 2048 / 128; Wp = I.w2; ldw_ = 2048; Nsrc_ = 2048; Dp = W_FF2; ldt_ = FF0; f8_ = 1; mode_ = 0; roff_ = 0; k0_ = 128 * (r / nb); n0_ = 128 * (r % nb); break; } r -= T_FF2; \
            if (r < T_IN0) { const int nb = 6144 / 128; Wp = I.w_in0; ldw_ = WIN0_PITCH; Nsrc_ = 6144; Dp = W_IN0; ldt_ = 2048; f8_ = 0; mode_ = 0; roff_ = 0; k0_ = 128 * (r / nb); n0_ = 128 * (r % nb); break; } r -= T_IN0; \
            if (r < T_SQ) { const int nb = 2048 / 128; Wp = I.w_out0; ldw_ = 2048; Nsrc_ = 2048; Dp = W_OUT0; ldt_ = 2048; f8_ = 1; mode_ = 0; roff_ = 0; k0_ = 128 * (r / nb); n0_ = 128 * (r % nb); break; } r -= T_SQ; \
            if (r < T_SQ) { const int nb = 2048 / 128; Wp = I.w_out1; ldw_ = 2048; Nsrc_ = 2048; Dp = W_OUT1; ldt_ = 2048; f8_ = 1; mode_ = 0; roff_ = 0; k0_ = 128 * (r / nb); n0_ = 128 * (r % nb); break; } r -= T_SQ; \
            if (r < T_IN1) { const int nb = NIN1P / 128; Wp = I.w_in1; ldw_ = NIN1; Nsrc_ = NIN1; Dp = W_IN1; ldt_ = 2048; f8_ = 0; mode_ = 0; roff_ = 0; k0_ = 128 * (r / nb); n0_ = 128 * (r % nb); break; } r -= T_IN1; \
            { const int nb = 1024 / 128; Wp = I.w_qidx; ldw_ = 1024; Nsrc_ = 1024; Dp = W_Q1; ldt_ = 512; f8_ = 0; mode_ = 0; roff_ = 8192; k0_ = 128 * (r / nb); n0_ = 128 * (r % nb); } } while (0)
        const int tid = F.tid;
        f32x4 va[2][4], vb[2][4];
        const int nb4 = tid & 31, kbb = tid >> 5;
        constexpr int T0_F8END = 8 * (2 * T_E + T_E2) + 2 * T_FF + T_FF2;
#define TILE_F8(it_) ((it_) < T0_F8END || ((it_) >= T0_F8END + T_IN0 && (it_) < T0_F8END + T_IN0 + 2 * T_SQ))
#define TILE_LOAD(v, it_) do { const float* Wp; unsigned char* Dp; int ldw_, Nsrc_, ldt_, f8_, mode_, roff_, k0_, n0_; TILE_DECODE(it_, Wp, ldw_, Nsrc_, Dp, ldt_, f8_, mode_, roff_, k0_, n0_); (void)Dp; (void)ldt_; (void)f8_; (void)mode_; (void)roff_; \
            int col = n0_ + 4 * nb4; col = col < Nsrc_ ? col : 0;        \
            _Pragma("unroll") for (int j = 0; j < 2; ++j) { const float* rp_ = Wp + (size_t)(k0_ + 4 * (kbb + 16 * j)) * ldw_ + col; \
                _Pragma("unroll") for (int r_ = 0; r_ < 4; ++r_) v[j][r_] = *(const f32x4*)(rp_ + (size_t)r_ * ldw_); } } while (0)
#define TILE_TO_LDS(v, buf_, it_) do { LAS unsigned char* ob_ = (buf_); \
            if (TILE_F8(it_)) { _Pragma("unroll") for (int j = 0; j < 2; ++j) _Pragma("unroll") for (int e = 0; e < 4; ++e) \
                    *(LAS unsigned*)(ob_ + (4 * nb4 + e) * 144 + 4 * (kbb + 16 * j)) = pg8::pk4_fp8(v[j][0][e] * 64.f, v[j][1][e] * 64.f, v[j][2][e] * 64.f, v[j][3][e] * 64.f); } \
            else { _Pragma("unroll") for (int j = 0; j < 2; ++j) _Pragma("unroll") for (int e = 0; e < 4; ++e) { u32x2 w_; w_.x = pk2(v[j][0][e], v[j][1][e]); w_.y = pk2(v[j][2][e], v[j][3][e]); \
                    *(LAS u32x2*)(ob_ + (4 * nb4 + e) * 272 + 8 * (kbb + 16 * j)) = w_; } } } while (0)
#define TILE_EMIT(buf_, it_) do { const float* Wp; unsigned char* Dp; int ldw_, Nsrc_, ldt_, f8_, mode_, roff_, k0_, n0_; TILE_DECODE(it_, Wp, ldw_, Nsrc_, Dp, ldt_, f8_, mode_, roff_, k0_, n0_); (void)Wp; (void)ldw_; (void)Nsrc_; \
            const LAS unsigned char* ib_ = (buf_); \
            if (f8_) { const int c = tid & 7;                     \
                _Pragma("unroll") for (int j = 0; j < 2; ++j) { const int n = (tid >> 3) + 64 * j, nn = n0_ + n; const int drow = mode_ ? ((nn >> 7) * 256 + roff_ + (nn & 127)) : (roff_ + nn); \
                    *(GAS u32x4*)(Dp + (size_t)drow * ldt_ + k0_ + 16 * c) = *(const LAS u32x4*)(ib_ + n * 144 + 16 * c); } } \
            else { const int c = tid & 15;                       \
                _Pragma("unroll") for (int j = 0; j < 4; ++j) { const int n = (tid >> 4) + 32 * j, nn = n0_ + n; const int drow = roff_ + nn; \
                    *(GAS u32x4*)(Dp + ((size_t)drow * ldt_ + k0_ + 8 * c) * 2) = *(const LAS u32x4*)(ib_ + n * 272 + 16 * c); } } } while (0)
        LAS unsigned char* const buf0 = F.lds; LAS unsigned char* const buf1 = F.lds + 36864;
        const int G2 = 2 * F.G;
        if (F.bid < TOT) TILE_LOAD(va, F.bid);
        if (F.bid + F.G < TOT) TILE_LOAD(vb, F.bid + F.G);
        for (int it = F.bid; it < TOT; it += G2) {
            TILE_TO_LDS(va, buf0, it);
            if (it + G2 < TOT) TILE_LOAD(va, it + G2);
            __syncthreads();
            TILE_EMIT(buf0, it);
            if (it + F.G < TOT) {
                TILE_TO_LDS(vb, buf1, it + F.G);
                if (it + F.G + G2 < TOT) TILE_LOAD(vb, it + F.G + G2);
                __syncthreads();
                TILE_EMIT(buf1, it + F.G);
            }
        }
        __syncthreads();
#undef TILE_TO_LDS
#undef TILE_EMIT
#undef TILE_F8
#undef TILE_LOAD
#undef TILE_DECODE
        bf16_t* const W_UV = (bf16_t*)(ws + WS_WUV);
        { LAS float* scr = (LAS float*)(F.lds + F.wave * 8448); constexpr int I_UV = (512 / 64) * (128 / 32);
          for (int it = gw; it < 16 * I_UV; it += NGW) { const int h = it / I_UV, rr = it % I_UV;
              transpose_item8(I.w_uv + (size_t)h * 512 * 128, 128, 128, (unsigned char*)W_UV, 1024, 0, h * 128, scr, rr, F.lane, (h & 1) * 512, ((h & 1) ^ 1) * 512); } }
    }
    {
        const float* wuq = I.w_uq; const float* wuk = I.w_uk; bf16_t* WQ = (bf16_t*)(ws + WS_WQ1);
        constexpr float C2s = 0.08838834764831845f * LOG2E;
        const int l15 = F.lane & 15, l4 = F.lane >> 4;
        for (int it = gw; it < 16 * 16 * 16; it += NGW) {
            const int h = it >> 8, rt = (it >> 4) & 15, jt = it & 15;
            f32x4 acc[2][2] = {};
            const float* ap = wuk + ((size_t)h * 512 + rt * 32 + l15) * 128 + 4 * l4;
            const float* bp = wuq + (size_t)(jt * 32 + l15) * 2048 + h * 128 + 4 * l4;
#pragma unroll 2
            for (int J = 0; J < 8; ++J) {
                const f32x4 a0 = *(const f32x4*)(ap + 16 * J), a1 = *(const f32x4*)(ap + 16 * 128 + 16 * J), b0 = *(const f32x4*)(bp + 16 * J), b1 = *(const f32x4*)(bp + (size_t)16 * 2048 + 16 * J);
#pragma unroll
                for (int e = 0; e < 4; ++e) {
                    acc[0][0] = __builtin_amdgcn_mfma_f32_16x16x4f32(a0[e], b0[e], acc[0][0], 0, 0, 0); acc[0][1] = __builtin_amdgcn_mfma_f32_16x16x4f32(a0[e], b1[e], acc[0][1], 0, 0, 0);
                    acc[1][0] = __builtin_amdgcn_mfma_f32_16x16x4f32(a1[e], b0[e], acc[1][0], 0, 0, 0); acc[1][1] = __builtin_amdgcn_mfma_f32_16x16x4f32(a1[e], b1[e], acc[1][1], 0, 0, 0); }
            }
#pragma unroll
            for (int a = 0; a < 2; ++a)
#pragma unroll
                for (int b = 0; b < 2; ++b)
#pragma unroll
                    for (int e = 0; e < 4; ++e) { const int r = rt * 32 + a * 16 + l4 * 4 + e, j = jt * 32 + b * 16 + l15;
                        WQ[(size_t)(h * 512 + r) * 512 + j] = (bf16_t)f2bf(acc[a][b][e] * C2s); }
        }
    }
}

__device__ __forceinline__ void phase_pre0(const Ctx& F) {
    unsigned char* ws = F.ws;
    LAS float* red = (LAS float*)F.lds;
    for (int job = F.bid; job < 16 + 256; job += F.G) {
        if (job < 16) {
            const int b = job >> 3, h = job & 7; const float* lf = (const float*)(ws + SM_LOGF) + (size_t)b * T * 8 + h;
            float v[16]; float s = 0.f;
#pragma unroll
            for (int i = 0; i < 16; ++i) { s += lf[(size_t)(F.tid * 16 + i) * 8]; v[i] = s; }
            float inc = s;
#pragma unroll
            for (int o = 1; o < 64; o <<= 1) { const float t = __shfl_up(inc, o); if (F.lane >= o) inc += t; }
            if (F.lane == 63) red[F.wave] = inc;
            __syncthreads();
            float base = 0.f;
            for (int w = 0; w < F.wave; ++w) base += red[w];
            base += inc - s;
            float* cl = (float*)(ws + SM_CL2) + (size_t)job * 8192 + F.tid * 16;
#pragma unroll
            for (int i = 0; i < 16; ++i) cl[i] = (base + v[i]) * LOG2E;
            __syncthreads();
        } else {
            const int jj = job - 16;
            for (int half = 0; half < 2; ++half) {
                const int bh = jj >> 4, blk = (jj & 15) * 2 + half;
                const bf16_t* kA = (const bf16_t*)(ws + B0_QKV) + ((size_t)(1 * 16 + bh) * 8192 + blk * 256) * 128;
                const bf16_t* qB = (const bf16_t*)(ws + B0_QKV) + ((size_t)(3 * 16 + bh) * 8192 + blk * 256) * 128;
                const bf16_t* kB = (const bf16_t*)(ws + B0_QKV) + ((size_t)(4 * 16 + bh) * 8192 + blk * 256) * 128;
                const int rg = F.tid >> 4, c8 = F.tid & 15;
                float cs[8] = {0, 0, 0, 0, 0, 0, 0, 0}; float qm = 0.f, km = 0.f;
                for (int i = 0; i < 8; ++i) { const int row = rg * 8 + i;
                    const u32x4 a = *(const u32x4*)(kA + (size_t)row * 128 + c8 * 8), q = *(const u32x4*)(qB + (size_t)row * 128 + c8 * 8), k = *(const u32x4*)(kB + (size_t)row * 128 + c8 * 8);
                    float sq = 0.f, sk = 0.f;
#pragma unroll
                    for (int e = 0; e < 4; ++e) { cs[2 * e] += bflo(a[e]); cs[2 * e + 1] += bfhi(a[e]);
                        sq += bflo(q[e]) * bflo(q[e]) + bfhi(q[e]) * bfhi(q[e]); sk += bflo(k[e]) * bflo(k[e]) + bfhi(k[e]) * bfhi(k[e]); }
#pragma unroll
                    for (int o = 1; o < 16; o <<= 1) { sq += __shfl_xor(sq, o); sk += __shfl_xor(sk, o); }
                    qm = fmaxf(qm, sq); km = fmaxf(km, sk); }
#pragma unroll
                for (int e = 0; e < 8; ++e) red[rg * 128 + c8 * 8 + e] = cs[e];
                qm = wave_max(qm); km = wave_max(km);
                if (F.lane == 0) { red[4096 + F.wave] = qm; red[4096 + 8 + F.wave] = km; }
                __syncthreads();
                if (F.tid < 128) { float s = 0.f; for (int g = 0; g < 32; ++g) s += red[g * 128 + F.tid]; ((float*)(ws + SM_KMEAN))[((size_t)bh * 32 + blk) * 128 + F.tid] = s * (1.0f / 256.0f); }
                if (F.tid == 128) { float a = 0.f, k = 0.f; for (int w = 0; w < 8; ++w) { a = fmaxf(a, red[4096 + w]); k = fmaxf(k, red[4096 + 8 + w]); }
                    ((float*)(ws + SM_QN))[bh * 32 + blk] = a; ((float*)(ws + SM_KN))[bh * 32 + blk] = k; }
                __syncthreads();
            }
        }
    }
}

__device__ __forceinline__ int rel_bucket_dev(int n) {
    if (n < 16) return n;
    const int l = 16 + (int)(logf((float)n / 16.0f) / 2.0794415416798357f * 16.0f);
    return l > 31 ? 31 : l;
}

#define ATT_COMMON() \
    unsigned char* ws = F.ws; char* lds = (char*)F.ldsg; \
    const bf16_t* QKV = (const bf16_t*)(ws + B0_QKV); unsigned char* O = ws + B0_O; \
    LAS float* ncl = (LAS float*)(F.lds + att::OFF_NCL); LAS float* lut = (LAS float*)(F.lds + att::OFF_LUT); LAS float* kmL = (LAS float*)(F.lds + att::OFF_KM); LAS int* misc = (LAS int*)(F.lds + att::OFF_MISC); \
    const size_t TSTR = (size_t)16 * 8192 * 128; \
    const int tid0 = F.tid;
#define ATT_LANE() int tid = tid0; asm volatile("" : "+v"(tid)); const int wid = __builtin_amdgcn_readfirstlane(tid >> 6), lane = tid & 63, r32 = lane & 31, hi = lane >> 5;
__device__ __forceinline__ void phase_attn0_moba(const Ctx& F, const float* tab) {
    ATT_COMMON()
    for (int u = F.bid; u < 256; u += F.G) {
        const int bh = u >> 4, b = bh >> 3, h = bh & 7;
        for (int i = tid0; i < 129; i += NTHREADS) lut[i] = tab[rel_bucket_dev(i) * 16 + h] * LOG2E;
        const float farL = tab[31 * 16 + h] * LOG2E;
        for (int pass = 0; pass < 2; ++pass) {
            ATT_LANE()
            const int qb = pass ? 31 - (u & 15) : (u & 15), P0 = qb * 256;
            const bf16_t* Qp = QKV + 0 * TSTR + ((size_t)bh * 8192 + P0) * 128; const bf16_t* Kh = QKV + 1 * TSTR + (size_t)bh * 8192 * 128; const bf16_t* Vh = QKV + 2 * TSTR + (size_t)bh * 8192 * 128;
            for (int i = tid; i < qb * 128; i += NTHREADS) kmL[i] = ((const float*)(ws + SM_KMEAN))[(size_t)bh * 32 * 128 + i];
            bf16x8 qr[8];
#pragma unroll
            for (int d0 = 0; d0 < 8; ++d0) qr[d0] = att::load8(Qp + (size_t)(wid * 32 + r32) * 128 + d0 * 16 + hi * 8);
            __syncthreads();
            float g1 = -__builtin_inff(), g2 = g1, g3 = g1; int i1 = -1, i2 = -1, i3 = -1;
            for (int blk = 0; blk < qb; ++blk) {
                float g = 0.f; const LAS float* km = kmL + blk * 128 + hi * 8;
#pragma unroll
                for (int d0 = 0; d0 < 8; ++d0) { const f32x4 k0 = *(const LAS f32x4*)(km + d0 * 16), k1 = *(const LAS f32x4*)(km + d0 * 16 + 4); const u32x4 q = *reinterpret_cast<const u32x4*>(&qr[d0]);
                    g += bflo(q[0]) * k0[0] + bfhi(q[0]) * k0[1] + bflo(q[1]) * k0[2] + bfhi(q[1]) * k0[3] + bflo(q[2]) * k1[0] + bfhi(q[2]) * k1[1] + bflo(q[3]) * k1[2] + bfhi(q[3]) * k1[3]; }
                g += __shfl_xor(g, 32);
                if (g > g1) { g3 = g2; i3 = i2; g2 = g1; i2 = i1; g1 = g; i1 = blk; }
                else if (g > g2) { g3 = g2; i3 = i2; g2 = g; i2 = blk; }
                else if (g > g3) { g3 = g; i3 = blk; }
            }
            unsigned selmask = 1u << qb;
            if (i1 >= 0) selmask |= 1u << i1; if (i2 >= 0) selmask |= 1u << i2; if (i3 >= 0) selmask |= 1u << i3;
            att::attn_block<1, 2048>(Qp, Kh, Vh, O + ((size_t)b * 8192 + P0) * 2048 + h * 128, P0, 0, (P0 + 255) / 64 + 1, lds, ncl, 0, lut, selmask, farL, qr, tid);
        }
    }
}
__device__ __forceinline__ void phase_attn0_fox(const Ctx& F) {
    ATT_COMMON()
    for (int u = F.bid; u < 512; u += F.G) {
        ATT_LANE()
        const int bh = u >> 5, b = bh >> 3, h = bh & 7, qb = 31 - (u & 31), P0 = qb * 256;
        const float* cl2 = (const float*)(ws + SM_CL2) + (size_t)bh * 8192;
        const bf16_t* Qp = QKV + 3 * TSTR + ((size_t)bh * 8192 + P0) * 128; const bf16_t* Kh = QKV + 4 * TSTR + (size_t)bh * 8192 * 128; const bf16_t* Vh = QKV + 5 * TSTR + (size_t)bh * 8192 * 128;
        const float ref = cl2[P0];
        if (wid == 0) {
            float kmax = 0.f; for (int i = lane; i <= qb; i += 64) kmax = fmaxf(kmax, ((const float*)(ws + SM_KN))[bh * 32 + i]);
            kmax = wave_max(kmax);
            const float qmax = ((const float*)(ws + SM_QN))[bh * 32 + qb];
            const float B2 = (105.0f + 2.0f * sqrtf(qmax * kmax) * att::SCALE * 1.0001f) * LOG2E;
            const int ntile = P0 / 64; int first = ntile;
            for (int base = 0; base < ntile; base += 64) { const int J = base + lane; const bool need = (J < ntile) && (cl2[64 * J + 63] - ref <= B2);
                const unsigned long long bal = __ballot(need); if (bal) { first = base + __builtin_ctzll(bal); break; } }
            if (lane == 0) misc[0] = first;
        }
        bf16x8 qr[8];
#pragma unroll
        for (int d0 = 0; d0 < 8; ++d0) qr[d0] = att::load8(Qp + (size_t)(wid * 32 + r32) * 128 + d0 * 16 + hi * 8);
        __syncthreads();
        const int j_lo = __builtin_amdgcn_readfirstlane(misc[0]), nclbase = j_lo * 64;
        for (int k = nclbase + tid; k < P0 + 256; k += NTHREADS) ncl[k - nclbase] = ref - cl2[k];
        att::attn_block<0, 2048>(Qp, Kh, Vh, O + ((size_t)b * 8192 + P0) * 2048 + 1024 + h * 128, P0, j_lo, (P0 + 255) / 64 + 1, lds, ncl, nclbase, lut, 0u, 0.f, qr, tid);
    }
}

__device__ __forceinline__ void ln_row(const f32x4 (&v)[8], const float* g, const float* bta, int lane, f32x4 (&y)[8], float* stat = nullptr) {
    float s = 0.f;
#pragma unroll
    for (int j = 0; j < 8; ++j) s += (v[j][0] + v[j][1]) + (v[j][2] + v[j][3]);
    const float mean = wave_sum(s) * (1.f / DM); float s2 = 0.f;
#pragma unroll
    for (int j = 0; j < 8; ++j) { const f32x4 d = v[j] - mean; s2 += (d[0] * d[0] + d[1] * d[1]) + (d[2] * d[2] + d[3] * d[3]); }
    const float rstd = 1.0f / sqrtf(wave_sum(s2) * (1.f / DM) + LN_EPS);
    if (stat != nullptr && lane == 0) { stat[0] = mean; stat[1] = rstd; }
#pragma unroll
    for (int j = 0; j < 8; ++j) { const f32x4 gg = *(const f32x4*)(g + 256 * j + 4 * lane), bb = *(const f32x4*)(bta + 256 * j + 4 * lane); y[j] = (v[j] - mean) * rstd * gg + bb; }
}
template <bool OUT8>
__device__ __forceinline__ void phase_ln(const Ctx& F, const float* g, const float* bta) {
    const int gw = F.bid * NWAVES + F.wave, NGW = F.G * NWAVES;
    for (int m = gw; m < M; m += NGW) {
        GAS f32x4* xr = (GAS f32x4*)(F.out + (size_t)m * DM) + F.lane;
        f32x4 v[8], y[8];
#pragma unroll
        for (int j = 0; j < 8; ++j) v[j] = xr[64 * j];
        ln_row(v, g, bta, F.lane, y, (float*)(F.ws + SM_STAT) + 2 * (size_t)m);
        if constexpr (OUT8) { GAS unsigned* o8 = (GAS unsigned*)(F.ws + WS_XB + (size_t)m * DM) + F.lane;
#pragma unroll
            for (int j = 0; j < 8; ++j) o8[64 * j] = pg8::pk4_fp8(y[j][0], y[j][1], y[j][2], y[j][3]); }
        else { GAS u32x2* o8 = (GAS u32x2*)((bf16_t*)(F.ws + WS_XB) + (size_t)m * DM) + F.lane;
#pragma unroll
            for (int j = 0; j < 8; ++j) { u32x2 w; w.x = pk2(y[j][0], y[j][1]); w.y = pk2(y[j][2], y[j][3]); o8[64 * j] = w; } }
    }
}
__device__ __forceinline__ void phase_ln_router(const Ctx& F, const float* g, const float* bta, const float* router) {
    const int gw = F.bid * NWAVES + F.wave, NGW = F.G * NWAVES;
    LAS float* wr = (LAS float*)F.lds;
    LAS unsigned* lcnt = (LAS unsigned*)(F.lds + 65536);
    LAS unsigned* rec = (LAS unsigned*)(F.lds + 65536 + 64) + F.wave * 64;
    for (int i = F.tid; i < 8 * 2048; i += NTHREADS) { const int j = i & 7, k = i >> 3; wr[j * 2048 + k] = router[(size_t)k * 8 + j]; }
    if (F.tid < 16) lcnt[F.tid] = 0u;
    __syncthreads();
    unsigned* cnt = (unsigned*)(F.ws + WS_CTL) + CW_CNT;
    const int nrow = (M - gw + NGW - 1) / NGW;
    const bool local = nrow <= 64;
    f32x4 v[8], vn[8];
    if (gw < M) { const GAS f32x4* xr = (const GAS f32x4*)(F.out + (size_t)gw * DM) + F.lane;
#pragma unroll
        for (int j = 0; j < 8; ++j) v[j] = xr[64 * j]; }
    int ri = 0;
    for (int m = gw; m < M; m += NGW, ++ri) {
        const int mn = m + NGW;
        if (mn < M) { const GAS f32x4* xn = (const GAS f32x4*)(F.out + (size_t)mn * DM) + F.lane;
#pragma unroll
            for (int j = 0; j < 8; ++j) vn[j] = xn[64 * j]; }
        f32x4 y[8];
        ln_row(v, g, bta, F.lane, y, (float*)(F.ws + SM_STAT) + 2 * (size_t)m);
        GAS unsigned* o8 = (GAS unsigned*)(F.ws + WS_XB + (size_t)m * DM) + F.lane;
#pragma unroll
        for (int j = 0; j < 8; ++j) o8[64 * j] = pg8::pk4_fp8(y[j][0], y[j][1], y[j][2], y[j][3]);
        float mylg = 0.f;
#pragma unroll 1
        for (int e = 0; e < 8; ++e) { float s = 0.f;
#pragma unroll
            for (int j = 0; j < 8; ++j) { const f32x4 w = *(const LAS f32x4*)(wr + e * 2048 + 256 * j + 4 * F.lane); s += y[j][0] * w[0] + y[j][1] * w[1] + y[j][2] * w[2] + y[j][3] * w[3]; }
            s = wave_sum(s); mylg = (F.lane == e) ? s : mylg; }
        float lg[8];
#pragma unroll
        for (int e = 0; e < 8; ++e) lg[e] = __builtin_bit_cast(float, __builtin_amdgcn_readlane(__builtin_bit_cast(int, mylg), e));
        if (F.lane == 0) {
            int e0 = 0; float l0 = lg[0];
#pragma unroll
            for (int e = 1; e < 8; ++e) if (lg[e] > l0) { l0 = lg[e]; e0 = e; }
            int e1 = -1; float l1 = -__builtin_inff();
#pragma unroll
            for (int e = 0; e < 8; ++e) if (e != e0 && lg[e] > l1) { l1 = lg[e]; e1 = e; }
            const float ex = expf(l1 - l0), g0 = 1.0f / (1.0f + ex), g1 = ex / (1.0f + ex);
            int* rte = (int*)(F.ws + SM_RTE) + (size_t)m * 2; float* rtg = (float*)(F.ws + SM_RTG) + (size_t)m * 2;
            rte[0] = e0; rte[1] = e1; rtg[0] = g0; rtg[1] = g1;
            if (local) {
                const unsigned r0 = __hip_atomic_fetch_add(lcnt + e0, 1u, __ATOMIC_RELAXED, __HIP_MEMORY_SCOPE_WORKGROUP), r1 = __hip_atomic_fetch_add(lcnt + e1, 1u, __ATOMIC_RELAXED, __HIP_MEMORY_SCOPE_WORKGROUP);
                rec[ri] = (unsigned)e0 | ((unsigned)e1 << 4) | (r0 << 8) | (r1 << 20);
            } else {
                const unsigned p0 = __hip_atomic_fetch_add(cnt + 64 * e0, 1u, RLX_AGENT), p1 = __hip_atomic_fetch_add(cnt + 64 * e1, 1u, RLX_AGENT);
                int* rtp = (int*)(F.ws + SM_RTP) + (size_t)m * 2; rtp[0] = (int)p0; rtp[1] = (int)p1;
            }
        }
#pragma unroll
        for (int j = 0; j < 8; ++j) v[j] = vn[j];
    }
    __syncthreads();
    if (F.tid < 8) lcnt[8 + F.tid] = __hip_atomic_fetch_add(cnt + 64 * F.tid, lcnt[F.tid], RLX_AGENT);
    __syncthreads();
    if (local && F.lane < nrow) { const int m = gw + F.lane * NGW; const unsigned r = rec[F.lane];
        int* rtp = (int*)(F.ws + SM_RTP) + (size_t)m * 2;
        rtp[0] = (int)(lcnt[8 + (r & 15u)] + ((r >> 8) & 0xFFFu)); rtp[1] = (int)(lcnt[8 + ((r >> 4) & 15u)] + (r >> 20)); }
}
__device__ __forceinline__ void moe_tstart(const Ctx& F, int (&ts)[9]) {
    const unsigned* cnt = (const unsigned*)(F.ws + WS_CTL) + CW_CNT; int a = 0;
#pragma unroll
    for (int e = 0; e < 8; ++e) { ts[e] = a; a += ((int)__hip_atomic_load(cnt + 64 * e, RLX_AGENT) + 255) >> 8; }
    ts[8] = a;
}
__device__ __forceinline__ void phase_gather(const Ctx& F) {
    int ts[9]; moe_tstart(F, ts);
    const int gw = F.bid * NWAVES + F.wave, NGW = F.G * NWAVES;
    const int* rte = (const int*)(F.ws + SM_RTE); const int* rtp = (const int*)(F.ws + SM_RTP); int* rrow = (int*)(F.ws + SM_ROW);
    for (int a = gw; a < 2 * M; a += NGW) {
        const int m = a >> 1, e = rte[a], p = rtp[a]; int st = 0;
#pragma unroll
        for (int j = 0; j < 8; ++j) st = (e == j) ? ts[j] : st;
        const int row = st * 256 + p;
        const GAS u32x4* src = (const GAS u32x4*)(F.ws + WS_XB + (size_t)m * DM) + F.lane;
        GAS u32x4* dst = (GAS u32x4*)(F.ws + B1_XG + (size_t)row * DM) + F.lane;
#pragma unroll
        for (int j = 0; j < 2; ++j) dst[64 * j] = src[64 * j];
        if (F.lane == 0) rrow[a] = row;
    }
}
__device__ __forceinline__ void phase_final(const Ctx& F, const float* g, const float* bta, const int S, const float* gp, const float* bp) {
    const int gw = F.bid * NWAVES + F.wave, NGW = F.G * NWAVES;
    const int* rrow = (const int*)(F.ws + SM_ROW); const float* rtg = (const float*)(F.ws + SM_RTG); const bf16_t* Y = (const bf16_t*)(F.ws + B1_Y);
    const unsigned* flags = (const unsigned*)(F.ws + WS_CTL) + CW_FLAG; const float* slabs = (const float*)(F.ws + B1_SLAB);
    for (int m = gw; m < M; m += NGW) {
        GAS f32x4* xr = (GAS f32x4*)(F.out + (size_t)m * DM) + F.lane;
        const int r0 = rrow[2 * m], r1 = rrow[2 * m + 1]; const float g0 = rtg[2 * m], g1 = rtg[2 * m + 1];
        const float pmean = ((const float*)(F.ws + SM_STAT))[2 * (size_t)m], prstd = ((const float*)(F.ws + SM_STAT))[2 * (size_t)m + 1];
        int lz = F.lane; asm volatile("" : "+v"(lz));
        const float* gpl = gp + 4 * lz; const float* bpl = bp + 4 * lz;
        const GAS u32x2* y0 = (const GAS u32x2*)(Y + (size_t)r0 * DM) + F.lane; const GAS u32x2* y1 = (const GAS u32x2*)(Y + (size_t)r1 * DM) + F.lane;
        f32x4 v[8], y[8];
        const unsigned* fl0 = flags + (r0 >> 8) * 8; const unsigned* fl1 = flags + (r1 >> 8) * 8;
#pragma unroll
        for (int j = 0; j < 8; ++j) { const f32x4 x = (xr[64 * j] - pmean) * prstd * *(const f32x4*)(gpl + 256 * j) + *(const f32x4*)(bpl + 256 * j); f32x4 fa, fc;
            const unsigned f0 = fl0[j], f1 = fl1[j];
            if (f0 == 0u) { const u32x2 a = y0[64 * j]; fa = (f32x4){bflo(a.x), bfhi(a.x), bflo(a.y), bfhi(a.y)}; }
            else { const float* sp = slabs + (size_t)(f0 - 1u) * 65536 + (size_t)(r0 & 255) * 256 + 4 * F.lane; fa = *(const f32x4*)sp; for (int s = 1; s < S; ++s) fa = fa + *(const f32x4*)(sp + (size_t)s * 65536); fa = (f32x4){bf2f((unsigned short)f2bf(fa[0])), bf2f((unsigned short)f2bf(fa[1])), bf2f((unsigned short)f2bf(fa[2])), bf2f((unsigned short)f2bf(fa[3]))}; }
            if (f1 == 0u) { const u32x2 c = y1[64 * j]; fc = (f32x4){bflo(c.x), bfhi(c.x), bflo(c.y), bfhi(c.y)}; }
            else { const float* sp = slabs + (size_t)(f1 - 1u) * 65536 + (size_t)(r1 & 255) * 256 + 4 * F.lane; fc = *(const f32x4*)sp; for (int s = 1; s < S; ++s) fc = fc + *(const f32x4*)(sp + (size_t)s * 65536); fc = (f32x4){bf2f((unsigned short)f2bf(fc[0])), bf2f((unsigned short)f2bf(fc[1])), bf2f((unsigned short)f2bf(fc[2])), bf2f((unsigned short)f2bf(fc[3]))}; }
            v[j] = x * ALPHA + (fa * g0 + fc * g1); }
        ln_row(v, g, bta, F.lane, y);
#pragma unroll
        for (int j = 0; j < 8; ++j) xr[64 * j] = y[j];
    }
}
__device__ __forceinline__ void phase_norm1(const Ctx& F, const float* gq, const float* gk) {
    const int gw = F.bid * NWAVES + F.wave, NGW = F.G * NWAVES;
    const float* proj = (const float*)(F.ws + B1_PROJ);
    for (int m = gw; m < M; m += NGW) {
        const float* pr = proj + (size_t)m * NIN1P;
        const f32x4 q0 = *(const f32x4*)(pr + 8 * F.lane), q1 = *(const f32x4*)(pr + 8 * F.lane + 4), k0 = *(const f32x4*)(pr + 512 + 8 * F.lane), k1 = *(const f32x4*)(pr + 512 + 8 * F.lane + 4);
        float sq = q0[0] * q0[0] + q0[1] * q0[1] + q0[2] * q0[2] + q0[3] * q0[3] + q1[0] * q1[0] + q1[1] * q1[1] + q1[2] * q1[2] + q1[3] * q1[3];
        float sk = k0[0] * k0[0] + k0[1] * k0[1] + k0[2] * k0[2] + k0[3] * k0[3] + k1[0] * k1[0] + k1[1] * k1[1] + k1[2] * k1[2] + k1[3] * k1[3];
        sq = wave_sum(sq); sk = wave_sum(sk);
        const float rq = 1.0f / sqrtf(sq * (1.f / 512.f) + RMS_EPS), rk = 1.0f / sqrtf(sk * (1.f / 512.f) + RMS_EPS);
        const f32x4 gq0 = *(const f32x4*)(gq + 8 * F.lane), gq1 = *(const f32x4*)(gq + 8 * F.lane + 4), gk0 = *(const f32x4*)(gk + 8 * F.lane), gk1 = *(const f32x4*)(gk + 8 * F.lane + 4);
        const f32x4 a0 = q0 * rq * gq0, a1 = q1 * rq * gq1, c0 = k0 * rk * gk0, c1 = k1 * rk * gk1;
        u32x4 w; w.x = pk2(a0[0], a0[1]); w.y = pk2(a0[2], a0[3]); w.z = pk2(a1[0], a1[1]); w.w = pk2(a1[2], a1[3]);
        *((GAS u32x4*)((bf16_t*)(F.ws + B1_CQN) + (size_t)m * 512) + F.lane) = w;
        w.x = pk2(c0[0], c0[1]); w.y = pk2(c0[2], c0[3]); w.z = pk2(c1[0], c1[1]); w.w = pk2(c1[2], c1[3]);
        *((GAS u32x4*)((bf16_t*)(F.ws + B1_CKVN) + (size_t)m * 512) + F.lane) = w;
        if (F.lane < 32) { const float a = pr[1024 + 2 * F.lane], c = pr[1024 + 2 * F.lane + 1]; ((unsigned*)((bf16_t*)(F.ws + SM_KIDX) + (size_t)m * 64))[F.lane] = pk2(a, c); }
        else if (F.lane < 48) ((float*)(F.ws + SM_WIDX))[(size_t)m * 16 + (F.lane - 32)] = pr[1088 + (F.lane - 32)];
    }
}
__device__ __forceinline__ size_t sc_row_off(int b, int t) { const int qc = t >> 7; return (size_t)b * SC_PER_BATCH + (size_t)16384 * (qc * (qc + 1) / 2) + (size_t)(t & 127) * (128 * (qc + 1)); }

__device__ __forceinline__ float relu_f(float x) { const int b = __builtin_bit_cast(int, x); return __builtin_bit_cast(float, b > 0 ? b : 0); }
__device__ __forceinline__ void phase_index(const Ctx& F, float* SC) {
    const bf16_t* QI = (const bf16_t*)(F.ws + B1_QIDX); const bf16_t* KI = (const bf16_t*)(F.ws + SM_KIDX); const float* WI = (const float*)(F.ws + SM_WIDX);
    const int tid = F.tid, lane = F.lane, l15 = lane & 15, q4 = lane >> 4, wid = F.wave;
    LAS unsigned char* ktile = F.lds + 65536;
    const int skey = tid >> 3, sch = tid & 7; const unsigned st_off = (unsigned)(skey * 128 + ((sch ^ (skey & 7)) << 4));
    unsigned rd_off[4][2];
#pragma unroll
    for (int sg = 0; sg < 4; ++sg)
#pragma unroll
        for (int s = 0; s < 2; ++s) { const int k = sg * 16 + l15, c = s * 4 + q4; rd_off[sg][s] = (unsigned)(k * 128 + ((c ^ (k & 7)) << 4)); }
    unsigned* qhead = (unsigned*)(F.ws + WS_CTL) + CW_QIDX; LAS int* qslot = (LAS int*)(F.lds + 65536 + 16384);
    if (tid == 0) qslot[0] = (int)__hip_atomic_fetch_add(qhead, 1u, RLX_AGENT);
    __syncthreads();
    for (;;) {
        const int u = __builtin_amdgcn_readfirstlane(qslot[0]);
        if (u >= 576) break;
        int unext = 0; if (tid == 0) unext = (int)__hip_atomic_fetch_add(qhead, 1u, RLX_AGENT);
        const int v = 575 - u;
        const int b = v / 288, w = v % 288; int g = 0;
#pragma unroll
        for (int j = 1; j < 8; ++j) g += (w >= 4 * j * (j + 1)) ? 1 : 0;
        const int rem = w - 4 * g * (g + 1), qc = 8 * g + rem / (g + 1), ks = rem % (g + 1);
        const int k_lo = ks * 1024; int k_hi = k_lo + 1024; if (k_hi > 128 * (qc + 1)) k_hi = 128 * (qc + 1);
        const int pitch = 128 * (qc + 1), ntile = (k_hi - k_lo) >> 6;
        const bf16_t* kg = KI + ((size_t)b * T + k_lo + skey) * 64 + sch * 8;
#pragma unroll 1
        for (int pass = 0; pass < 4; ++pass) {
            const int t0 = qc * 128 + wid * 16 + pass * 4;
            bf16x8 af[4][2]; f32x4 wq[4];
#pragma unroll
            for (int i = 0; i < 4; ++i) { const size_t m = (size_t)b * T + t0 + i;
                af[i][0] = *(const bf16x8*)(QI + m * 1024 + l15 * 64 + q4 * 8); af[i][1] = *(const bf16x8*)(QI + m * 1024 + l15 * 64 + 32 + q4 * 8);
                wq[i] = *(const f32x4*)(WI + m * 16 + 4 * q4); }
            LAS float* stg = (LAS float*)(F.lds + wid * 8192) + lane; float* scp = SC + sc_row_off(b, t0) + k_lo;
            u32x4 kreg = *(const u32x4*)kg;
            *(LAS u32x4*)(ktile + st_off) = kreg;
            if (ntile > 1) kreg = *(const u32x4*)(kg + (size_t)64 * 64);
            __syncthreads();
#pragma unroll 1
            for (int ti = 0; ti < ntile; ++ti) {
                const LAS unsigned char* kt = ktile + (ti & 1) * 8192;
                bf16x8 bfr[4][2];
#pragma unroll
                for (int sg = 0; sg < 4; ++sg) { bfr[sg][0] = *(const LAS bf16x8*)(kt + rd_off[sg][0]); bfr[sg][1] = *(const LAS bf16x8*)(kt + rd_off[sg][1]); }
                if (ti + 1 < ntile) *(LAS u32x4*)(ktile + ((ti + 1) & 1) * 8192 + st_off) = kreg;
                if (ti + 2 < ntile) kreg = *(const u32x4*)(kg + (size_t)(ti + 2) * 64 * 64);
                f32x4 acc[4][4];
#pragma unroll
                for (int i = 0; i < 4; ++i)
#pragma unroll
                    for (int sg = 0; sg < 4; ++sg) acc[i][sg] = __builtin_amdgcn_mfma_f32_16x16x32_bf16(af[i][0], bfr[sg][0], (f32x4){0.f, 0.f, 0.f, 0.f}, 0, 0, 0);
#pragma unroll
                for (int i = 0; i < 4; ++i)
#pragma unroll
                    for (int sg = 0; sg < 4; ++sg) acc[i][sg] = __builtin_amdgcn_mfma_f32_16x16x32_bf16(af[i][1], bfr[sg][1], acc[i][sg], 0, 0, 0);
#pragma unroll
                for (int i = 0; i < 4; ++i) {
                    float part[4];
#pragma unroll
                    for (int sg = 0; sg < 4; ++sg) part[sg] = relu_f(acc[i][sg][0]) * wq[i][0] + relu_f(acc[i][sg][1]) * wq[i][1] + relu_f(acc[i][sg][2]) * wq[i][2] + relu_f(acc[i][sg][3]) * wq[i][3];
                    auto s0 = __builtin_amdgcn_permlane32_swap(__float_as_uint(part[0]), __float_as_uint(part[2]), false, false);
                    auto s1 = __builtin_amdgcn_permlane32_swap(__float_as_uint(part[1]), __float_as_uint(part[3]), false, false);
                    const float k0 = __uint_as_float(s0[0]) + __uint_as_float(s0[1]), k1 = __uint_as_float(s1[0]) + __uint_as_float(s1[1]);
                    auto s2 = __builtin_amdgcn_permlane16_swap(__float_as_uint(k0), __float_as_uint(k1), false, false);
                    stg[i * 512 + (ti & 7) * 64] = __uint_as_float(s2[0]) + __uint_as_float(s2[1]);
                }
                if ((ti & 7) == 7 || ti + 1 == ntile) {
                    LDS_WAIT(); asm volatile("" ::: "memory");
                    const int c0 = (ti & ~7) * 64, nc = (ti + 1) * 64 - c0;
#pragma unroll
                    for (int i = 0; i < 4; ++i) for (int k = 4 * lane; k < nc; k += 256) *(f32x4*)(scp + (size_t)i * pitch + c0 + k) = *(const LAS f32x4*)((LAS float*)(F.lds + wid * 8192) + i * 512 + k);
                    LDS_WAIT(); asm volatile("" ::: "memory"); }
                __syncthreads();
            }
        }
        if (tid == 0) qslot[0] = unext;
        __syncthreads();
    }
}

__device__ __forceinline__ int cnt_ge8(unsigned a0, unsigned a1, unsigned a2, unsigned a3, unsigned a4, unsigned a5, unsigned a6, unsigned a7, unsigned b) {
    unsigned long long m0, m1, m2, m3, m4, m5, m6, m7;
    asm("v_cmp_ge_u32_e64 %0, %8, %16\n\tv_cmp_ge_u32_e64 %1, %9, %16\n\tv_cmp_ge_u32_e64 %2, %10, %16\n\tv_cmp_ge_u32_e64 %3, %11, %16\n\t"
        "v_cmp_ge_u32_e64 %4, %12, %16\n\tv_cmp_ge_u32_e64 %5, %13, %16\n\tv_cmp_ge_u32_e64 %6, %14, %16\n\tv_cmp_ge_u32_e64 %7, %15, %16"
        : "=&s"(m0), "=&s"(m1), "=&s"(m2), "=&s"(m3), "=&s"(m4), "=&s"(m5), "=&s"(m6), "=&s"(m7)
        : "v"(a0), "v"(a1), "v"(a2), "v"(a3), "v"(a4), "v"(a5), "v"(a6), "v"(a7), "v"(b));
    return (__builtin_popcountll(m0) + __builtin_popcountll(m1)) + (__builtin_popcountll(m2) + __builtin_popcountll(m3)) + (__builtin_popcountll(m4) + __builtin_popcountll(m5)) + (__builtin_popcountll(m6) + __builtin_popcountll(m7));
}
__device__ __forceinline__ void phase_topk(const Ctx& F, const int reps) {
    const float* SC = (const float*)(F.ws + B1_SC); int* SEL = (int*)(F.ws + SM_SEL);
    const int lane = F.lane;
    LAS int* lst = (LAS int*)(F.lds + F.wave * 1024);
    unsigned* qhead = (unsigned*)(F.ws + WS_CTL) + CW_QTOPK;
    unsigned nxt = 0u; if (lane == 0) nxt = __hip_atomic_fetch_add(qhead, 1u, RLX_AGENT);
#pragma unroll 1
    for (;;) {
        const unsigned qi = (unsigned)__builtin_amdgcn_readfirstlane((int)nxt);
        if (qi >= (unsigned)(M * reps)) break;
        if (lane == 0) nxt = __hip_atomic_fetch_add(qhead, 1u, RLX_AGENT);
        const int qq = (int)(qi % (unsigned)M), b = qq & 1, t = 8191 - (qq >> 1), m = b * T + t; int* out = SEL + (size_t)m * 256;
        if (t < 256) {
#pragma unroll
            for (int j = 0; j < 4; ++j) { const int i = lane + 64 * j; out[i] = (i <= t) ? i : -1; }
            continue;
        }
        const float* row = SC + sc_row_off(b, t);
        const int nreg = (t >> 6) + 1;
        unsigned u[128];
#pragma unroll
        for (int gi = 0; gi < 8; ++gi) {
            if (gi * 16 < nreg) {
#pragma unroll
                for (int i = gi * 16; i < gi * 16 + 16; ++i) u[i] = __float_as_uint(row[lane + 64 * i]);
            } else {
#pragma unroll
                for (int i = gi * 16; i < gi * 16 + 16; ++i) u[i] = 0u;
            }
        }
#pragma unroll
        for (int gi = 0; gi < 8; ++gi) if (gi * 16 < nreg) {
#pragma unroll
            for (int i = gi * 16; i < gi * 16 + 16; ++i) { const int idx = lane + 64 * i; const unsigned bits = u[i]; const unsigned key = (bits & 0x80000000u) ? ~bits : (bits | 0x80000000u); u[i] = (idx <= t) ? key : 0u; }
        }
        bool done = false;
        if (nreg > 16) {
            unsigned Tl = 0u;
            for (int bit = 31; bit >= 0; --bit) { const unsigned cand = Tl | (1u << bit); int c = 0;
#pragma unroll
                for (int gi = 0; gi < 8; ++gi) if (gi * 16 < nreg) c += __builtin_popcountll(__ballot(u[gi * 16] >= cand)) + __builtin_popcountll(__ballot(u[gi * 16 + 8] >= cand));
                if (c >= 48) Tl = cand; }
            int call = 0;
#pragma unroll
            for (int gi = 0; gi < 8; ++gi) if (gi * 16 < nreg) {
#pragma unroll
                for (int i = gi * 16; i < gi * 16 + 16; i += 8) call += cnt_ge8(u[i], u[i + 1], u[i + 2], u[i + 3], u[i + 4], u[i + 5], u[i + 6], u[i + 7], Tl); }
            if (call >= 256 && call <= 1024) {
                LAS unsigned* keyL = (LAS unsigned*)(F.lds + 8192 + F.wave * 8192); LAS unsigned* idxL = keyL + 1024;
                int cb = 0;
#pragma unroll
                for (int gi = 0; gi < 8; ++gi) if (gi * 16 < nreg) {
#pragma unroll
                    for (int i = gi * 16; i < gi * 16 + 16; ++i) { const bool s = u[i] >= Tl; const unsigned long long sb = __ballot(s);
                        if (s) { const int p = cb + (int)__builtin_amdgcn_mbcnt_hi((unsigned)(sb >> 32), __builtin_amdgcn_mbcnt_lo((unsigned)sb, 0u)); keyL[p] = u[i]; idxL[p] = (unsigned)(lane + 64 * i); }
                        cb += __builtin_popcountll(sb); } }
                LDS_WAIT(); asm volatile("" ::: "memory");
                const int nc = (call + 63) >> 6;
                unsigned ck[16], ci[16];
#pragma unroll
                for (int j = 0; j < 16; ++j) { const int p = lane + 64 * j; const bool ok = (j < nc) && (p < call); ck[j] = ok ? keyL[p] : 0u; ci[j] = ok ? idxL[p] : 0u; }
                unsigned Tk = 0u; bool exact = false;
                for (int bit = 31; bit >= 0; --bit) { const unsigned cand = Tk | (1u << bit); int c = 0;
#pragma unroll
                    for (int j = 0; j < 16; ++j) if (j < nc) c += __builtin_popcountll(__ballot(ck[j] >= cand));
                    if (c >= 256) { Tk = cand; if (c == 256) { exact = true; break; } } }
                int need = 0;
                if (!exact) { int c = 0;
#pragma unroll
                    for (int j = 0; j < 16; ++j) if (j < nc) c += __builtin_popcountll(__ballot(ck[j] > Tk));
                    need = 256 - c; }
                int base = 0, eq_taken = 0;
#pragma unroll
                for (int j = 0; j < 16; ++j) if (j < nc) {
                    const bool eq = ck[j] == Tk; const unsigned long long eb = __ballot(eq && !exact);
                    const int rank = eq_taken + __builtin_popcountll(eb & ((1ull << lane) - 1ull)); eq_taken += __builtin_popcountll(eb);
                    const bool s = exact ? (ck[j] >= Tk) : ((ck[j] > Tk) || (eq && rank < need));
                    const unsigned long long sb = __ballot(s);
                    if (s) { const int pos = base + __builtin_popcountll(sb & ((1ull << lane) - 1ull)); if (pos < 256) lst[pos] = (int)ci[j]; }
                    base += __builtin_popcountll(sb); }
                done = true;
            }
        }
        if (!done) {
            unsigned Tk = 0u; bool exact = false;
            for (int bit = 31; bit >= 0; --bit) {
                const unsigned cand = Tk | (1u << bit); int c = 0;
    #pragma unroll
                for (int gi = 0; gi < 8; ++gi) if (gi * 16 < nreg) {
    #pragma unroll
                    for (int i = gi * 16; i < gi * 16 + 16; i += 8) c += cnt_ge8(u[i], u[i + 1], u[i + 2], u[i + 3], u[i + 4], u[i + 5], u[i + 6], u[i + 7], cand); }
                if (c >= 256) { Tk = cand; if (c == 256) { exact = true; break; } }
            }
            int need = 0;
            if (!exact) { int c = 0;
    #pragma unroll
                for (int gi = 0; gi < 8; ++gi) if (gi * 16 < nreg) {
    #pragma unroll
                    for (int i = gi * 16; i < gi * 16 + 16; ++i) c += __builtin_popcountll(__ballot(u[i] > Tk)); }
                need = 256 - c; }
            int base = 0;
            if (exact) {
    #pragma unroll
                for (int gi = 0; gi < 8; ++gi) if (gi * 16 < nreg) {
    #pragma unroll
                    for (int i = gi * 16; i < gi * 16 + 16; ++i) {
                        const bool s = u[i] >= Tk; const unsigned long long sb = __ballot(s);
                        if (s) lst[base + (int)__builtin_amdgcn_mbcnt_hi((unsigned)(sb >> 32), __builtin_amdgcn_mbcnt_lo((unsigned)sb, 0u))] = lane + 64 * i;
                        base += __builtin_popcountll(sb);
                    } }
            } else {
                int eq_taken = 0;
    #pragma unroll
                for (int gi = 0; gi < 8; ++gi) if (gi * 16 < nreg) {
    #pragma unroll
                    for (int i = gi * 16; i < gi * 16 + 16; ++i) {
                        const bool eq = u[i] == Tk; const unsigned long long eb = __ballot(eq);
                        const int rank = eq_taken + __builtin_popcountll(eb & ((1ull << lane) - 1ull)); eq_taken += __builtin_popcountll(eb);
                        const bool s = (u[i] > Tk) || (eq && rank < need);
                        const unsigned long long sb = __ballot(s);
                        if (s) { const int pos = base + __builtin_popcountll(sb & ((1ull << lane) - 1ull)); if (pos < 256) lst[pos] = lane + 64 * i; }
                        base += __builtin_popcountll(sb);
                    } }
            }
        }
        LDS_WAIT(); asm volatile("" ::: "memory");
        *(GAS u32x4*)(out + 4 * lane) = *(const LAS u32x4*)(lst + 4 * lane);
        LDS_WAIT(); asm volatile("" ::: "memory");
    }
}

__device__ __forceinline__ void quad_barrier(volatile LAS unsigned* cnt, unsigned& epoch, int lane) {
    asm volatile("s_waitcnt lgkmcnt(0)" ::: "memory");
    epoch += 4u;
    if (lane == 0) __hip_atomic_fetch_add((LAS unsigned*)cnt, 1u, __ATOMIC_RELAXED, __HIP_MEMORY_SCOPE_WORKGROUP);
    for (unsigned sp = 0; __builtin_amdgcn_readfirstlane(*cnt) < epoch && sp < (1u << 24); ++sp) __builtin_amdgcn_s_sleep(1);
    asm volatile("" ::: "memory");
}
__device__ __forceinline__ void quad_signal(volatile LAS unsigned* cnt4, int qt, unsigned value, int lane) {
    asm volatile("s_waitcnt lgkmcnt(0)" ::: "memory");
    if (lane == 0) cnt4[qt] = value;
}
__device__ __forceinline__ void quad_wait(volatile LAS unsigned* cnt4, unsigned target) {
    for (unsigned sp = 0; sp < (1u << 24); ++sp) {
        const u32x4 v = *(const volatile LAS u32x4*)cnt4;
        unsigned mn = v.x < v.y ? v.x : v.y; const unsigned m2 = v.z < v.w ? v.z : v.w; mn = mn < m2 ? mn : m2;
        if ((int)((unsigned)__builtin_amdgcn_readfirstlane(mn) - target) >= 0) break;
        __builtin_amdgcn_s_sleep(1); }
    asm volatile("" ::: "memory");
}
namespace dsa {
constexpr int OFF_ROWS = 0, OFF_XCH = 65536, OFF_SEL = OFF_XCH + 32768, OFF_LUT = OFF_SEL + 4096, OFF_AL = OFF_LUT + 129 * 16 * 4 + 64, OFF_QB = OFF_AL + 8 * 64 * 4, LDS_END = OFF_QB + 64;
__device__ __forceinline__ unsigned off_a(unsigned row, unsigned ch) { return 2048u * (row >> 3) + 512u * (ch >> 2) + 64u * (row & 7) + 16u * ((ch & 3) ^ ((row >> 2) & 3)); }
}
#ifndef SATTN_LMAP
#define SATTN_LMAP 1
#endif
template <int V>
__device__ __forceinline__ void phase_sattn(const Ctx& F, const float* tab, unsigned char* OL) {
    using namespace dsa;
    const bf16_t* CKV = (const bf16_t*)(F.ws + B1_CKVN); const bf16_t* QL = (const bf16_t*)(F.ws + B1_QLAT); const int* SEL = (const int*)(F.ws + SM_SEL);
    const int lane = F.lane, wid = F.wave, l15 = lane & 15, q4 = lane >> 4, slot = wid >> 2, qt = wid & 3;
    char* lds = (char*)F.ldsg;
    char* rows = lds + OFF_ROWS + wid * 8192;
    float* lut = (float*)(lds + OFF_LUT); float* alw = (float*)(lds + OFF_AL) + wid * 64;
    for (int i = F.tid; i < 129 * 16; i += NTHREADS) lut[i] = tab[rel_bucket_dev(i >> 4) * 16 + (i & 15)] * LOG2E;
    unsigned st_addr[2][4];
#pragma unroll
    for (int c = 0; c < 2; ++c)
#pragma unroll
        for (int s = 0; s < 4; ++s) st_addr[c][s] = off_a(8u * (l15 >> 2) + 4u * c + (l15 & 3), 4u * s + q4);
    unsigned wr_addr[2];
#if SATTN_LMAP == 2
#define WR_IMM(s_) (4096 * ((s_) >> 1) + 1024 * ((s_) & 1))
#pragma unroll
    for (int c = 0; c < 2; ++c) { const unsigned nl = lane >> 3; wr_addr[c] = off_a(8u * (nl >> 2) + 4u * c + (nl & 3), lane & 7); }
#else
#define WR_IMM(s_) (512 * (s_))
#pragma unroll
    for (int c = 0; c < 2; ++c) { const unsigned nl = lane >> 2; wr_addr[c] = off_a(8u * (nl >> 2) + 4u * c + (nl & 3), lane & 3); }
#endif
    unsigned tr_base[2][2];
    { const unsigned q = (lane & 15) >> 2, p = lane & 3;
#pragma unroll
      for (int c1 = 0; c1 < 2; ++c1)
#pragma unroll
          for (int t = 0; t < 2; ++t) tr_base[c1][t] = (unsigned)(uintptr_t)rows + off_a(8u * q4 + 4u * t + q, 2u * c1 + (p >> 1)) + 8u * (p & 1); }
    __syncthreads();
    volatile LAS unsigned* pcnt = (volatile LAS unsigned*)(F.lds + OFF_QB) + slot * 8; volatile LAS unsigned* ccnt = pcnt + 4;
    if (F.tid < 16) ((LAS unsigned*)(F.lds + OFF_QB))[F.tid] = 0u;
    const int per = (M + F.G - 1) / F.G;
    int* sellb = (int*)(lds + OFF_SEL);
    bf16x8 bq[4];
    const bool xmap = (F.G == 256) && (per == 64);
    const int xb = (F.bid >> 2) & 1, xj = ((F.bid >> 3) << 2) | (F.bid & 3);
#define QUERY_OF(it_) (xmap ? (xb * T + ((it_) + slot) * 128 + xj) : (F.bid * per + (it_) + slot))
    { const int m0 = QUERY_OF(0); const int mm0 = m0 < M ? m0 : M - 1;
      if (qt == 0) *(u32x4*)(sellb + slot * 256 + 4 * lane) = *(const u32x4*)(SEL + (size_t)mm0 * 256 + 4 * lane);
#pragma unroll
      for (int s = 0; s < 4; ++s) bq[s] = *(const bf16x8*)(QL + (size_t)mm0 * 8192 + l15 * 512 + qt * 128 + 32 * s + 8 * q4); }
    __syncthreads();
    if (slot == 1) { for (int i = 0; i < 12; ++i) __builtin_amdgcn_s_sleep(64); }
    for (int it = 0; it < per; it += 2) {
        const int par = (it >> 1) & 1;
        const int m = QUERY_OF(it); const bool live = m < M;
        const int mm = live ? m : M - 1; const int b = mm >> 13, t = mm & 8191;
        const int* sell = sellb + (par * 2 + slot) * 256;
        int mn = QUERY_OF(it + 2); if (it + 2 >= per || mn >= M) mn = mm;
        u32x4 seln = {0u, 0u, 0u, 0u}; bf16x8 bqn[4];
        bf16x8 afn[2][4];
#if SATTN_LMAP == 2
#define LOAD_ROWS(dst, step_) do { _Pragma("unroll") for (int c = 0; c < 2; ++c) { _Pragma("unroll") for (int h2 = 0; h2 < 2; ++h2) { int kidx = sell[(step_) * 32 + c * 16 + 8 * h2 + (lane >> 3)]; kidx = kidx < 0 ? 0 : kidx; \
            const bf16_t* rp = CKV + ((size_t)b * T + kidx) * 512 + qt * 128 + 8 * (lane & 7); dst[c][2 * h2] = *(const bf16x8*)rp; dst[c][2 * h2 + 1] = *(const bf16x8*)(rp + 64); } } } while (0)
#else
#define LOAD_ROWS(dst, step_) do { _Pragma("unroll") for (int c = 0; c < 2; ++c) { int kidx = sell[(step_) * 32 + c * 16 + (lane >> 2)]; kidx = kidx < 0 ? 0 : kidx; \
            const bf16_t* rp = CKV + ((size_t)b * T + kidx) * 512 + qt * 128 + 8 * (lane & 3); _Pragma("unroll") for (int s = 0; s < 4; ++s) dst[c][s] = *(const bf16x8*)(rp + 32 * s); } } while (0)
#endif
        LOAD_ROWS(afn, 0);
        f32x4 o[8];
#pragma unroll
        for (int cb = 0; cb < 8; ++cb) o[cb] = (f32x4){0.f, 0.f, 0.f, 0.f};
        float m_run = -1e30f, l_run = 0.f;
        s16x4 v0[8], v1[8];
        const unsigned gbase = (unsigned)(it >> 1) * 8u;
#pragma unroll 1
        for (int step = 0; step <= 8; ++step) {
            if (step < 8) {
#pragma unroll
                for (int c = 0; c < 2; ++c)
#pragma unroll
                    for (int s = 0; s < 4; ++s) *(bf16x8*)(rows + wr_addr[c] + WR_IMM(s)) = afn[c][s];
                if (step < 7) LOAD_ROWS(afn, step + 1);
                if (step == 6) {
                    if (qt == 0) seln = *(const u32x4*)(SEL + (size_t)mn * 256 + 4 * lane);
#pragma unroll
                    for (int s = 0; s < 4; ++s) bqn[s] = *(const bf16x8*)(QL + (size_t)mn * 8192 + l15 * 512 + qt * 128 + 32 * s + 8 * q4); }
                f32x4 sp[2]; bf16x8 af[2][4];
#pragma unroll
                for (int c = 0; c < 2; ++c) { sp[c] = (f32x4){0.f, 0.f, 0.f, 0.f};
#pragma unroll
                    for (int s = 0; s < 4; ++s) af[c][s] = *(const bf16x8*)(rows + st_addr[c][s]);
#pragma unroll
                    for (int s = 0; s < 4; ++s) sp[c] = __builtin_amdgcn_mfma_f32_16x16x32_bf16(af[c][s], bq[s], sp[c], 0, 0, 0); }
                const unsigned g = gbase + (unsigned)step;
                if (g >= 2u) quad_wait(ccnt, g - 1u);
                if (step == 7 && qt == 0) *(u32x4*)(sellb + ((par ^ 1) * 2 + slot) * 256 + 4 * lane) = seln;
                f32x4* xch = (f32x4*)(lds + OFF_XCH) + (size_t)(step & 1) * 1024;
                xch[(wid * 2 + 0) * 64 + lane] = sp[0]; xch[(wid * 2 + 1) * 64 + lane] = sp[1];
                quad_signal(pcnt, qt, g + 1u, lane);
            }
            if (step > 0) {
                const int ps = step - 1;
                quad_wait(pcnt, gbase + (unsigned)ps + 1u);
                const f32x4* xch = (const f32x4*)(lds + OFF_XCH) + (size_t)(ps & 1) * 1024;
                f32x4 st[2];
#pragma unroll
                for (int c = 0; c < 2; ++c) { st[c] = xch[((slot * 4 + 0) * 2 + c) * 64 + lane] + xch[((slot * 4 + 1) * 2 + c) * 64 + lane] + xch[((slot * 4 + 2) * 2 + c) * 64 + lane] + xch[((slot * 4 + 3) * 2 + c) * 64 + lane]; }
                quad_signal(ccnt, qt, gbase + (unsigned)ps + 1u, lane);
                float pmax = -__builtin_inff();
#pragma unroll
                for (int c = 0; c < 2; ++c) { const u32x4 kk = *(const u32x4*)(sell + ps * 32 + c * 16 + 4 * q4);
                    float bv[4];
#pragma unroll
                    for (int j = 0; j < 4; ++j) { int d = t - (int)kk[j]; d = d < 0 ? 0 : (d > 128 ? 128 : d); bv[j] = lut[d * 16 + l15]; }
                    asm volatile("" : "+v"(bv[0]), "+v"(bv[1]), "+v"(bv[2]), "+v"(bv[3]));
#pragma unroll
                    for (int j = 0; j < 4; ++j) { const int kidx = (int)kk[j]; const bool ok = (kidx >= 0) && (kidx <= t);
                        const float v = ok ? st[c][j] + bv[j] : -__builtin_inff(); st[c][j] = v; pmax = fmaxf(pmax, v); } }
                { auto r16 = __builtin_amdgcn_permlane16_swap(__float_as_uint(pmax), __float_as_uint(pmax), false, false); pmax = fmaxf(__uint_as_float(r16[0]), __uint_as_float(r16[1]));
                  auto r32 = __builtin_amdgcn_permlane32_swap(__float_as_uint(pmax), __float_as_uint(pmax), false, false); pmax = fmaxf(__uint_as_float(r32[0]), __uint_as_float(r32[1])); }
                float alpha = 1.f;
                if (!__all((pmax - m_run) <= att::THR2)) { const float mnew = fmaxf(m_run, pmax); alpha = __builtin_amdgcn_exp2f(m_run - mnew); m_run = mnew;
                    if (q4 == 0) alw[l15] = alpha;
                    LDS_WAIT(); asm volatile("" ::: "memory");
                    const f32x4 a4 = *(const f32x4*)(alw + 4 * q4);
#pragma unroll
                    for (int cb = 0; cb < 8; ++cb) o[cb] = o[cb] * a4; }
                float ps_ = 0.f; unsigned pk[4];
#pragma unroll
                for (int c = 0; c < 2; ++c) { float p0 = __builtin_amdgcn_exp2f(st[c][0] - m_run), p1 = __builtin_amdgcn_exp2f(st[c][1] - m_run), p2 = __builtin_amdgcn_exp2f(st[c][2] - m_run), p3 = __builtin_amdgcn_exp2f(st[c][3] - m_run);
                    ps_ += (p0 + p1) + (p2 + p3); pk[2 * c] = cvt_pk_bf16(p0, p1); pk[2 * c + 1] = cvt_pk_bf16(p2, p3); }
                l_run = l_run * alpha + ps_;
                const u32x4 pw = {pk[0], pk[1], pk[2], pk[3]}; const bf16x8 pa = *reinterpret_cast<const bf16x8*>(&pw);
                asm volatile("s_waitcnt lgkmcnt(0)" ::: "memory");
#pragma unroll
                for (int cb = 0; cb < 8; ++cb)
                    o[cb] = __builtin_amdgcn_mfma_f32_16x16x32_bf16(pa, (bf16x8){v0[cb][0], v0[cb][1], v0[cb][2], v0[cb][3], v1[cb][0], v1[cb][1], v1[cb][2], v1[cb][3]}, o[cb], 0, 0, 0);
            }
            if (step < 8) {
#pragma unroll
                for (int cb = 0; cb < 8; ++cb) {
                    asm volatile("ds_read_b64_tr_b16 %0, %1 offset:%2" : "=&v"(v0[cb]) : "v"(tr_base[cb & 1][0]), "i"(512 * (cb >> 1)) : "memory");
                    asm volatile("ds_read_b64_tr_b16 %0, %1 offset:%2" : "=&v"(v1[cb]) : "v"(tr_base[cb & 1][1]), "i"(512 * (cb >> 1)) : "memory"); }
            }
        }
#undef LOAD_ROWS
        float l = l_run;
        { auto r16 = __builtin_amdgcn_permlane16_swap(__float_as_uint(l), __float_as_uint(l), false, false); l = __uint_as_float(r16[0]) + __uint_as_float(r16[1]);
          auto r32 = __builtin_amdgcn_permlane32_swap(__float_as_uint(l), __float_as_uint(l), false, false); l = __uint_as_float(r32[0]) + __uint_as_float(r32[1]); }
        if (q4 == 0) alw[16 + l15] = 1.0f / l;
        LDS_WAIT(); asm volatile("" ::: "memory");
        const f32x4 r4 = *(const f32x4*)(alw + 16 + 4 * q4);
        if (live) {
#pragma unroll
            for (int cb = 0; cb < 8; ++cb)
#pragma unroll
                for (int e = 0; e < 4; ++e) { const float v = o[cb][e] * (r4[e] * 16.0f); const float v1_ = pg8::quad_xor1(v), v2_ = pg8::quad_xor2(v), v3_ = pg8::quad_xor3(v);
                    if ((lane & 3) == 0) *(unsigned*)(OL + (size_t)m * 8192 + (4 * q4 + e) * 512 + qt * 128 + 16 * cb + l15) = pg8::pk4_fp8(v, v1_, v2_, v3_); }
        }
#pragma unroll
        for (int s = 0; s < 4; ++s) bq[s] = bqn[s];
    }
    __syncthreads();
}
#ifndef MK_PER_PHASE
#define MK_PER_PHASE 0
#endif
constexpr int NPHASE = 22;
#ifndef REPEAT_MASK
#define REPEAT_MASK 0ull
#endif
#define REP(k) ((int)(((unsigned long long)(REPEAT_MASK) >> (k)) & 1ull))
__global__ void __launch_bounds__(NTHREADS, 2) fwd(Args args) {
    extern __shared__ __attribute__((aligned(16))) unsigned char lds_raw[];
    const int wave_s = __builtin_amdgcn_readfirstlane((int)threadIdx.x >> 6);
#define MKCTX(F) Ctx F; { int t_ = (int)__builtin_amdgcn_mbcnt_hi(~0u, __builtin_amdgcn_mbcnt_lo(~0u, 0u)); asm volatile("" : "+v"(t_)); t_ |= wave_s << 6; F.lds = (LAS unsigned char*)lds_raw; F.ldsg = lds_raw; F.ws = args.ws; F.out = args.out; \
        F.tid = t_; F.lane = t_ & 63; F.wave = __builtin_amdgcn_readfirstlane(t_ >> 6); F.G = gridDim.x; F.bid = blockIdx.x; }
    volatile LAS unsigned* MISC = (volatile LAS unsigned*)((LAS unsigned char*)lds_raw + MISC_OFF);
    for (int u = (int)threadIdx.x; u < (LDS_BYTES - MISC_OFF) / 4; u += NTHREADS) ((LAS unsigned*)((LAS unsigned char*)lds_raw + MISC_OFF))[u] = 0u;
    __syncthreads();
    const int lo = args.ph_lo, hi = args.ph_hi;
    XcdBarrier bar; bar.bar = (unsigned*)(args.ws + WS_CTL) + CW_BAR; bar.x = 0; bar.st = nullptr;
    #define LEADER() (wave_s == 0 && __builtin_amdgcn_mbcnt_hi(~0u, __builtin_amdgcn_mbcnt_lo(~0u, 0u)) == 0u)
    if (hi - lo > 1) bar = xcd_barrier_post((unsigned*)(args.ws + WS_CTL) + CW_BAR, MISC + 8, LEADER());
#ifdef ONLY_PHASE
#define IN(k) ((k) == ONLY_PHASE && lo <= (k) && (k) < hi)
#else
#define IN(k) (lo <= (k) && (k) < hi)
#endif
#define SEAM(k) do { if (IN(k) && IN((k) + 1)) xcd_barrier(bar, LEADER()); } while (0)
    unsigned char* ws = args.ws;
    bf16_t* XB = (bf16_t*)(ws + WS_XB);

    if (IN(0)) for (int rep_ = 0; rep_ <= REP(0); ++rep_) { if (rep_) xcd_barrier(bar, LEADER()); MKCTX(F); const ProIn I{args.in[0], args.in[2], args.in[3], args.in[4], args.in[7], args.in[8], args.in[9], args.in[12], args.in[15], args.in[16], args.in[17], args.in[18], args.in[19], args.in[23], args.in[24], args.in[25]}; phase_prologue(F, I); } SEAM(0);
    if (IN(1)) for (int rep_ = 0; rep_ <= REP(1); ++rep_) { if (rep_) xcd_barrier(bar, LEADER()); MKCTX(F);
        pg8::Gemm g{XB, (const bf16_t*)(ws + WS_WIN0), 2048, 2048, 2048}; pg8::PlainSched S; S.init(M / 256, NQKV0 / 256, F.G, F.bid); S.akstep = 0;
        pg8::EpiQKV0 E{(bf16_t*)(ws + B0_QKV)}; pg8::gemm_phase(F.lds, g, S, E, F.tid); } SEAM(1);
    if (IN(2)) for (int rep_ = 0; rep_ <= REP(2); ++rep_) { if (rep_) xcd_barrier(bar, LEADER()); MKCTX(F); phase_pre0(F); } SEAM(2);
    if (IN(3)) { for (int rep_ = 0; rep_ <= REP(3); ++rep_) { if (rep_) xcd_barrier(bar, LEADER()); MKCTX(F); phase_attn0_moba(F, args.in[1]); } for (int rep_ = 0; rep_ <= REP(22); ++rep_) { if (rep_) xcd_barrier(bar, LEADER()); MKCTX(F); phase_attn0_fox(F); } } SEAM(3);
    if (IN(4)) for (int rep_ = 0; rep_ <= REP(4); ++rep_) { if (rep_) xcd_barrier(bar, LEADER()); MKCTX(F);
        pg8::Gemm g{(const bf16_t*)(ws + B0_O), (const bf16_t*)(ws + WS_WOUT0), 1024, 1024, 1024}; pg8::PlainSched S; S.init(M / 256, DM / 256, F.G, F.bid); S.akstep = 0;
        pg8::EpiResF32 E{args.in[0], args.out, DM, ALPHA, 1.0f / 1024.0f}; pg8::gemm_phase<pg8::EpiResF32, pg8::PlainSched, true>(F.lds, g, S, E, F.tid); } SEAM(4);
    if (IN(5)) for (int rep_ = 0; rep_ <= REP(5); ++rep_) { if (rep_) xcd_barrier(bar, LEADER()); MKCTX(F); phase_ln<true>(F, args.in[5], args.in[6]); } SEAM(5);
    if (IN(6)) for (int rep_ = 0; rep_ <= REP(6); ++rep_) { if (rep_) xcd_barrier(bar, LEADER()); MKCTX(F);
        pg8::Gemm g{XB, (const bf16_t*)(ws + WS_WFF13), 1024, 1024, 1024}; pg8::PlainSched S; S.init(M / 256, 2 * FF0 / 256, F.G, F.bid); S.akstep = 0;
        pg8::EpiSwiGLU8 E{ws + B0_ACT, FF0}; pg8::gemm_phase<pg8::EpiSwiGLU8, pg8::PlainSched, true>(F.lds, g, S, E, F.tid); } SEAM(6);
    if (IN(7)) for (int rep_ = 0; rep_ <= REP(7); ++rep_) { if (rep_) xcd_barrier(bar, LEADER()); MKCTX(F);
        pg8::Gemm g{(const bf16_t*)(ws + B0_ACT), (const bf16_t*)(ws + WS_WFF2), FF0 / 2, FF0 / 2, FF0 / 2}; pg8::PlainSched S; S.init(M / 256, DM / 256, F.G, F.bid); S.akstep = 0;
        pg8::EpiResLnF32 E{args.out, args.out, DM, ALPHA, 1.0f / 512.0f, (const float*)(ws + SM_STAT), args.in[5], args.in[6]}; pg8::gemm_phase<pg8::EpiResLnF32, pg8::PlainSched, true>(F.lds, g, S, E, F.tid); } SEAM(7);
    if (IN(8)) for (int rep_ = 0; rep_ <= REP(8); ++rep_) { if (rep_) xcd_barrier(bar, LEADER()); MKCTX(F); phase_ln<false>(F, args.in[10], args.in[11]); } SEAM(8);
    if (IN(9)) for (int rep_ = 0; rep_ <= REP(9); ++rep_) { if (rep_) xcd_barrier(bar, LEADER()); MKCTX(F);
        pg8::Gemm g{XB, (const bf16_t*)(ws + WS_WIN1), 2048, 2048, 2048}; pg8::PlainSched S; S.init(M / 256, NIN1P / 256, F.G, F.bid); S.akstep = 0;
        pg8::EpiF32 E{(float*)(ws + B1_PROJ), NIN1P}; pg8::gemm_phase(F.lds, g, S, E, F.tid); } SEAM(9);
    if (IN(10)) for (int rep_ = 0; rep_ <= REP(10); ++rep_) { if (rep_) xcd_barrier(bar, LEADER()); MKCTX(F); phase_norm1(F, args.in[13], args.in[14]); } SEAM(10);
    if (IN(11)) for (int rep_ = 0; rep_ <= REP(11); ++rep_) { if (rep_) xcd_barrier(bar, LEADER()); MKCTX(F);
        pg8::Gemm g{(const bf16_t*)(ws + B1_CQN), (const bf16_t*)(ws + WS_WQ1), 512, 512, 512}; pg8::PlainSched S; S.init(M / 256, NQ1 / 256, F.G, F.bid); S.akstep = 0;
        pg8::EpiBf16 E{(bf16_t*)(ws + B1_QLAT), 8192, 8192, (bf16_t*)(ws + B1_QIDX), 1024}; pg8::gemm_phase(F.lds, g, S, E, F.tid); } SEAM(11);
    if (IN(12)) for (int rep_ = 0; rep_ <= REP(12); ++rep_) { if (rep_) xcd_barrier(bar, LEADER()); MKCTX(F); phase_index(F, (float*)(ws + B1_SC)); } SEAM(12);
    if (IN(13)) { MKCTX(F); phase_topk(F, 1 + REP(13)); } SEAM(13);
    if (IN(14)) for (int rep_ = 0; rep_ <= REP(14); ++rep_) { if (rep_) xcd_barrier(bar, LEADER()); MKCTX(F); phase_sattn<0>(F, args.in[1], ws + B1_SC); }
#ifdef SATTN_PROBE
    if (IN(14)) { xcd_barrier(bar, LEADER()); MKCTX(F); phase_sattn<SATTN_PROBE>(F, args.in[1], ws + B1_SC); }
#endif
    SEAM(14);
    if (IN(15)) for (int rep_ = 0; rep_ <= REP(15); ++rep_) { if (rep_) xcd_barrier(bar, LEADER()); MKCTX(F);
        pg8::Gemm g{(const bf16_t*)(ws + B1_SC), (const bf16_t*)(ws + WS_WUV), 4096, 512, 512}; pg8::PlainSched S; S.init(M / 256, DM / 256, F.G, F.bid); S.akstep = 512;
        pg8::Epi8 E{ws + B1_OB, DM, 1.0f / 64.0f}; pg8::gemm_phase<pg8::Epi8, pg8::PlainSched, true>(F.lds, g, S, E, F.tid); } SEAM(15);
    if (IN(16)) for (int rep_ = 0; rep_ <= REP(16); ++rep_) { if (rep_) xcd_barrier(bar, LEADER()); MKCTX(F);
        pg8::Gemm g{(const bf16_t*)(ws + B1_OB), (const bf16_t*)(ws + WS_WOUT1), 1024, 1024, 1024}; pg8::PlainSched S; S.init(M / 256, DM / 256, F.G, F.bid); S.akstep = 0;
        pg8::EpiResLnF32 E{args.out, args.out, DM, ALPHA, 1.0f / 1024.0f, (const float*)(ws + SM_STAT), args.in[10], args.in[11]}; pg8::gemm_phase<pg8::EpiResLnF32, pg8::PlainSched, true>(F.lds, g, S, E, F.tid); } SEAM(16);
    if (IN(17)) for (int rep_ = 0; rep_ <= REP(17); ++rep_) { if (rep_) xcd_barrier(bar, LEADER()); MKCTX(F); phase_ln_router(F, args.in[20], args.in[21], args.in[22]); } SEAM(17);
    if (IN(18)) for (int rep_ = 0; rep_ <= REP(18); ++rep_) { if (rep_) xcd_barrier(bar, LEADER()); MKCTX(F); phase_gather(F); } SEAM(18);
    if (IN(19)) for (int rep_ = 0; rep_ <= REP(19); ++rep_) { if (rep_) xcd_barrier(bar, LEADER()); MKCTX(F);
        int ts_[9]; moe_tstart(F, ts_); pg8::MoeSched S; S.set_tstart(ts_); S.brows = 2 * FFE; S.init(ts_[8], 2 * FFE / 256, F.G, F.bid);
        pg8::Gemm g{(const bf16_t*)(ws + B1_XG), (const bf16_t*)(ws + WS_WE13), 1024, 1024, 1024};
        pg8::EpiSwiGLU8 E{ws + B1_H, FFE}; pg8::gemm_phase<pg8::EpiSwiGLU8, pg8::MoeSched, true>(F.lds, g, S, E, F.tid); } SEAM(19);
    if (IN(20)) for (int rep_ = 0; rep_ <= REP(20); ++rep_) { if (rep_) xcd_barrier(bar, LEADER()); MKCTX(F);
        int ts_[9]; moe_tstart(F, ts_); pg8::MoeSplitSched S; S.set_tstart(ts_); S.brows = DM; S.init2(ts_[8], DM / 256, F.G, F.bid, FFE / 128);
        pg8::Gemm g{(const bf16_t*)(ws + B1_H), (const bf16_t*)(ws + WS_WE2), FFE / 2, FFE / 2, FFE / 2};
        pg8::EpiYSlab E{(bf16_t*)(ws + B1_Y), DM, (float*)(ws + B1_SLAB), (unsigned*)(ws + WS_CTL) + CW_FLAG, DM / 256, S.S, 1.0f / 512.0f}; pg8::gemm_phase<pg8::EpiYSlab, pg8::MoeSplitSched, true>(F.lds, g, S, E, F.tid); } SEAM(20);
    if (IN(21)) for (int rep_ = 0; rep_ <= REP(21); ++rep_) { if (rep_) xcd_barrier(bar, LEADER()); MKCTX(F); int ts_[9]; moe_tstart(F, ts_); phase_final(F, args.in[26], args.in[27], pg8::split_factor(ts_[8] * (DM / 256), F.G, FFE / 128), args.in[20], args.in[21]); }
#undef IN
#undef SEAM
}

extern "C" void kernel_launch(void* const* d_in, const int* in_sizes, int n_in, void* d_out, int out_size, void* d_ws, size_t ws_size, hipStream_t stream) {
    static int grid = 0;
    if (grid == 0) {
        if (n_in != 28 || out_size != M * DM || ws_size < WS_NEED) { fprintf(stderr, "kernel_launch: unexpected shapes (n_in %d, out %d, ws %zu < %zu)\n", n_in, out_size, ws_size, (size_t)WS_NEED); grid = -1; return; }
        int dev = 0, cus = 0, per_cu = 0;
        if (hipGetDevice(&dev) != hipSuccess || hipDeviceGetAttribute(&cus, hipDeviceAttributeMultiprocessorCount, dev) != hipSuccess) { grid = -1; return; }
        if (hipFuncSetAttribute((const void*)fwd, hipFuncAttributeMaxDynamicSharedMemorySize, LDS_BYTES) != hipSuccess) { fprintf(stderr, "kernel_launch: hipFuncSetAttribute failed\n"); grid = -1; return; }
        if (hipOccupancyMaxActiveBlocksPerMultiprocessor(&per_cu, (const void*)fwd, NTHREADS, LDS_BYTES) != hipSuccess || per_cu < 1) fprintf(stderr, "kernel_launch: occupancy query reports %d\n", per_cu);
        (void)hipGetLastError();
        grid = cus;
    }
    if (grid < 0) return;
    if (hipMemsetAsync((char*)d_ws + WS_CTL, 0, CTL_ZERO_BYTES, stream) != hipSuccess) return;
    Args a{};
    for (int i = 0; i < 28; ++i) a.in[i] = (const float*)d_in[i];
    a.out = (float*)d_out; a.ws = (unsigned char*)d_ws;
#if MK_PER_PHASE
    for (int p = 0; p < NPHASE; ++p) { a.ph_lo = p; a.ph_hi = p + 1; hipLaunchKernelGGL(fwd, dim3(grid), dim3(NTHREADS), LDS_BYTES, stream, a); }
#else
    a.ph_lo = 0; a.ph_hi = NPHASE; hipLaunchKernelGGL(fwd, dim3(grid), dim3(NTHREADS), LDS_BYTES, stream, a);
#endif
}
```

```cpp
#include <hip/hip_runtime.h>
#include <cstdint>
#include <cstdio>

#define GAS __attribute__((address_space(1)))
#define LAS __attribute__((address_space(3)))
typedef unsigned short bf16_t;
typedef short bf16x8 __attribute__((ext_vector_type(8)));
typedef short s16x4 __attribute__((ext_vector_type(4)));
typedef float f32x2 __attribute__((ext_vector_type(2)));
typedef float f32x4 __attribute__((ext_vector_type(4)));
typedef float f32x16 __attribute__((ext_vector_type(16)));
typedef unsigned u32x2 __attribute__((ext_vector_type(2)));
typedef unsigned u32x4 __attribute__((ext_vector_type(4)));
typedef GAS unsigned gu32;
#define RLX_AGENT __ATOMIC_RELAXED, __HIP_MEMORY_SCOPE_AGENT
#define LDS_WAIT() asm volatile("s_waitcnt lgkmcnt(0)" ::: "memory")
#define VM_WAIT() asm volatile("s_waitcnt vmcnt(0)" ::: "memory")
#define SBAR() __builtin_amdgcn_sched_barrier(0)

__device__ __forceinline__ unsigned cvt_pk_bf16(float lo, float hi) { unsigned r; asm volatile("v_cvt_pk_bf16_f32 %0, %1, %2" : "=v"(r) : "v"(lo), "v"(hi)); return r; }
__device__ __forceinline__ unsigned f2bf(float f) { unsigned u = __builtin_bit_cast(unsigned, f); return (u + 0x7fffu + ((u >> 16) & 1u)) >> 16; }
__device__ __forceinline__ unsigned pk2(float lo, float hi) { return f2bf(lo) | (f2bf(hi) << 16); }
__device__ __forceinline__ float bf2f(unsigned short b) { return __builtin_bit_cast(float, ((unsigned)b) << 16); }
__device__ __forceinline__ float bflo(unsigned w) { return __builtin_bit_cast(float, w << 16); }
__device__ __forceinline__ float bfhi(unsigned w) { return __builtin_bit_cast(float, w & 0xffff0000u); }
#define WAVE_DPP(v, ctrl) __builtin_bit_cast(float, __builtin_amdgcn_mov_dpp(__builtin_bit_cast(int, v), ctrl, 0xF, 0xF, true))
#define WAVE_DPP_ROWS(old_, v, ctrl, rmask) __builtin_bit_cast(float, __builtin_amdgcn_update_dpp(__builtin_bit_cast(int, old_), __builtin_bit_cast(int, v), ctrl, rmask, 0xF, false))
__device__ __forceinline__ float wave_sum(float v) {
    v += WAVE_DPP(v, 0xB1);
    v += WAVE_DPP(v, 0x4E);
    v += WAVE_DPP(v, 0x141);
    v += WAVE_DPP(v, 0x140);
    v += WAVE_DPP_ROWS(0.0f, v, 0x142, 0xA);
    v += WAVE_DPP_ROWS(0.0f, v, 0x143, 0xC);
    return __builtin_bit_cast(float, __builtin_amdgcn_readlane(__builtin_bit_cast(int, v), 63));
}
__device__ __forceinline__ float wave_max(float v) {
    v = fmaxf(v, WAVE_DPP(v, 0xB1)); v = fmaxf(v, WAVE_DPP(v, 0x4E)); v = fmaxf(v, WAVE_DPP(v, 0x141)); v = fmaxf(v, WAVE_DPP(v, 0x140));
    v = fmaxf(v, WAVE_DPP_ROWS(v, v, 0x142, 0xA)); v = fmaxf(v, WAVE_DPP_ROWS(v, v, 0x143, 0xC));
    return __builtin_bit_cast(float, __builtin_amdgcn_readlane(__builtin_bit_cast(int, v), 63));
}

#define XB_TMO      128
#define XB_XCNT(j)  (256  + 64 * (j))
#define XB_XSUB(j)  (1280 + 64 * (j))
#define XB_XGEN(j)  (2304 + 64 * (j))
#define XB_TOP      3328
#define XB_TOPGEN   3392
#define XCD_BAR_WORDS 3456
#define XB_SPIN_CAP (1u << 18)
__device__ __forceinline__ unsigned xb_ld(unsigned* p)              { return __hip_atomic_load(p, __ATOMIC_RELAXED, __HIP_MEMORY_SCOPE_AGENT); }
__device__ __forceinline__ unsigned xb_add(unsigned* p, unsigned v) { return __hip_atomic_fetch_add(p, v, __ATOMIC_RELAXED, __HIP_MEMORY_SCOPE_AGENT); }
__device__ __forceinline__ unsigned xb_xcc_id() { return (unsigned)__builtin_amdgcn_s_getreg((3 << 11) | 20) & 0xFu; }
#define XB_SPIN(cond, bar) do { unsigned _sp = 0; while (cond) { __builtin_amdgcn_s_sleep(1); \
    if ((++_sp & 255u) == 0u) { if (xb_ld(&(bar)[XB_TMO])) break; if (_sp > XB_SPIN_CAP) { atomicAdd(&(bar)[XB_TMO], 1u); break; } } } } while (0)
struct XcdBarrier { unsigned* bar; unsigned x; volatile LAS unsigned* st; };
__device__ __forceinline__ XcdBarrier xcd_barrier_post(unsigned* bar, volatile LAS unsigned* st, bool leader) {
    XcdBarrier b; b.bar = bar; b.x = xb_xcc_id(); b.st = st;
    if (leader) (void)xb_add(&bar[XB_XCNT(b.x)], 1u);
    return b;
}
__device__ __forceinline__ void xcd_barrier_complete(unsigned* bar, unsigned x, unsigned& nloc, unsigned& nx) {
    const unsigned G = gridDim.x * gridDim.y * gridDim.z;
    unsigned sum, cnt, mine, sp = 0u;
    for (;;) {
        sum = 0u; cnt = 0u; mine = 0u;
#pragma unroll
        for (unsigned j = 0; j < 16; ++j) { const unsigned c = xb_ld(&bar[XB_XCNT(j)]); sum += c; cnt += (c > 0u) ? 1u : 0u; mine = (j == x) ? c : mine; }
        if (sum == G) break;
        __builtin_amdgcn_s_sleep(1);
        if ((++sp & 255u) == 0u) { if (xb_ld(&bar[XB_TMO])) break; if (sp > XB_SPIN_CAP) { atomicAdd(&bar[XB_TMO], 1u); break; } }
    }
    nloc = mine > 0u ? mine : 1u; nx = cnt > 0u ? cnt : 1u;
}
__device__ __forceinline__ void xcd_barrier(const XcdBarrier& b, bool leader) {
    asm volatile("s_waitcnt vmcnt(0)" ::: "memory");
    __syncthreads();
    if (leader) {
        unsigned* bar = b.bar;
        __builtin_amdgcn_s_waitcnt(0);
        unsigned nloc = b.st[0], nx = b.st[1];
        if (nloc == 0u) { xcd_barrier_complete(bar, b.x, nloc, nx); b.st[0] = nloc; b.st[1] = nx; }
        const unsigned old = xb_add(&bar[XB_XSUB(b.x)], 1u);
        const unsigned gen = old / nloc;
        if (old + 1u == (gen + 1u) * nloc) {
            __builtin_amdgcn_fence(__ATOMIC_RELEASE, "agent");
            asm volatile("s_waitcnt vmcnt(0)" ::: "memory");
            const unsigned og = xb_add(&bar[XB_TOP], 1u);
            const unsigned tg = og / nx;
            if (og + 1u == (tg + 1u) * nx) xb_add(&bar[XB_TOPGEN], 1u);
            else XB_SPIN(xb_ld(&bar[XB_TOPGEN]) == tg, bar);
            __builtin_amdgcn_fence(__ATOMIC_ACQUIRE, "agent");
            xb_add(&bar[XB_XGEN(b.x)], 1u);
            asm volatile("s_waitcnt vmcnt(0)" ::: "memory");
        } else {
            XB_SPIN(xb_ld(&bar[XB_XGEN(b.x)]) == gen, bar);
            __builtin_amdgcn_fence(__ATOMIC_ACQUIRE, "agent");
            asm volatile("s_waitcnt vmcnt(0)" ::: "memory");
        }
    }
    __syncthreads();
}

namespace pg8 {
constexpr int BM = 256, BK = 64, HALF = 128, HTB = HALF * BK * 2, STAGE_BYTES = 8 * HTB, NXCD = 8, WGM = 8;
__host__ __device__ __forceinline__ int lds_byte(int r, int c) { const int st = (r >> 4) * 2 + (c >> 5), rr = r & 15, cc = c & 31, ob = rr * 64 + cc * 2; return st * 1024 + (ob ^ (((ob >> 9) & 1) << 5)); }
__host__ __device__ __forceinline__ void stage_rc(int b, int& R, int& C) { const int st = b / 1024, sb = b % 1024, swz = sb ^ (((sb >> 9) & 1) << 5); R = (st >> 1) * 16 + swz / 64; C = (st & 1) * 32 + (swz % 64) / 2; }
__host__ __device__ __forceinline__ int perm32(int rho) { const int n = rho >> 4, i = rho & 15; return 8 * (i >> 2) + 4 * n + (i & 3); }

struct Unit { int arow, brow, akoff, orow, ocol, nt, slab; };
struct Gemm { const bf16_t* A; const bf16_t* Bt; int lda, ldb, K; };

struct TileOrder {
    int nM, nN, nwg, G, c;
    __device__ __forceinline__ void init(int nM_, int nN_, int G_, int c_) { nM = nM_; nN = nN_; nwg = nM * nN; G = G_; c = c_; }
    __device__ __forceinline__ bool tile(int i, int& pm, int& pn) const {
        const long L = (long)i * G + c; if (L >= nwg) return false;
        int wgid = (int)L; { const int q = nwg / NXCD, r = nwg % NXCD, xcd = wgid % NXCD, off = wgid / NXCD; wgid = (xcd < r ? xcd * (q + 1) : r * (q + 1) + (xcd - r) * q) + off; }
        const int nig = WGM * nN, gid = wgid / nig, fm = gid * WGM, gsz = (nM - fm) < WGM ? (nM - fm) : WGM;
        pm = fm + ((wgid % nig) % gsz); pn = (wgid % nig) / gsz; return true;
    }
};
struct PlainSched : TileOrder {
    static constexpr bool KSPLIT = false;
    int akstep;
    __device__ __forceinline__ bool next(int i, Unit& u) const { int pm, pn; if (!tile(i, pm, pn)) return false; u.arow = pm * BM; u.brow = pn * BM; u.akoff = pn * akstep; u.orow = pm * BM; u.ocol = pn * BM; u.nt = 0; u.slab = -1; return true; }
};
struct MoeSched : TileOrder {
    static constexpr bool KSPLIT = false;
    int t1, t2, t3, t4, t5, t6, t7, ttot; int brows;
    __device__ __forceinline__ void set_tstart(const int (&ts)[9]) { t1 = ts[1]; t2 = ts[2]; t3 = ts[3]; t4 = ts[4]; t5 = ts[5]; t6 = ts[6]; t7 = ts[7]; ttot = ts[8]; }
    __device__ __forceinline__ int expert_of(int pm) const { return (pm >= t1) + (pm >= t2) + (pm >= t3) + (pm >= t4) + (pm >= t5) + (pm >= t6) + (pm >= t7); }
    __device__ __forceinline__ bool next(int i, Unit& u) const { int pm, pn; if (!tile(i, pm, pn)) return false;
        const int e = expert_of(pm);
        u.arow = pm * BM; u.brow = e * brows + pn * BM; u.akoff = 0; u.orow = pm * BM; u.ocol = pn * BM; u.nt = 0; u.slab = -1; return true; }
};
__device__ __forceinline__ int split_factor(int nwg, int G, int ktiles) { const int nleft = nwg % G; int S = 1;
#define PG8_TRY_S(v) if (nleft > 0 && (v) * nleft <= G && (ktiles % (2 * (v))) == 0 && ktiles / (v) >= 4) S = (v)
    PG8_TRY_S(2); PG8_TRY_S(4); PG8_TRY_S(7); PG8_TRY_S(8);
#undef PG8_TRY_S
    return S; }
struct MoeSplitSched : MoeSched {
    static constexpr bool KSPLIT = true;
    int nfull, nleft, S, ktiles;
    __device__ __forceinline__ void init2(int nM_, int nN_, int G_, int c_, int ktiles_) { init(nM_, nN_, G_, c_); ktiles = ktiles_; nfull = nwg / G; nleft = nwg - nfull * G; S = split_factor(nwg, G_, ktiles_); }
    __device__ __forceinline__ bool next(int i, Unit& u) const {
        const bool split = (S > 1) && (i >= nfull);
        const int lu = c / S, s = c - lu * S;
        const long L = split ? (long)nfull * G + lu : (long)i * G + c;
        if (L >= nwg || (split && (i > nfull || c >= nleft * S))) return false;
        int wgid = (int)L; { const int q = nwg / NXCD, r = nwg % NXCD, xcd = wgid % NXCD, off = wgid / NXCD; wgid = (xcd < r ? xcd * (q + 1) : r * (q + 1) + (xcd - r) * q) + off; }
        const int nig = WGM * nN, gid = wgid / nig, fm = gid * WGM, gsz = (nM - fm) < WGM ? (nM - fm) : WGM;
        const int pm = fm + ((wgid % nig) % gsz), pn = (wgid % nig) / gsz;
        const int e = expert_of(pm), ntp = ktiles / S;
        u.arow = pm * BM; u.brow = e * brows + pn * BM; u.nt = split ? ntp : 0; u.akoff = split ? s * ntp * BK : 0; u.orow = pm * BM; u.ocol = pn * BM; u.slab = split ? lu * S + s : -1; return true; }
};

struct ColMapSched : TileOrder {
    static constexpr bool KSPLIT = false;
    int vsel;
    __device__ __forceinline__ bool next(int i, Unit& u) const { int pm, pn; if (!tile(i, pm, pn)) return false;
        const int on = vsel ? (pn < 4 ? 8 + pn : 16 + pn) : (pn < 8 ? pn : pn + 4);
        u.arow = pm * BM; u.brow = (vsel ? pn : on) * BM; u.akoff = 0; u.orow = pm * BM; u.ocol = on * BM; u.nt = 0; u.slab = -1; return true; }
};
struct EpiQKV0 {
    static constexpr bool PERM = true;
    bf16_t* O; float scale;
    __device__ __forceinline__ void operator()(const f32x4 (&acc)[2][2][4][2], const Unit& u, int wr, int wc, int fr, int fq) const {
        const int row0 = u.orow + wr * 64 + fr;
#pragma unroll
        for (int bj = 0; bj < 2; ++bj) {
            const int c = u.ocol + bj * HALF, ten = c >> 10, h = (c & 1023) >> 7;
#pragma unroll
            for (int ai = 0; ai < 2; ++ai)
#pragma unroll
                for (int m = 0; m < 4; ++m) { const int row = row0 + ai * HALF + m * 16, b = row >> 13, t = row & 8191;
                    bf16_t* p = O + ((((size_t)ten * 2 + b) * 8 + h) * 8192 + t) * 128 + wc * 32 + 8 * fq;
                    const f32x4 v0 = acc[ai][bj][m][0] * scale, v1 = acc[ai][bj][m][1] * scale;
                    u32x4 w; w.x = cvt_pk_bf16(v0[0], v0[1]); w.y = cvt_pk_bf16(v0[2], v0[3]); w.z = cvt_pk_bf16(v1[0], v1[1]); w.w = cvt_pk_bf16(v1[2], v1[3]);
                    *(u32x4*)p = w; }
        }
    }
};
struct EpiResF32 {
    static constexpr bool PERM = false;
    const float* res; float* out; int ldc; float alpha; float scale;
    __device__ __forceinline__ void operator()(const f32x4 (&acc)[2][2][4][2], const Unit& u, int wr, int wc, int fr, int fq) const {
        const int row0 = u.orow + wr * 64 + fr, col0 = u.ocol + wc * 32 + 4 * fq;
#pragma unroll
        for (int ai = 0; ai < 2; ++ai)
#pragma unroll
            for (int m = 0; m < 4; ++m) { const size_t off = (size_t)(row0 + ai * HALF + m * 16) * ldc + col0;
                f32x4 r[2][2];
#pragma unroll
                for (int bj = 0; bj < 2; ++bj)
#pragma unroll
                    for (int n = 0; n < 2; ++n) r[bj][n] = *(const f32x4*)(res + off + bj * HALF + n * 16);
#pragma unroll
                for (int bj = 0; bj < 2; ++bj)
#pragma unroll
                    for (int n = 0; n < 2; ++n) *(f32x4*)(out + off + bj * HALF + n * 16) = r[bj][n] * alpha + acc[ai][bj][m][n] * scale;
                asm volatile("" ::: "memory"); }
    }
};
struct EpiResLnF32 {
    static constexpr bool PERM = false;
    const float* res; float* out; int ldc; float alpha; float scale; const float* stat; const float* g; const float* b;
    __device__ __forceinline__ void operator()(const f32x4 (&acc)[2][2][4][2], const Unit& u, int wr, int wc, int fr, int fq) const {
        const int row0 = u.orow + wr * 64 + fr, col0 = u.ocol + wc * 32 + 4 * fq;
#pragma unroll
        for (int bj = 0; bj < 2; ++bj)
#pragma unroll
            for (int n = 0; n < 2; ++n) {
                const int col = col0 + bj * HALF + n * 16;
                const f32x4 gg = *(const f32x4*)(g + col), bb = *(const f32x4*)(b + col);
#pragma unroll
                for (int ai = 0; ai < 2; ++ai)
#pragma unroll
                    for (int m = 0; m < 4; ++m) { const int row = row0 + ai * HALF + m * 16; const size_t off = (size_t)row * ldc + col;
                        const float mean = stat[2 * (size_t)row], rstd = stat[2 * (size_t)row + 1];
                        const f32x4 r = *(const f32x4*)(res + off);
                        *(f32x4*)(out + off) = ((r - mean) * rstd * gg + bb) * alpha + acc[ai][bj][m][n] * scale; }
                asm volatile("" ::: "memory"); }
    }
};
struct EpiF32 {
    static constexpr bool PERM = false;
    float* out; int ldc;
    __device__ __forceinline__ void operator()(const f32x4 (&acc)[2][2][4][2], const Unit& u, int wr, int wc, int fr, int fq) const {
        const int row0 = u.orow + wr * 64 + fr, col0 = u.ocol + wc * 32 + 4 * fq;
#pragma unroll
        for (int ai = 0; ai < 2; ++ai)
#pragma unroll
            for (int m = 0; m < 4; ++m) { float* rowp = out + (size_t)(row0 + ai * HALF + m * 16) * ldc + col0;
#pragma unroll
                for (int bj = 0; bj < 2; ++bj)
#pragma unroll
                    for (int n = 0; n < 2; ++n) *(f32x4*)(rowp + bj * HALF + n * 16) = acc[ai][bj][m][n]; }
    }
};
struct EpiBf16 {
    static constexpr bool PERM = true;
    bf16_t* O0; int ld0; int split; bf16_t* O1; int ld1;
    __device__ __forceinline__ void operator()(const f32x4 (&acc)[2][2][4][2], const Unit& u, int wr, int wc, int fr, int fq) const {
        const int row0 = u.orow + wr * 64 + fr; bf16_t* base = O0; int ld = ld0, colt = u.ocol;
        if (colt >= split) { base = O1; ld = ld1; colt -= split; }
        const int col0 = colt + wc * 32 + 8 * fq;
#pragma unroll
        for (int ai = 0; ai < 2; ++ai)
#pragma unroll
            for (int m = 0; m < 4; ++m) { bf16_t* rowp = base + (size_t)(row0 + ai * HALF + m * 16) * ld + col0;
#pragma unroll
                for (int bj = 0; bj < 2; ++bj) { const f32x4 v0 = acc[ai][bj][m][0], v1 = acc[ai][bj][m][1];
                    u32x4 w; w.x = cvt_pk_bf16(v0[0], v0[1]); w.y = cvt_pk_bf16(v0[2], v0[3]); w.z = cvt_pk_bf16(v1[0], v1[1]); w.w = cvt_pk_bf16(v1[2], v1[3]);
                    *(u32x4*)(rowp + bj * HALF) = w; } }
    }
};
struct EpiYSlab {
    static constexpr bool PERM = true;
    bf16_t* O; int ld; float* slabs; unsigned* flags; int nN, S; float scale;
    __device__ __forceinline__ void operator()(const f32x4 (&acc)[2][2][4][2], const Unit& u, int wr, int wc, int fr, int fq) const {
        if (u.slab < 0) {
            const int row0 = u.orow + wr * 64 + fr, col0 = u.ocol + wc * 32 + 8 * fq;
#pragma unroll
            for (int ai = 0; ai < 2; ++ai)
#pragma unroll
                for (int m = 0; m < 4; ++m) { bf16_t* rowp = O + (size_t)(row0 + ai * HALF + m * 16) * ld + col0;
#pragma unroll
                    for (int bj = 0; bj < 2; ++bj) { const f32x4 v0 = acc[ai][bj][m][0] * scale, v1 = acc[ai][bj][m][1] * scale;
                        u32x4 w; w.x = cvt_pk_bf16(v0[0], v0[1]); w.y = cvt_pk_bf16(v0[2], v0[3]); w.z = cvt_pk_bf16(v1[0], v1[1]); w.w = cvt_pk_bf16(v1[2], v1[3]);
                        *(u32x4*)(rowp + bj * HALF) = w; } }
        } else {
            float* sl = slabs + (size_t)u.slab * 65536 + (size_t)(wr * 64 + fr) * 256 + wc * 32 + 8 * fq;
#pragma unroll
            for (int ai = 0; ai < 2; ++ai)
#pragma unroll
                for (int m = 0; m < 4; ++m)
#pragma unroll
                    for (int bj = 0; bj < 2; ++bj) { float* p = sl + (size_t)(ai * HALF + m * 16) * 256 + bj * HALF; *(f32x4*)p = acc[ai][bj][m][0] * scale; *(f32x4*)(p + 4) = acc[ai][bj][m][1] * scale; }
            if ((u.slab % S) == 0 && wr == 0 && wc == 0 && fr == 0 && fq == 0) flags[(u.orow >> 8) * nN + (u.ocol >> 8)] = (unsigned)u.slab + 1u;
        }
    }
};
typedef int v8i __attribute__((ext_vector_type(8)));
typedef int v8i_a16 __attribute__((ext_vector_type(8), aligned(16)));
__device__ __forceinline__ float quad_xor1(float v) { return __builtin_bit_cast(float, __builtin_amdgcn_mov_dpp(__builtin_bit_cast(int, v), 0xB1, 0xF, 0xF, true)); }
__device__ __forceinline__ float quad_xor2(float v) { return __builtin_bit_cast(float, __builtin_amdgcn_mov_dpp(__builtin_bit_cast(int, v), 0x4E, 0xF, 0xF, true)); }
__device__ __forceinline__ float quad_xor3(float v) { return __builtin_bit_cast(float, __builtin_amdgcn_mov_dpp(__builtin_bit_cast(int, v), 0x1B, 0xF, 0xF, true)); }
__device__ __forceinline__ unsigned pk4_fp8(float a, float b, float c, float d) { int w = __builtin_amdgcn_cvt_pk_fp8_f32(a, b, 0, false); w = __builtin_amdgcn_cvt_pk_fp8_f32(c, d, w, true); return (unsigned)w; }
__device__ __forceinline__ float silu_mul(float a, float b) { return a * __builtin_amdgcn_rcpf(1.0f + __builtin_amdgcn_exp2f(-1.4426950408889634f * a)) * b; }
struct EpiSwiGLU {
    static constexpr bool PERM = true;
    bf16_t* O; int ldc;
    __device__ __forceinline__ void operator()(const f32x4 (&acc)[2][2][4][2], const Unit& u, int wr, int wc, int fr, int fq) const {
        const int row0 = u.orow + wr * 64 + fr, col0 = (u.ocol >> 1) + wc * 32 + 8 * fq;
#pragma unroll
        for (int ai = 0; ai < 2; ++ai)
#pragma unroll
            for (int m = 0; m < 4; ++m) { bf16_t* rowp = O + (size_t)(row0 + ai * HALF + m * 16) * ldc + col0;
                const f32x4 g0 = acc[ai][0][m][0], g1 = acc[ai][0][m][1], u0 = acc[ai][1][m][0], u1 = acc[ai][1][m][1];
                u32x4 w; w.x = cvt_pk_bf16(silu_mul(g0[0], u0[0]), silu_mul(g0[1], u0[1])); w.y = cvt_pk_bf16(silu_mul(g0[2], u0[2]), silu_mul(g0[3], u0[3]));
                w.z = cvt_pk_bf16(silu_mul(g1[0], u1[0]), silu_mul(g1[1], u1[1])); w.w = cvt_pk_bf16(silu_mul(g1[2], u1[2]), silu_mul(g1[3], u1[3]));
                *(u32x4*)rowp = w; }
    }
};

struct Epi8 {
    static constexpr bool PERM = true;
    unsigned char* O; int ld; float scale;
    __device__ __forceinline__ void operator()(const f32x4 (&acc)[2][2][4][2], const Unit& u, int wr, int wc, int fr, int fq) const {
        const int row0 = u.orow + wr * 64 + fr, col0 = u.ocol + wc * 32 + 8 * fq;
#pragma unroll
        for (int ai = 0; ai < 2; ++ai)
#pragma unroll
            for (int m = 0; m < 4; ++m) { unsigned char* rowp = O + (size_t)(row0 + ai * HALF + m * 16) * ld + col0;
#pragma unroll
                for (int bj = 0; bj < 2; ++bj) { const f32x4 v0 = acc[ai][bj][m][0] * scale, v1 = acc[ai][bj][m][1] * scale;
                    u32x2 w; w.x = pk4_fp8(v0[0], v0[1], v0[2], v0[3]); w.y = pk4_fp8(v1[0], v1[1], v1[2], v1[3]); *(u32x2*)(rowp + bj * HALF) = w; } }
    }
};
struct EpiSwiGLU8 {
    static constexpr bool PERM = true;
    unsigned char* O; int ldc;
    __device__ __forceinline__ void operator()(const f32x4 (&acc)[2][2][4][2], const Unit& u, int wr, int wc, int fr, int fq) const {
        const int row0 = u.orow + wr * 64 + fr, col0 = (u.ocol >> 1) + wc * 32 + 8 * fq; constexpr float si = 1.0f / 64.0f;
#pragma unroll
        for (int ai = 0; ai < 2; ++ai)
#pragma unroll
            for (int m = 0; m < 4; ++m) { unsigned char* rowp = O + (size_t)(row0 + ai * HALF + m * 16) * ldc + col0;
                const f32x4 g0 = acc[ai][0][m][0] * si, g1 = acc[ai][0][m][1] * si, u0 = acc[ai][1][m][0] * (si * 8.0f), u1 = acc[ai][1][m][1] * (si * 8.0f);
                u32x2 w; w.x = pk4_fp8(silu_mul(g0[0], u0[0]), silu_mul(g0[1], u0[1]), silu_mul(g0[2], u0[2]), silu_mul(g0[3], u0[3]));
                w.y = pk4_fp8(silu_mul(g1[0], u1[0]), silu_mul(g1[1], u1[1]), silu_mul(g1[2], u1[2]), silu_mul(g1[3], u1[3]));
                *(u32x2*)rowp = w; }
    }
};
template <class Epi, class Sched, bool F8 = false>
__device__ __forceinline__ void gemm_phase(LAS unsigned char* lds, const Gemm g, const Sched& S, const Epi& E, const int tid) {
    const int wid = __builtin_amdgcn_readfirstlane(tid >> 6), lane = tid & 63, wr = wid >> 2, wc = wid & 3, fr = lane & 15, fq = lane >> 4;
    const int K = g.K, nt = K / BK;
    unsigned voffA[2], voffB[2];
#pragma unroll
    for (int i = 0; i < 2; ++i) { int R, C; stage_rc(tid * 16 + i * 8192, R, C); const int Rb = Epi::PERM ? ((R & ~31) + perm32(R & 31)) : R;
        voffA[i] = (unsigned)(R * g.lda + C) * 2u; voffB[i] = (unsigned)(Rb * g.ldb + C) * 2u; }
    const size_t kstep = (size_t)(BK * 2);
    const size_t hstepA = (size_t)HALF * g.lda * 2, hstepB = (size_t)HALF * g.ldb * 2;
    const unsigned ldsw = (unsigned)wid * 1024u;
    const int aoff = F8 ? lds_byte(wr * 64 + fr, fq * 16) : lds_byte(wr * 64 + fr, fq * 8), boff = F8 ? lds_byte(wc * 32 + fr, fq * 16) : lds_byte(wc * 32 + fr, fq * 8);
#define PG8_SA(b, h) (((b) * 2 + (h)) * HTB)
#define PG8_SB(b, h) ((4 + (b) * 2 + (h)) * HTB)
#define PG8_STAGE(bufoff, gbase, voff) do { _Pragma("unroll") for (int _i = 0; _i < 2; ++_i) \
        __builtin_amdgcn_global_load_lds((const unsigned*)((const char*)(gbase) + (voff)[_i]), (LAS unsigned*)(lds + (bufoff) + ldsw + _i * 8192), 16, 0, 0); } while (0)
#define PG8_LDA(dst, b, h) do { _Pragma("unroll") for (int m = 0; m < 4; ++m) { if constexpr (F8) { dst##8[m] = *(const LAS v8i_a16*)(lds + PG8_SA(b, h) + aoff + m * 2048); } \
        else { _Pragma("unroll") for (int k = 0; k < 2; ++k) dst[m][k] = *(const LAS bf16x8*)(lds + PG8_SA(b, h) + aoff + m * 2048 + k * 1024); } } } while (0)
#define PG8_LDB(dst, b, h) do { _Pragma("unroll") for (int n = 0; n < 2; ++n) { if constexpr (F8) { dst##8[n] = *(const LAS v8i_a16*)(lds + PG8_SB(b, h) + boff + n * 2048); } \
        else { _Pragma("unroll") for (int k = 0; k < 2; ++k) dst[n][k] = *(const LAS bf16x8*)(lds + PG8_SB(b, h) + boff + n * 2048 + k * 1024); } } } while (0)
#define PG8_MMA(ai, bj, At, Bt) do { __builtin_amdgcn_s_setprio(1); _Pragma("unroll") for (int m = 0; m < 4; ++m) _Pragma("unroll") for (int n = 0; n < 2; ++n) { if constexpr (F8) { \
            acc[ai][bj][m][n] = __builtin_amdgcn_mfma_scale_f32_16x16x128_f8f6f4(Bt##8[n], At##8[m], acc[ai][bj][m][n], 0, 0, 0, 0x7F7F7F7F, 0, 0x7F7F7F7F); \
        } else { _Pragma("unroll") for (int k = 0; k < 2; ++k) acc[ai][bj][m][n] = __builtin_amdgcn_mfma_f32_16x16x32_bf16(Bt[n][k], At[m][k], acc[ai][bj][m][n], 0, 0, 0); } } __builtin_amdgcn_s_setprio(0); } while (0)
#define PG8_WAIT_V(n) asm volatile("s_waitcnt vmcnt(" #n ")" ::: "memory")
#define PG8_WAIT_L(n) asm volatile("s_waitcnt lgkmcnt(" #n ")" ::: "memory")
#define PG8_BAR __builtin_amdgcn_s_barrier()
    Unit cur, nxt; int ui = 0;
    if (!S.next(0, cur)) return;
    f32x4 acc[2][2][4][2];
#pragma unroll
    for (int a = 0; a < 2; ++a)
#pragma unroll
        for (int b = 0; b < 2; ++b)
#pragma unroll
            for (int m = 0; m < 4; ++m)
#pragma unroll
                for (int n = 0; n < 2; ++n) acc[a][b][m][n] = (f32x4){0.f, 0.f, 0.f, 0.f};
    bf16x8 At[4][2], B0[2][2], B1[2][2]; v8i At8[4], B08[2], B18[2];
    const char* cA = (const char*)g.A + ((size_t)cur.arow * g.lda + cur.akoff) * 2; const char* cB = (const char*)g.Bt + ((size_t)cur.brow * g.ldb + (Sched::KSPLIT ? cur.akoff : 0)) * 2;
    PG8_STAGE(PG8_SB(0, 0), cB, voffB); PG8_STAGE(PG8_SB(0, 1), cB + hstepB, voffB); PG8_STAGE(PG8_SA(0, 0), cA, voffA); PG8_STAGE(PG8_SA(0, 1), cA + hstepA, voffA);
    if (wr == 1) PG8_BAR;
    PG8_WAIT_V(2); PG8_BAR;
    PG8_STAGE(PG8_SB(1, 0), cB + kstep, voffB); PG8_STAGE(PG8_SA(1, 0), cA + kstep, voffA); PG8_STAGE(PG8_SB(1, 1), cB + hstepB + kstep, voffB);
    PG8_WAIT_V(6); PG8_BAR;
    for (;;) {
        const bool has_next = S.next(ui + 1, nxt);
        const char* nA = has_next ? (const char*)g.A + ((size_t)nxt.arow * g.lda + nxt.akoff) * 2 : cA; const char* nB = has_next ? (const char*)g.Bt + ((size_t)nxt.brow * g.ldb + (Sched::KSPLIT ? nxt.akoff : 0)) * 2 : cB;
        const int ntc = (Sched::KSPLIT && cur.nt) ? cur.nt : nt;
        if constexpr (F8) {
#pragma unroll 1
            for (int t = 0; t < ntc; ++t) {
                const int b = t & 1; LAS unsigned char* lb = lds + b * (2 * HTB); LAS unsigned char* lo = lds + (b ^ 1) * (2 * HTB);
                const unsigned lbv = (unsigned)(uintptr_t)lb;
#define PG8_LDS32(dst, addr, imm) do { u32x4 lo_, hi_; asm volatile("ds_read_b128 %0, %2 offset:%3\n\tds_read_b128 %1, %2 offset:%4" : "=&v"(lo_), "=&v"(hi_) : "v"(addr), "i"(imm), "i"((imm) + 16) : "memory"); \
        dst = __builtin_bit_cast(v8i, __builtin_shufflevector(lo_, hi_, 0, 1, 2, 3, 4, 5, 6, 7)); } while (0)
                const char* s1 = (t + 1 < ntc) ? cA + (size_t)(t + 1) * kstep : nA + (size_t)(t + 1 - ntc) * kstep;
                const char* a2 = (t + 2 < ntc) ? cA + (size_t)(t + 2) * kstep : nA + (size_t)(t + 2 - ntc) * kstep;
                const char* b2 = (t + 2 < ntc) ? cB + (size_t)(t + 2) * kstep : nB + (size_t)(t + 2 - ntc) * kstep;
#define PG8_STAGE8(ldsdst, gbase, voff) do { _Pragma("unroll") for (int _i = 0; _i < 2; ++_i) \
        __builtin_amdgcn_global_load_lds((const unsigned*)((const char*)(gbase) + (voff)[_i]), (LAS unsigned*)((ldsdst) + ldsw + _i * 8192), 16, 0, 0); } while (0)
#pragma unroll
                for (int n = 0; n < 2; ++n) { PG8_LDS32(B08[n], lbv + (unsigned)(4 * HTB) + boff, n * 2048); PG8_LDS32(B18[n], lbv + (unsigned)(4 * HTB) + boff, HTB + n * 2048); }
                SBAR();
#pragma unroll
                for (int m = 0; m < 4; ++m) PG8_LDS32(At8[m], lbv + aoff, m * 2048);
                PG8_STAGE8(lo + HTB, s1 + hstepA, voffA);
                PG8_WAIT_V(8); PG8_WAIT_L(0); PG8_BAR; PG8_MMA(0, 0, At, B0); PG8_MMA(0, 1, At, B1); PG8_BAR; SBAR();
#pragma unroll
                for (int m = 0; m < 4; ++m) PG8_LDS32(At8[m], lbv + aoff, HTB + m * 2048);
                PG8_STAGE8(lb + 4 * HTB, b2, voffB); PG8_STAGE8(lb + 5 * HTB, b2 + hstepB, voffB); PG8_STAGE8(lb, a2, voffA);
                PG8_WAIT_V(8); PG8_WAIT_L(0); PG8_BAR; PG8_MMA(1, 0, At, B0); PG8_MMA(1, 1, At, B1); PG8_BAR; SBAR();
#undef PG8_STAGE8
#undef PG8_LDS32
            }
        } else
        for (int t = 0; t < ntc; t += 2) {
            const bool last = (t == ntc - 2);
            const char* a1 = cA + (size_t)(t + 1) * kstep;
            const char* a2 = last ? nA : cA + (size_t)(t + 2) * kstep; const char* b2 = last ? nB : cB + (size_t)(t + 2) * kstep;
            const char* a3 = a2 + kstep; const char* b3 = b2 + kstep;
            PG8_LDB(B0, 0, 0); PG8_LDB(B1, 0, 1); SBAR(); PG8_LDA(At, 0, 0); PG8_STAGE(PG8_SA(1, 1), a1 + hstepA, voffA);
            PG8_WAIT_V(8); PG8_WAIT_L(0); PG8_BAR; PG8_MMA(0, 0, At, B0); PG8_MMA(0, 1, At, B1); PG8_BAR; SBAR();
            PG8_LDA(At, 0, 1); PG8_STAGE(PG8_SB(0, 0), b2, voffB); PG8_STAGE(PG8_SB(0, 1), b2 + hstepB, voffB); PG8_STAGE(PG8_SA(0, 0), a2, voffA);
            PG8_WAIT_V(8); PG8_WAIT_L(0); PG8_BAR; PG8_MMA(1, 0, At, B0); PG8_MMA(1, 1, At, B1); PG8_BAR; SBAR();
            PG8_LDB(B0, 1, 0); PG8_LDB(B1, 1, 1); SBAR(); PG8_LDA(At, 1, 0); PG8_STAGE(PG8_SA(0, 1), a2 + hstepA, voffA);
            PG8_WAIT_V(8); PG8_WAIT_L(0); PG8_BAR; PG8_MMA(0, 0, At, B0); PG8_MMA(0, 1, At, B1); PG8_BAR; SBAR();
            PG8_LDA(At, 1, 1); PG8_STAGE(PG8_SB(1, 0), b3, voffB); PG8_STAGE(PG8_SB(1, 1), b3 + hstepB, voffB); PG8_STAGE(PG8_SA(1, 0), a3, voffA);
            PG8_WAIT_V(8); PG8_WAIT_L(0); PG8_BAR; PG8_MMA(1, 0, At, B0); PG8_MMA(1, 1, At, B1); PG8_BAR; SBAR();
        }
        if (wr == 0) PG8_BAR;
        { int t2 = tid; asm volatile("" : "+v"(t2));
          const int w2 = __builtin_amdgcn_readfirstlane(t2 >> 6), l2 = t2 & 63; E(acc, cur, w2 >> 2, w2 & 3, l2 & 15, l2 >> 4); }
        if (!has_next) break;
#pragma unroll
        for (int a = 0; a < 2; ++a)
#pragma unroll
            for (int b = 0; b < 2; ++b)
#pragma unroll
                for (int m = 0; m < 4; ++m)
#pragma unroll
                    for (int n = 0; n < 2; ++n) acc[a][b][m][n] = (f32x4){0.f, 0.f, 0.f, 0.f};
        cur = nxt; cA = nA; cB = nB; ++ui;
        if (wr == 1) PG8_BAR;
    }
    PG8_WAIT_V(0);
    PG8_BAR;
#undef PG8_SA
#undef PG8_SB
#undef PG8_STAGE
#undef PG8_LDA
#undef PG8_LDB
#undef PG8_MMA
#undef PG8_WAIT_V
#undef PG8_WAIT_L
#undef PG8_BAR
}
}
namespace att {
constexpr int D = 128, NW = 8, QBLK = 32, KVBLK = 64, QB = NW * QBLK;
constexpr int SHM_V = KVBLK * D * 2, SHM_K = KVBLK * D * 2;
constexpr int OFF_V = 0, OFF_K = 2 * SHM_V, OFF_WS = OFF_K + 2 * SHM_K, OFF_NCL = OFF_WS + NW * 64 * 4, OFF_LUT = OFF_NCL + (8192 + 256) * 4, OFF_KM = OFF_LUT + 1024, OFF_MISC = OFF_KM + 32 * 128 * 4, LDS_END = OFF_MISC + 256;
constexpr float SCALE = 0.08838834764831845f, LOG2E = 1.4426950408889634f, C2 = SCALE * LOG2E;
constexpr float THR2 = 8.f * LOG2E;
#define KSWZ(row, colB) ((row) * 256 + ((colB) ^ (((row) & 7) << 4)))
__device__ __forceinline__ int v_st(int k, int c) { const int kk = (k & ~0xC) | ((k & 4) << 1) | ((k & 8) >> 1); return ((kk >> 3) * 4 + (c >> 5)) * 512 + ((kk & 7) * 32 + (c & 31)) * 2; }
__device__ __forceinline__ int v_rd_base(int lane) { return ((lane & 3) << 3) | (((lane >> 2) & 3) << 6) | (((lane >> 4) & 1) << 5) | (((lane >> 5) & 1) << 8); }
constexpr int v_rd_off(int d0, int ks, int half) { return d0 * 512 + ks * 4096 + half * 2048; }
__device__ __forceinline__ int crow(int r, int hi) { return (r & 3) + 8 * (r >> 2) + 4 * hi; }
__device__ __forceinline__ bf16x8 load8(const bf16_t* p) { return *reinterpret_cast<const bf16x8*>(p); }

__device__ __forceinline__ void partialSM(f32x16& p0, f32x16& p1, float& m_reg, float& mn, float& alpha) {
    float pmax = p0[0];
#pragma unroll
    for (int r = 1; r < 16; ++r) pmax = fmaxf(pmax, p0[r]);
#pragma unroll
    for (int r = 0; r < 16; ++r) pmax = fmaxf(pmax, p1[r]);
    { auto rr = __builtin_amdgcn_permlane32_swap(__float_as_uint(pmax), __float_as_uint(pmax), false, false);
      pmax = fmaxf(__uint_as_float(rr[0]), __uint_as_float(rr[1])); }
    if (__builtin_expect(__all((pmax - m_reg) <= THR2), 1)) { mn = m_reg; alpha = 1.f; }
    else { mn = fmaxf(m_reg, pmax); alpha = __builtin_amdgcn_exp2f(m_reg - mn); m_reg = mn; }
#pragma unroll
    for (int r = 0; r < 16; ++r) p0[r] = p0[r] - mn;
#pragma unroll
    for (int r = 0; r < 16; ++r) p1[r] = p1[r] - mn;
#pragma unroll
    for (int r = 0; r < 16; ++r) p0[r] = __builtin_amdgcn_exp2f(p0[r]);
}
__device__ __forceinline__ void finishSM(f32x16& p0, f32x16& p1, float alpha, float& l_reg, bf16x8& pa0, bf16x8& pa1, bf16x8& pa2, bf16x8& pa3) {
#pragma unroll
    for (int r = 0; r < 16; ++r) p1[r] = __builtin_amdgcn_exp2f(p1[r]);
    float ps = 0;
#pragma unroll
    for (int r = 0; r < 16; ++r) ps += p0[r];
#pragma unroll
    for (int r = 0; r < 16; ++r) ps += p1[r];
    { auto rr = __builtin_amdgcn_permlane32_swap(__float_as_uint(ps), __float_as_uint(ps), false, false);
      ps = __uint_as_float(rr[0]) + __uint_as_float(rr[1]); }
    l_reg = l_reg * alpha + ps;
#define PK4(P, B_, OUT) do { unsigned a0 = cvt_pk_bf16(P[B_+0], P[B_+1]), a1 = cvt_pk_bf16(P[B_+2], P[B_+3]);                          \
        unsigned b0 = cvt_pk_bf16(P[B_+4], P[B_+5]), b1 = cvt_pk_bf16(P[B_+6], P[B_+7]);                                             \
        auto r0 = __builtin_amdgcn_permlane32_swap(a0, b0, false, false); auto r1 = __builtin_amdgcn_permlane32_swap(a1, b1, false, false); \
        u32x4 w = {r0[0], r1[0], r0[1], r1[1]}; OUT = *reinterpret_cast<bf16x8*>(&w); } while (0)
    PK4(p0, 0, pa0); PK4(p0, 8, pa1); PK4(p1, 0, pa2); PK4(p1, 8, pa3);
#undef PK4
}
template <int KB>
__device__ __forceinline__ void qkt(f32x16& p0, f32x16& p1, const char* K_lds, int r32, int hi, const bf16x8* qr) {
    p0 = f32x16{}; p1 = f32x16{};
    const char* kb[4];
#pragma unroll
    for (int dd = 0; dd < 4; ++dd) kb[dd] = K_lds + KB * SHM_K + KSWZ(r32, (dd * 16 + hi * 8) * 2);
#pragma unroll
    for (int d0 = 0; d0 < 8; ++d0) { const char* a = kb[d0 & 3] + (d0 >> 2) * 128;
        bf16x8 b0 = *reinterpret_cast<const bf16x8*>(a);
        bf16x8 b1 = *reinterpret_cast<const bf16x8*>(a + 32 * 256);
        p0 = __builtin_amdgcn_mfma_f32_32x32x16_bf16(b0, qr[d0], p0, 0, 0, 0);
        p1 = __builtin_amdgcn_mfma_f32_32x32x16_bf16(b1, qr[d0], p1, 0, 0, 0); }
}
template <int VB>
__device__ __forceinline__ void pv_tile(f32x16* o, int vb0, bf16x8 pa0, bf16x8 pa1, bf16x8 pa2, bf16x8 pa3) {
#define TRRD(dst, off) asm volatile("ds_read_b64_tr_b16 %0, %1 offset:%2" : "=&v"(dst) : "v"(vb0), "i"(off) : "memory")
#define PV_D0(d0) do { s16x4 l0, l1, l2, l3, h0, h1, h2, h3; constexpr int b_ = VB * SHM_V + v_rd_off(d0, 0, 0); \
        TRRD(l0, b_); TRRD(h0, b_ + 2048); TRRD(l1, b_ + 4096); TRRD(h1, b_ + 6144); TRRD(l2, b_ + 8192); TRRD(h2, b_ + 10240); TRRD(l3, b_ + 12288); TRRD(h3, b_ + 14336); \
        asm volatile("s_waitcnt lgkmcnt(0)" ::: "memory"); SBAR(); \
        o[d0] = __builtin_amdgcn_mfma_f32_32x32x16_bf16(pa0, (bf16x8){l0[0], l0[1], l0[2], l0[3], h0[0], h0[1], h0[2], h0[3]}, o[d0], 0, 0, 0);   \
        o[d0] = __builtin_amdgcn_mfma_f32_32x32x16_bf16(pa1, (bf16x8){l1[0], l1[1], l1[2], l1[3], h1[0], h1[1], h1[2], h1[3]}, o[d0], 0, 0, 0);   \
        o[d0] = __builtin_amdgcn_mfma_f32_32x32x16_bf16(pa2, (bf16x8){l2[0], l2[1], l2[2], l2[3], h2[0], h2[1], h2[2], h2[3]}, o[d0], 0, 0, 0);   \
        o[d0] = __builtin_amdgcn_mfma_f32_32x32x16_bf16(pa3, (bf16x8){l3[0], l3[1], l3[2], l3[3], h3[0], h3[1], h3[2], h3[3]}, o[d0], 0, 0, 0); } while (0)
    PV_D0(0); PV_D0(1); PV_D0(2); PV_D0(3);
#undef PV_D0
#undef TRRD
}

template <int VAR>
__device__ __forceinline__ void prep(f32x16& p0, f32x16& p1, int kb, int pos, int qlo, int hi, const LAS float* ncl, int nclbase, const LAS float* lut, unsigned selmask, float farL) {
    const float NEG = -__builtin_inff();
    if constexpr (VAR == 0) {
        if (kb + KVBLK - 1 > qlo) {
            const int dq = pos - kb - 4 * hi;
#pragma unroll
            for (int r = 0; r < 16; ++r) { const int c = (r & 3) + 8 * (r >> 2);
                if (dq - c < 0) p0[r] = NEG;
                if (dq - c - 32 < 0) p1[r] = NEG; }
        }
        const LAS float* nb = ncl + (kb - nclbase) + 4 * hi;
#pragma unroll
        for (int g = 0; g < 4; ++g) { const f32x4 b0 = *(const LAS f32x4*)(nb + 8 * g), b1 = *(const LAS f32x4*)(nb + 32 + 8 * g);
#pragma unroll
            for (int j = 0; j < 4; ++j) { p0[4 * g + j] = fmaf(p0[4 * g + j], C2, b0[j]); p1[4 * g + j] = fmaf(p1[4 * g + j], C2, b1[j]); }
            asm volatile("" ::: "memory"); }
    } else {
        const bool selb = (selmask >> (kb >> 8)) & 1u;
        if (kb + KVBLK - 1 + 128 <= qlo) {
            const float add = selb ? farL : NEG;
#pragma unroll
            for (int r = 0; r < 16; ++r) { p0[r] = fmaf(p0[r], C2, add); p1[r] = fmaf(p1[r], C2, add); }
        } else {
            const int dq = pos - kb - 4 * hi;
#pragma unroll
            for (int r = 0; r < 16; ++r) { const int c = (r & 3) + 8 * (r >> 2);
                const int d0 = dq - c, d1 = dq - c - 32;
                const float b0 = lut[d0 < 0 ? 0 : (d0 > 128 ? 128 : d0)], b1 = lut[d1 < 0 ? 0 : (d1 > 128 ? 128 : d1)];
                const float t0 = fmaf(p0[r], C2, b0), t1 = fmaf(p1[r], C2, b1);
                p0[r] = (d0 < 0 || !selb) ? NEG : t0; p1[r] = (d1 < 0 || !selb) ? NEG : t1;
                if ((r & 3) == 3) asm volatile("" ::: "memory"); }
        }
    }
}

template <int VAR, int OP>
__device__ __forceinline__ void attn_block(const bf16_t* Q, const bf16_t* Kh, const bf16_t* Vh, unsigned char* O, int P0, int j_lo, int j_hi, char* lds,
                                           const LAS float* ncl, int nclbase, const LAS float* lut, unsigned selmask, float farL, const bf16x8 (&qr)[8], const int tid) {
    const int wid = __builtin_amdgcn_readfirstlane(tid >> 6), lane = tid & 63, r32 = lane & 31, hi = lane >> 5;
    const int NT = j_hi - j_lo;
    const int qlo = P0 + wid * QBLK, pos = qlo + r32;
    char* V_lds = lds + OFF_V; char* K_lds = lds + OFF_K;
    float* ws = (float*)(lds + OFF_WS) + wid * 64; float* li_l = ws, * al_l = ws + 32;
    float m_reg = -1e30f, l_reg = 0; f32x16 o[4] = {};
    const int sr = tid >> 4, sc = (tid & 15) * 8, vst0 = v_st(sr, sc), vst1 = v_st(32 + sr, sc), kws = KSWZ(sr, sc * 2);
    const int vb0 = (int)(uintptr_t)V_lds + v_rd_base(lane);
    bf16x8 st_v0, st_v1, st_k0, st_k1;
#define ROW(p, k0, rr) ((p) + (size_t)((k0) + (rr)) * D + sc)
#define SLOAD_H(k0) do { st_v0 = load8(ROW(Vh, k0, sr)); st_v1 = load8(ROW(Vh, k0, 32 + sr)); st_k0 = load8(ROW(Kh, k0, sr)); st_k1 = load8(ROW(Kh, k0, 32 + sr)); } while (0)
#define SWRITE_HK(bf) do { *(bf16x8*)(K_lds + (bf) * SHM_K + kws) = st_k0; *(bf16x8*)(K_lds + (bf) * SHM_K + kws + 32 * 256) = st_k1; } while (0)
#define SWRITE_HV(bf) do { *(bf16x8*)(V_lds + (bf) * SHM_V + vst0) = st_v0; *(bf16x8*)(V_lds + (bf) * SHM_V + vst1) = st_v1; } while (0)
#define SWRITE_H(bf) do { SWRITE_HV(bf); SWRITE_HK(bf); } while (0)
#define RESC(a) do { if (__any((a) < 1.f)) { if (hi == 0) al_l[r32] = (a); asm volatile("s_waitcnt lgkmcnt(0)" ::: "memory");              \
                     for (int d_ = 0; d_ < 4; ++d_) for (int r = 0; r < 16; ++r) o[d_][r] *= al_l[crow(r, hi)]; } } while (0)
#define KBASE(t) ((j_lo + (t)) * KVBLK)
#define PREP(P0_, P1_, t) prep<VAR>(P0_, P1_, KBASE(t), pos, qlo, hi, ncl, nclbase, lut, selmask, farL)
    f32x16 pA0, pA1, pB0, pB1; float mnA, mnB, alA, alB; bf16x8 pa0, pa1, pa2, pa3;
    SLOAD_H(KBASE(0)); VM_WAIT(); SWRITE_H(0); SBAR();
    if (NT > 1) SLOAD_H(KBASE(1));
    __syncthreads();
    SBAR(); qkt<0>(pA0, pA1, K_lds, r32, hi, qr);
    PREP(pA0, pA1, 0); partialSM(pA0, pA1, m_reg, mnA, alA);
    if (NT > 1) { VM_WAIT(); SWRITE_H(1); }
    __syncthreads();
#define HALF_STEP(PX0, PX1, mnX, alX, PY0, PY1, alY, t, KB, VB, SB) do {                                                      \
        SBAR(); qkt<KB>(PX0, PX1, K_lds, r32, hi, qr);                                                                        \
        finishSM(PY0, PY1, alY, l_reg, pa0, pa1, pa2, pa3); SBAR();                                                           \
        if ((t) + 1 < NT) { SLOAD_H(KBASE((t) + 1)); SBAR(); }                                                                \
        pv_tile<VB>(o, vb0, pa0, pa1, pa2, pa3); PREP(PX0, PX1, (t)); partialSM(PX0, PX1, m_reg, mnX, alX);                   \
        __syncthreads();                                                                                                      \
        if ((t) + 1 < NT) { VM_WAIT(); SWRITE_H(SB); }                                                                        \
        RESC(alX); __syncthreads(); } while (0)
    for (int t = 1; t + 1 < NT; t += 2) {
        HALF_STEP(pB0, pB1, mnB, alB, pA0, pA1, alA, t, 1, 0, 0);
        HALF_STEP(pA0, pA1, mnA, alA, pB0, pB1, alB, t + 1, 0, 1, 1);
    }
    const bool even = (NT & 1) == 0;
    if (even) { SBAR(); qkt<1>(pB0, pB1, K_lds, r32, hi, qr); SBAR(); }
    finishSM(pA0, pA1, alA, l_reg, pa0, pa1, pa2, pa3); SBAR();
    pv_tile<0>(o, vb0, pa0, pa1, pa2, pa3);
    if (even) { PREP(pB0, pB1, NT - 1); partialSM(pB0, pB1, m_reg, mnB, alB); __syncthreads(); RESC(alB);
        finishSM(pB0, pB1, alB, l_reg, pa0, pa1, pa2, pa3); SBAR(); pv_tile<1>(o, vb0, pa0, pa1, pa2, pa3); }
    SBAR();
    if (hi == 0) li_l[r32] = l_reg; asm volatile("s_waitcnt lgkmcnt(0)" ::: "memory");
    float rli[16];
#pragma unroll
    for (int r = 0; r < 16; ++r) rli[r] = __builtin_amdgcn_rcpf(li_l[crow(r, hi)]);
    unsigned ob = (unsigned)((wid * QBLK + 4 * hi) * OP + r32);
    asm volatile("" : "+v"(ob));
    char* pb = (char*)O + ob;
#pragma unroll
    for (int r = 0; r < 16; ++r) { char* pr = pb + (size_t)((r & 3) + 8 * (r >> 2)) * OP;
#pragma unroll
        for (int d0 = 0; d0 < 4; ++d0) { const float v = o[d0][r] * (rli[r] * 16.0f);
            const float v1 = pg8::quad_xor1(v), v2 = pg8::quad_xor2(v), v3 = pg8::quad_xor3(v);
            if ((r32 & 3) == 0) *(unsigned*)(pr + d0 * 32) = pg8::pk4_fp8(v, v1, v2, v3); } }
    __syncthreads();
#undef ROW
#undef SLOAD_H
#undef SWRITE_HK
#undef SWRITE_HV
#undef SWRITE_H
#undef RESC
#undef KBASE
#undef PREP
#undef HALF_STEP
}
}
constexpr int NWAVES = 8, NTHREADS = 512;
constexpr int BATCH = 2, T = 8192, M = BATCH * T, DM = 2048;
constexpr int NQKV0 = 6144, WIN0_PITCH = 6152, FF0 = 5632, NIN1 = 1104, NIN1P = 1280, NQ1 = 9216, NEXP = 8, FFE = 7168;
constexpr int MAXROWS = 34816;
constexpr float ALPHA = 1.4142135623730951f;
constexpr float LN_EPS = 1e-5f, RMS_EPS = 1e-6f;
constexpr float LOG2E = 1.4426950408889634f;
constexpr size_t MiB = 1u << 20;
constexpr size_t WS_CTL = 0, CTL_ZERO_BYTES = 1 * MiB;
constexpr size_t WS_WIN0 = 2 * MiB, WS_WOUT0 = 26 * MiB, WS_WFF13 = 34 * MiB, WS_WFF2 = 78 * MiB, WS_WIN1 = 100 * MiB, WS_WQ1 = 105 * MiB, WS_WUV = 114 * MiB, WS_WOUT1 = 118 * MiB,
                 WS_WE13 = 126 * MiB, WS_WE2 = 574 * MiB, WS_XB = 798 * MiB, WS_SMALL = 862 * MiB, WS_BIG = 896 * MiB;
constexpr size_t SM_LOGF = WS_SMALL, SM_CL2 = SM_LOGF + (size_t)M * 8 * 4, SM_KMEAN = SM_CL2 + 16 * 8192 * 4, SM_QN = SM_KMEAN + 16 * 32 * 128 * 4, SM_KN = SM_QN + 16 * 32 * 4,
                 SM_WIDX = SM_KN + 16 * 32 * 4 + 3072, SM_KIDX = SM_WIDX + (size_t)M * 16 * 4, SM_RTE = SM_KIDX + (size_t)M * 64 * 2, SM_RTG = SM_RTE + (size_t)M * 2 * 4, SM_RTP = SM_RTG + (size_t)M * 2 * 4,
                 SM_ROW = SM_RTP + (size_t)M * 2 * 4, SM_SEL = SM_ROW + (size_t)M * 2 * 4, SM_STAT = SM_SEL + (size_t)M * 256 * 4, SM_END = SM_STAT + (size_t)M * 2 * 4;
static_assert(SM_END <= WS_BIG, "small region");
constexpr size_t B0_QKV = WS_BIG, B0_O = WS_BIG + 192 * MiB, B0_ACT = WS_BIG + 256 * MiB;
constexpr size_t B0_X8 = WS_BIG + 400 * MiB, B0_WV8 = WS_BIG + 440 * MiB;
constexpr size_t B1_PROJ = WS_BIG, B1_CQN = WS_BIG + 80 * MiB, B1_CKVN = WS_BIG + 96 * MiB, B1_QIDX = WS_BIG + 112 * MiB, B1_QLAT = WS_BIG + 144 * MiB, B1_SC = WS_BIG + 400 * MiB, B1_OB = WS_BIG;
constexpr size_t SC_PER_BATCH = (size_t)16384 * (64 * 65 / 2);
static_assert(B1_SC + 2 * SC_PER_BATCH * 4 <= WS_BIG + 662 * MiB, "scores");
constexpr size_t B1_XG = WS_BIG, B1_H = WS_BIG + 136 * MiB, B1_Y = WS_BIG;
constexpr size_t B1_SLAB = WS_BIG + 614 * MiB;
constexpr size_t WS_NEED = WS_BIG + 680 * MiB;
constexpr int CW_BAR = 4096, CW_CNT = 8192, CW_QIDX = 12288, CW_QTOPK = 12352, CW_FLAG = 16384;
constexpr int LDS_BYTES = 147456, SCR_BYTES = 143360, MISC_OFF = SCR_BYTES;

struct Args { const float* in[28]; float* out; unsigned char* ws; int ph_lo, ph_hi; };
struct Ctx {
    LAS unsigned char* lds; unsigned char* ldsg; unsigned char* ws; float* out;
    int tid, lane, wave, G, bid;
};

__device__ __forceinline__ void transpose_item(const float* W, int ldw, int Nsrc, int Ndst, bf16_t* WT, int ldt, int koff, int mode, int row_off, int zero_koff, LAS float* scr, int item, int lane) {
    const int nblk = Ndst / 32, kb = item / nblk, nb = item % nblk, k0 = 64 * kb, n0 = 32 * nb;
    const int ncol = n0 + (lane & 31); const bool ok = ncol < Nsrc;
    float tv[32];
#pragma unroll
    for (int i = 0; i < 32; ++i) { const int kk = 2 * i + (lane >> 5); tv[i] = ok ? W[(size_t)(k0 + kk) * ldw + ncol] : 0.f; }
#pragma unroll
    for (int i = 0; i < 32; ++i) { const int kk = 2 * i + (lane >> 5); scr[kk * 33 + (lane & 31)] = tv[i]; }
    LDS_WAIT(); asm volatile("" ::: "memory");
    const int c = lane & 7;
#pragma unroll
    for (int j = 0; j < 4; ++j) { const int n = (lane >> 3) + 8 * j; const LAS float* s = scr + (8 * c) * 33 + n;
        u32x4 o; o.x = pk2(s[0 * 33], s[1 * 33]); o.y = pk2(s[2 * 33], s[3 * 33]); o.z = pk2(s[4 * 33], s[5 * 33]); o.w = pk2(s[6 * 33], s[7 * 33]);
        const int nn = n0 + n; const int drow = mode ? ((nn >> 7) * 256 + row_off + (nn & 127)) : (row_off + nn);
        *(GAS u32x4*)(WT + (size_t)drow * ldt + koff + k0 + 8 * c) = o;
        if (zero_koff >= 0) *(GAS u32x4*)(WT + (size_t)drow * ldt + zero_koff + k0 + 8 * c) = (u32x4){0u, 0u, 0u, 0u}; }
    LDS_WAIT(); asm volatile("" ::: "memory");
}

__device__ __forceinline__ void transpose_item8(const float* W, int ldw, int Ndst, unsigned char* WT, int ldt, int mode, int row_off, LAS float* scr, int item, int lane, int koff = 0, int zero_koff = -1) {
    const int nblk = Ndst / 32, kb = item / nblk, nb = item % nblk, k0 = 64 * kb, n0 = 32 * nb;
    const int ncol = n0 + (lane & 31);
    float tv[32];
#pragma unroll
    for (int i = 0; i < 32; ++i) { const int kk = 2 * i + (lane >> 5); tv[i] = W[(size_t)(k0 + kk) * ldw + ncol]; }
#pragma unroll
    for (int i = 0; i < 32; ++i) { const int kk = 2 * i + (lane >> 5); scr[kk * 33 + (lane & 31)] = tv[i] * 64.0f; }
    LDS_WAIT(); asm volatile("" ::: "memory");
    const int c = lane & 7;
#pragma unroll
    for (int j = 0; j < 4; ++j) { const int n = (lane >> 3) + 8 * j; const LAS float* s = scr + (8 * c) * 33 + n;
        u32x2 o; o.x = pg8::pk4_fp8(s[0 * 33], s[1 * 33], s[2 * 33], s[3 * 33]); o.y = pg8::pk4_fp8(s[4 * 33], s[5 * 33], s[6 * 33], s[7 * 33]);
        const int nn = n0 + n; const int drow = mode ? ((nn >> 7) * 256 + row_off + (nn & 127)) : (row_off + nn);
        *(GAS u32x2*)(WT + (size_t)drow * ldt + koff + k0 + 8 * c) = o;
        if (zero_koff >= 0) *(GAS u32x2*)(WT + (size_t)drow * ldt + zero_koff + k0 + 8 * c) = (u32x2){0u, 0u}; }
    LDS_WAIT(); asm volatile("" ::: "memory");
}
template <bool F8>
__device__ __forceinline__ void transpose_tile(const float* W, int ldw, int Nsrc, void* WTv, int ldt, int koff, int mode, int row_off, int zero_koff, int k0, int n0, LAS float* tile, int tid) {
    constexpr int KT = F8 ? 128 : 64, NI = KT / 8;
    const int wv = tid >> 6, ln = tid & 63;
    float v[NI][4];
#pragma unroll
    for (int i = 0; i < NI; ++i)
#pragma unroll
        for (int e = 0; e < 4; ++e) { const int col = ln + 64 * e; v[i][e] = (n0 + col) < Nsrc ? W[(size_t)(k0 + wv + 8 * i) * ldw + n0 + col] : 0.f; }
#pragma unroll
    for (int i = 0; i < NI; ++i)
#pragma unroll
        for (int e = 0; e < 4; ++e) tile[(wv + 8 * i) * 257 + ln + 64 * e] = v[i][e];
    __syncthreads();
    const int c = tid & 7;
#pragma unroll
    for (int j = 0; j < 4; ++j) { const int n = (tid >> 3) + 64 * j; const int nn = n0 + n; const int drow = mode ? ((nn >> 7) * 256 + row_off + (nn & 127)) : (row_off + nn);
        if constexpr (F8) { const LAS float* s = tile + (16 * c) * 257 + n; u32x4 o;
            o.x = pg8::pk4_fp8(s[0 * 257] * 64.f, s[1 * 257] * 64.f, s[2 * 257] * 64.f, s[3 * 257] * 64.f); o.y = pg8::pk4_fp8(s[4 * 257] * 64.f, s[5 * 257] * 64.f, s[6 * 257] * 64.f, s[7 * 257] * 64.f);
            o.z = pg8::pk4_fp8(s[8 * 257] * 64.f, s[9 * 257] * 64.f, s[10 * 257] * 64.f, s[11 * 257] * 64.f); o.w = pg8::pk4_fp8(s[12 * 257] * 64.f, s[13 * 257] * 64.f, s[14 * 257] * 64.f, s[15 * 257] * 64.f);
            *(GAS u32x4*)((unsigned char*)WTv + (size_t)drow * ldt + koff + k0 + 16 * c) = o; }
        else { const LAS float* s = tile + (8 * c) * 257 + n; u32x4 o;
            o.x = pk2(s[0 * 257], s[1 * 257]); o.y = pk2(s[2 * 257], s[3 * 257]); o.z = pk2(s[4 * 257], s[5 * 257]); o.w = pk2(s[6 * 257], s[7 * 257]);
            *(GAS u32x4*)((bf16_t*)WTv + (size_t)drow * ldt + koff + k0 + 8 * c) = o;
            if (zero_koff >= 0) *(GAS u32x4*)((bf16_t*)WTv + (size_t)drow * ldt + zero_koff + k0 + 8 * c) = (u32x4){0u, 0u, 0u, 0u}; } }
    __syncthreads();
}
struct ProIn { const float *x, *w_in0, *b_forget, *w_out0, *w1, *w3, *w2, *w_in1, *w_uq, *w_qidx, *w_uk, *w_uv, *w_out1, *e1, *e3, *e2; };
__device__ __forceinline__ void phase_prologue(const Ctx& F, const ProIn& I) {
    LAS float* scr = (LAS float*)(F.lds + F.wave * 8448);
    LAS float* wf = (LAS float*)(F.lds + 69632);
    const int gw = F.bid * NWAVES + F.wave, NGW = F.G * NWAVES;
    unsigned char* ws = F.ws;
    for (int i = F.tid; i < 8 * 2048; i += NTHREADS) { const int j = i & 7, k = i >> 3; wf[j * 2048 + k] = I.w_in0[(size_t)k * WIN0_PITCH + 6144 + j]; }
    __syncthreads();
    for (int m = gw; m < M; m += NGW) {
        const GAS f32x4* xr = (const GAS f32x4*)(I.x + (size_t)m * DM) + F.lane;
        f32x4 v[8];
#pragma unroll
        for (int j = 0; j < 8; ++j) v[j] = xr[64 * j];
        GAS u32x2* o8 = (GAS u32x2*)((bf16_t*)(ws + WS_XB) + (size_t)m * DM) + F.lane;
#pragma unroll
        for (int j = 0; j < 8; ++j) { u32x2 w; w.x = pk2(v[j][0], v[j][1]); w.y = pk2(v[j][2], v[j][3]); o8[64 * j] = w; }
        { GAS unsigned* x8 = (GAS unsigned*)(ws + B0_X8 + (size_t)m * DM) + F.lane;
#pragma unroll
          for (int j = 0; j < 8; ++j) x8[64 * j] = pg8::pk4_fp8(v[j][0] * 8.f, v[j][1] * 8.f, v[j][2] * 8.f, v[j][3] * 8.f); }
        float z = 0.f;
#pragma unroll 1
        for (int h = 0; h < 8; ++h) { float s = 0.f;
#pragma unroll
            for (int j = 0; j < 8; ++j) { const f32x4 w = *(const LAS f32x4*)(wf + h * 2048 + 256 * j + 4 * F.lane); s += v[j][0] * w[0] + v[j][1] * w[1] + v[j][2] * w[2] + v[j][3] * w[3]; }
            s = wave_sum(s); z = (F.lane == h) ? s : z; }
        if (F.lane < 8) {
            z += I.b_forget[F.lane];
            const float lf = z >= 0.f ? -log1pf(expf(-z)) : z - log1pf(expf(z));
            ((float*)(ws + SM_LOGF))[(size_t)m * 8 + F.lane] = lf; }
    }
    __syncthreads();
    {
        LAS float* tile = (LAS float*)F.lds;
        unsigned char* const W_IN0 = ws + WS_WIN0; unsigned char* const W_OUT0 = ws + WS_WOUT0; unsigned char* const W_FF13 = ws + WS_WFF13; unsigned char* const W_FF2 = ws + WS_WFF2;
        unsigned char* const W_IN1 = ws + WS_WIN1; unsigned char* const W_Q1 = ws + WS_WQ1; unsigned char* const W_OUT1 = ws + WS_WOUT1;
        unsigned char* const W_E13 = ws + WS_WE13; unsigned char* const W_E2 = ws + WS_WE2;
        constexpr int T_IN0 = (2048 / 128) * (6144 / 128), T_SQ = (2048 / 128) * (2048 / 128), T_FF = (2048 / 128) * (FF0 / 128), T_FF2 = (FF0 / 128) * (2048 / 128), T_IN1 = (2048 / 128) * (NIN1P / 128),
                      T_QI = (512 / 128) * (1024 / 128), T_E = (2048 / 128) * (FFE / 128), T_E2 = (FFE / 128) * (2048 / 128);
        constexpr int TOT0 = 8 * (2 * T_E + T_E2) + 2 * T_FF + T_FF2 + T_IN0 + 2 * T_SQ + T_IN1 + T_QI, TOT = TOT0 + T_SQ;
#define TILE_DECODE(it_, Wp, ldw_, Nsrc_, Dp, ldt_, f8_, mode_, roff_, k0_, n0_) do { int r = (it_); \
            if (r < 8 * T_E) { const int e = r / T_E, rr = r % T_E, nb = FFE / 128; Wp = I.e1 + (size_t)e * 2048 * FFE; ldw_ = FFE; Nsrc_ = FFE; Dp = W_E13 + (size_t)e * 2 * FFE * 2048; ldt_ = 2048; f8_ = 1; mode_ = 1; roff_ = 0; k0_ = 128 * (rr / nb); n0_ = 128 * (rr % nb); break; } r -= 8 * T_E; \
            if (r < 8 * T_E) { const int e = r / T_E, rr = r % T_E, nb = FFE / 128; Wp = I.e3 + (size_t)e * 2048 * FFE; ldw_ = FFE; Nsrc_ = FFE; Dp = W_E13 + (size_t)e * 2 * FFE * 2048; ldt_ = 2048; f8_ = 1; mode_ = 1; roff_ = 128; k0_ = 128 * (rr / nb); n0_ = 128 * (rr % nb); break; } r -= 8 * T_E; \
            if (r < 8 * T_E2) { const int e = r / T_E2, rr = r % T_E2, nb = 2048 / 128; Wp = I.e2 + (size_t)e * FFE * 2048; ldw_ = 2048; Nsrc_ = 2048; Dp = W_E2 + (size_t)e * 2048 * FFE; ldt_ = FFE; f8_ = 1; mode_ = 0; roff_ = 0; k0_ = 128 * (rr / nb); n0_ = 128 * (rr % nb); break; } r -= 8 * T_E2; \
            if (r < T_FF) { const int nb = FF0 / 128; Wp = I.w1; ldw_ = FF0; Nsrc_ = FF0; Dp = W_FF13; ldt_ = 2048; f8_ = 1; mode_ = 1; roff_ = 0; k0_ = 128 * (r / nb); n0_ = 128 * (r % nb); break; } r -= T_FF; \
            if (r < T_FF) { const int nb = FF0 / 128; Wp = I.w3; ldw_ = FF0; Nsrc_ = FF0; Dp = W_FF13; ldt_ = 2048; f8_ = 1; mode_ = 1; roff_ = 128; k0_ = 128 * (r / nb); n0_ = 128 * (r % nb); break; } r -= T_FF; \
            if (r < T_FF2) { const int nb = 2048 / 128; Wp = I.w2; ldw_ = 2048; Nsrc_ = 2048; Dp = W_FF2; ldt_ = FF0; f8_ = 1; mode_ = 0; roff_ = 0; k0_ = 128 * (r / nb); n0_ = 128 * (r % nb); break; } r -= T_FF2; \
            if (r < T_IN0) { const int nb = 6144 / 128; Wp = I.w_in0; ldw_ = WIN0_PITCH; Nsrc_ = 6144; Dp = W_IN0; ldt_ = 2048; f8_ = 0; mode_ = 0; roff_ = 0; k0_ = 128 * (r / nb); n0_ = 128 * (r % nb); break; } r -= T_IN0; \
            if (r < T_SQ) { const int nb = 2048 / 128; Wp = I.w_out0; ldw_ = 2048; Nsrc_ = 2048; Dp = W_OUT0; ldt_ = 2048; f8_ = 1; mode_ = 0; roff_ = 0; k0_ = 128 * (r / nb); n0_ = 128 * (r % nb); break; } r -= T_SQ; \
            if (r < T_SQ) { const int nb = 2048 / 128; Wp = I.w_out1; ldw_ = 2048; Nsrc_ = 2048; Dp = W_OUT1; ldt_ = 2048; f8_ = 1; mode_ = 0; roff_ = 0; k0_ = 128 * (r / nb); n0_ = 128 * (r % nb); break; } r -= T_SQ; \
            if (r < T_IN1) { const int nb = NIN1P / 128; Wp = I.w_in1; ldw_ = NIN1; Nsrc_ = NIN1; Dp = W_IN1; ldt_ = 2048; f8_ = 0; mode_ = 0; roff_ = 0; k0_ = 128 * (r / nb); n0_ = 128 * (r % nb); break; } r -= T_IN1; \
            if (r < T_QI) { const int nb = 1024 / 128; Wp = I.w_qidx; ldw_ = 1024; Nsrc_ = 1024; Dp = W_Q1; ldt_ = 512; f8_ = 0; mode_ = 0; roff_ = 8192; k0_ = 128 * (r / nb); n0_ = 128 * (r % nb); break; } r -= T_QI; \
            { const int nb = 16, nbi = r % nb; Wp = I.w_in0 + (nbi < 8 ? 2048 : 5120 - 1024); ldw_ = WIN0_PITCH; Nsrc_ = 1 << 30; Dp = ws + B0_WV8; ldt_ = 2048; f8_ = 1; mode_ = 0; roff_ = 0; k0_ = 128 * (r / nb); n0_ = 128 * nbi; } } while (0)
        const int tid = F.tid;
        f32x4 va[2][4], vb[2][4];
        const int nb4 = tid & 31, kbb = tid >> 5;
        constexpr int T0_F8END = 8 * (2 * T_E + T_E2) + 2 * T_FF + T_FF2;
#define TILE_F8(it_) ((it_) < T0_F8END || ((it_) >= T0_F8END + T_IN0 && (it_) < T0_F8END + T_IN0 + 2 * T_SQ) || (it_) >= TOT0)
#define TILE_LOAD(v, it_) do { const float* Wp; unsigned char* Dp; int ldw_, Nsrc_, ldt_, f8_, mode_, roff_, k0_, n0_; TILE_DECODE(it_, Wp, ldw_, Nsrc_, Dp, ldt_, f8_, mode_, roff_, k0_, n0_); (void)Dp; (void)ldt_; (void)f8_; (void)mode_; (void)roff_; \
            int col = n0_ + 4 * nb4; col = col < Nsrc_ ? col : 0;        \
            _Pragma("unroll") for (int j = 0; j < 2; ++j) { const float* rp_ = Wp + (size_t)(k0_ + 4 * (kbb + 16 * j)) * ldw_ + col; \
                _Pragma("unroll") for (int r_ = 0; r_ < 4; ++r_) v[j][r_] = *(const f32x4*)(rp_ + (size_t)r_ * ldw_); } } while (0)
#define TILE_TO_LDS(v, buf_, it_) do { LAS unsigned char* ob_ = (buf_); \
            if (TILE_F8(it_)) { _Pragma("unroll") for (int j = 0; j < 2; ++j) _Pragma("unroll") for (int e = 0; e < 4; ++e) \
                    *(LAS unsigned*)(ob_ + (4 * nb4 + e) * 144 + 4 * (kbb + 16 * j)) = pg8::pk4_fp8(v[j][0][e] * 64.f, v[j][1][e] * 64.f, v[j][2][e] * 64.f, v[j][3][e] * 64.f); } \
            else { _Pragma("unroll") for (int j = 0; j < 2; ++j) _Pragma("unroll") for (int e = 0; e < 4; ++e) { u32x2 w_; w_.x = pk2(v[j][0][e], v[j][1][e]); w_.y = pk2(v[j][2][e], v[j][3][e]); \
                    *(LAS u32x2*)(ob_ + (4 * nb4 + e) * 272 + 8 * (kbb + 16 * j)) = w_; } } } while (0)
#define TILE_EMIT(buf_, it_) do { const float* Wp; unsigned char* Dp; int ldw_, Nsrc_, ldt_, f8_, mode_, roff_, k0_, n0_; TILE_DECODE(it_, Wp, ldw_, Nsrc_, Dp, ldt_, f8_, mode_, roff_, k0_, n0_); (void)Wp; (void)ldw_; (void)Nsrc_; \
            const LAS unsigned char* ib_ = (buf_); \
            if (f8_) { const int c = tid & 7;                     \
                _Pragma("unroll") for (int j = 0; j < 2; ++j) { const int n = (tid >> 3) + 64 * j, nn = n0_ + n; const int drow = mode_ ? ((nn >> 7) * 256 + roff_ + (nn & 127)) : (roff_ + nn); \
                    *(GAS u32x4*)(Dp + (size_t)drow * ldt_ + k0_ + 16 * c) = *(const LAS u32x4*)(ib_ + n * 144 + 16 * c); } } \
            else { const int c = tid & 15;                       \
                _Pragma("unroll") for (int j = 0; j < 4; ++j) { const int n = (tid >> 4) + 32 * j, nn = n0_ + n; const int drow = roff_ + nn; \
                    *(GAS u32x4*)(Dp + ((size_t)drow * ldt_ + k0_ + 8 * c) * 2) = *(const LAS u32x4*)(ib_ + n * 272 + 16 * c); } } } while (0)
        LAS unsigned char* const buf0 = F.lds; LAS unsigned char* const buf1 = F.lds + 36864;
        const int G2 = 2 * F.G;
        if (F.bid < TOT) TILE_LOAD(va, F.bid);
        if (F.bid + F.G < TOT) TILE_LOAD(vb, F.bid + F.G);
        for (int it = F.bid; it < TOT; it += G2) {
            TILE_TO_LDS(va, buf0, it);
            if (it + G2 < TOT) TILE_LOAD(va, it + G2);
            __syncthreads();
            TILE_EMIT(buf0, it);
            if (it + F.G < TOT) {
                TILE_TO_LDS(vb, buf1, it + F.G);
                if (it + F.G + G2 < TOT) TILE_LOAD(vb, it + F.G + G2);
                __syncthreads();
                TILE_EMIT(buf1, it + F.G);
            }
        }
        __syncthreads();
#undef TILE_TO_LDS
#undef TILE_EMIT
#undef TILE_F8
#undef TILE_LOAD
#undef TILE_DECODE
        bf16_t* const W_UV = (bf16_t*)(ws + WS_WUV);
        { LAS float* scr = (LAS float*)(F.lds + F.wave * 8448); constexpr int I_UV = (512 / 64) * (128 / 32);
          for (int it = gw; it < 16 * I_UV; it += NGW) { const int h = it / I_UV, rr = it % I_UV;
              transpose_item8(I.w_uv + (size_t)h * 512 * 128, 128, 128, (unsigned char*)W_UV, 1024, 0, h * 128, scr, rr, F.lane, (h & 1) * 512, ((h & 1) ^ 1) * 512); } }
    }
    {
        const float* wuq = I.w_uq; const float* wuk = I.w_uk; bf16_t* WQ = (bf16_t*)(ws + WS_WQ1);
        constexpr float C2s = 0.08838834764831845f * LOG2E;
        const int l15 = F.lane & 15, l4 = F.lane >> 4;
        for (int it = gw; it < 16 * 16 * 16; it += NGW) {
            const int h = it >> 8, rt = (it >> 4) & 15, jt = it & 15;
            f32x4 acc[2][2] = {};
            const float* ap = wuk + ((size_t)h * 512 + rt * 32 + l15) * 128 + 4 * l4;
            const float* bp = wuq + (size_t)(jt * 32 + l15) * 2048 + h * 128 + 4 * l4;
#pragma unroll 2
            for (int J = 0; J < 8; ++J) {
                const f32x4 a0 = *(const f32x4*)(ap + 16 * J), a1 = *(const f32x4*)(ap + 16 * 128 + 16 * J), b0 = *(const f32x4*)(bp + 16 * J), b1 = *(const f32x4*)(bp + (size_t)16 * 2048 + 16 * J);
#pragma unroll
                for (int e = 0; e < 4; ++e) {
                    acc[0][0] = __builtin_amdgcn_mfma_f32_16x16x4f32(a0[e], b0[e], acc[0][0], 0, 0, 0); acc[0][1] = __builtin_amdgcn_mfma_f32_16x16x4f32(a0[e], b1[e], acc[0][1], 0, 0, 0);
                    acc[1][0] = __builtin_amdgcn_mfma_f32_16x16x4f32(a1[e], b0[e], acc[1][0], 0, 0, 0); acc[1][1] = __builtin_amdgcn_mfma_f32_16x16x4f32(a1[e], b1[e], acc[1][1], 0, 0, 0); }
            }
#pragma unroll
            for (int a = 0; a < 2; ++a)
#pragma unroll
                for (int b = 0; b < 2; ++b)
#pragma unroll
                    for (int e = 0; e < 4; ++e) { const int r = rt * 32 + a * 16 + l4 * 4 + e, j = jt * 32 + b * 16 + l15;
                        WQ[(size_t)(h * 512 + r) * 512 + j] = (bf16_t)f2bf(acc[a][b][e] * C2s); }
        }
    }
}

__device__ __forceinline__ void phase_pre0(const Ctx& F) {
    unsigned char* ws = F.ws;
    LAS float* red = (LAS float*)F.lds;
    for (int job = F.bid; job < 16 + 256; job += F.G) {
        if (job < 16) {
            const int b = job >> 3, h = job & 7; const float* lf = (const float*)(ws + SM_LOGF) + (size_t)b * T * 8 + h;
            float v[16]; float s = 0.f;
#pragma unroll
            for (int i = 0; i < 16; ++i) { s += lf[(size_t)(F.tid * 16 + i) * 8]; v[i] = s; }
            float inc = s;
#pragma unroll
            for (int o = 1; o < 64; o <<= 1) { const float t = __shfl_up(inc, o); if (F.lane >= o) inc += t; }
            if (F.lane == 63) red[F.wave] = inc;
            __syncthreads();
            float base = 0.f;
            for (int w = 0; w < F.wave; ++w) base += red[w];
            base += inc - s;
            float* cl = (float*)(ws + SM_CL2) + (size_t)job * 8192 + F.tid * 16;
#pragma unroll
            for (int i = 0; i < 16; ++i) cl[i] = (base + v[i]) * LOG2E;
            __syncthreads();
        } else {
            const int jj = job - 16;
            for (int half = 0; half < 2; ++half) {
                const int bh = jj >> 4, blk = (jj & 15) * 2 + half;
                const bf16_t* kA = (const bf16_t*)(ws + B0_QKV) + ((size_t)(1 * 16 + bh) * 8192 + blk * 256) * 128;
                const bf16_t* qB = (const bf16_t*)(ws + B0_QKV) + ((size_t)(3 * 16 + bh) * 8192 + blk * 256) * 128;
                const bf16_t* kB = (const bf16_t*)(ws + B0_QKV) + ((size_t)(4 * 16 + bh) * 8192 + blk * 256) * 128;
                const int rg = F.tid >> 4, c8 = F.tid & 15;
                float cs[8] = {0, 0, 0, 0, 0, 0, 0, 0}; float qm = 0.f, km = 0.f;
                for (int i = 0; i < 8; ++i) { const int row = rg * 8 + i;
                    const u32x4 a = *(const u32x4*)(kA + (size_t)row * 128 + c8 * 8), q = *(const u32x4*)(qB + (size_t)row * 128 + c8 * 8), k = *(const u32x4*)(kB + (size_t)row * 128 + c8 * 8);
                    float sq = 0.f, sk = 0.f;
#pragma unroll
                    for (int e = 0; e < 4; ++e) { cs[2 * e] += bflo(a[e]); cs[2 * e + 1] += bfhi(a[e]);
                        sq += bflo(q[e]) * bflo(q[e]) + bfhi(q[e]) * bfhi(q[e]); sk += bflo(k[e]) * bflo(k[e]) + bfhi(k[e]) * bfhi(k[e]); }
#pragma unroll
                    for (int o = 1; o < 16; o <<= 1) { sq += __shfl_xor(sq, o); sk += __shfl_xor(sk, o); }
                    qm = fmaxf(qm, sq); km = fmaxf(km, sk); }
#pragma unroll
                for (int e = 0; e < 8; ++e) red[rg * 128 + c8 * 8 + e] = cs[e];
                qm = wave_max(qm); km = wave_max(km);
                if (F.lane == 0) { red[4096 + F.wave] = qm; red[4096 + 8 + F.wave] = km; }
                __syncthreads();
                if (F.tid < 128) { float s = 0.f; for (int g = 0; g < 32; ++g) s += red[g * 128 + F.tid]; ((float*)(ws + SM_KMEAN))[((size_t)bh * 32 + blk) * 128 + F.tid] = s * (1.0f / 256.0f); }
                if (F.tid == 128) { float a = 0.f, k = 0.f; for (int w = 0; w < 8; ++w) { a = fmaxf(a, red[4096 + w]); k = fmaxf(k, red[4096 + 8 + w]); }
                    ((float*)(ws + SM_QN))[bh * 32 + blk] = a; ((float*)(ws + SM_KN))[bh * 32 + blk] = k; }
                __syncthreads();
            }
        }
    }
}

__device__ __forceinline__ int rel_bucket_dev(int n) {
    if (n < 16) return n;
    const int l = 16 + (int)(logf((float)n / 16.0f) / 2.0794415416798357f * 16.0f);
    return l > 31 ? 31 : l;
}

#define ATT_COMMON() \
    unsigned char* ws = F.ws; char* lds = (char*)F.ldsg; \
    const bf16_t* QKV = (const bf16_t*)(ws + B0_QKV); unsigned char* O = ws + B0_O; \
    LAS float* ncl = (LAS float*)(F.lds + att::OFF_NCL); LAS float* lut = (LAS float*)(F.lds + att::OFF_LUT); LAS float* kmL = (LAS float*)(F.lds + att::OFF_KM); LAS int* misc = (LAS int*)(F.lds + att::OFF_MISC); \
    const size_t TSTR = (size_t)16 * 8192 * 128; \
    const int tid0 = F.tid;
#define ATT_LANE() int tid = tid0; asm volatile("" : "+v"(tid)); const int wid = __builtin_amdgcn_readfirstlane(tid >> 6), lane = tid & 63, r32 = lane & 31, hi = lane >> 5;
__device__ __forceinline__ void phase_attn0_moba(const Ctx& F, const float* tab) {
    ATT_COMMON()
    for (int u = F.bid; u < 256; u += F.G) {
        const int bh = u >> 4, b = bh >> 3, h = bh & 7;
        for (int i = tid0; i < 129; i += NTHREADS) lut[i] = tab[rel_bucket_dev(i) * 16 + h] * LOG2E;
        const float farL = tab[31 * 16 + h] * LOG2E;
        for (int pass = 0; pass < 2; ++pass) {
            ATT_LANE()
            const int qb = pass ? 31 - (u & 15) : (u & 15), P0 = qb * 256;
            const bf16_t* Qp = QKV + 0 * TSTR + ((size_t)bh * 8192 + P0) * 128; const bf16_t* Kh = QKV + 1 * TSTR + (size_t)bh * 8192 * 128; const bf16_t* Vh = QKV + 2 * TSTR + (size_t)bh * 8192 * 128;
            for (int i = tid; i < qb * 128; i += NTHREADS) kmL[i] = ((const float*)(ws + SM_KMEAN))[(size_t)bh * 32 * 128 + i];
            bf16x8 qr[8];
#pragma unroll
            for (int d0 = 0; d0 < 8; ++d0) qr[d0] = att::load8(Qp + (size_t)(wid * 32 + r32) * 128 + d0 * 16 + hi * 8);
            __syncthreads();
            float g1 = -__builtin_inff(), g2 = g1, g3 = g1; int i1 = -1, i2 = -1, i3 = -1;
            for (int blk = 0; blk < qb; ++blk) {
                float g = 0.f; const LAS float* km = kmL + blk * 128 + hi * 8;
#pragma unroll
                for (int d0 = 0; d0 < 8; ++d0) { const f32x4 k0 = *(const LAS f32x4*)(km + d0 * 16), k1 = *(const LAS f32x4*)(km + d0 * 16 + 4); const u32x4 q = *reinterpret_cast<const u32x4*>(&qr[d0]);
                    g += bflo(q[0]) * k0[0] + bfhi(q[0]) * k0[1] + bflo(q[1]) * k0[2] + bfhi(q[1]) * k0[3] + bflo(q[2]) * k1[0] + bfhi(q[2]) * k1[1] + bflo(q[3]) * k1[2] + bfhi(q[3]) * k1[3]; }
                g += __shfl_xor(g, 32);
                if (g > g1) { g3 = g2; i3 = i2; g2 = g1; i2 = i1; g1 = g; i1 = blk; }
                else if (g > g2) { g3 = g2; i3 = i2; g2 = g; i2 = blk; }
                else if (g > g3) { g3 = g; i3 = blk; }
            }
            unsigned selmask = 1u << qb;
            if (i1 >= 0) selmask |= 1u << i1; if (i2 >= 0) selmask |= 1u << i2; if (i3 >= 0) selmask |= 1u << i3;
            att::attn_block<1, 2048>(Qp, Kh, Vh, O + ((size_t)b * 8192 + P0) * 2048 + h * 128, P0, 0, (P0 + 255) / 64 + 1, lds, ncl, 0, lut, selmask, farL, qr, tid);
        }
    }
}
__device__ __forceinline__ void phase_attn0_fox(const Ctx& F) {
    ATT_COMMON()
    for (int u = F.bid; u < 512; u += F.G) {
        ATT_LANE()
        const int bh = u >> 5, b = bh >> 3, h = bh & 7, qb = 31 - (u & 31), P0 = qb * 256;
        const float* cl2 = (const float*)(ws + SM_CL2) + (size_t)bh * 8192;
        const bf16_t* Qp = QKV + 3 * TSTR + ((size_t)bh * 8192 + P0) * 128; const bf16_t* Kh = QKV + 4 * TSTR + (size_t)bh * 8192 * 128; const bf16_t* Vh = QKV + 5 * TSTR + (size_t)bh * 8192 * 128;
        const float ref = cl2[P0];
        if (wid == 0) {
            float kmax = 0.f; for (int i = lane; i <= qb; i += 64) kmax = fmaxf(kmax, ((const float*)(ws + SM_KN))[bh * 32 + i]);
            kmax = wave_max(kmax);
            const float qmax = ((const float*)(ws + SM_QN))[bh * 32 + qb];
            const float B2 = (105.0f + 2.0f * sqrtf(qmax * kmax) * att::SCALE * 1.0001f) * LOG2E;
            const int ntile = P0 / 64; int first = ntile;
            for (int base = 0; base < ntile; base += 64) { const int J = base + lane; const bool need = (J < ntile) && (cl2[64 * J + 63] - ref <= B2);
                const unsigned long long bal = __ballot(need); if (bal) { first = base + __builtin_ctzll(bal); break; } }
            if (lane == 0) misc[0] = first;
        }
        bf16x8 qr[8];
#pragma unroll
        for (int d0 = 0; d0 < 8; ++d0) qr[d0] = att::load8(Qp + (size_t)(wid * 32 + r32) * 128 + d0 * 16 + hi * 8);
        __syncthreads();
        const int j_lo = __builtin_amdgcn_readfirstlane(misc[0]), nclbase = j_lo * 64;
        for (int k = nclbase + tid; k < P0 + 256; k += NTHREADS) ncl[k - nclbase] = ref - cl2[k];
        att::attn_block<0, 2048>(Qp, Kh, Vh, O + ((size_t)b * 8192 + P0) * 2048 + 1024 + h * 128, P0, j_lo, (P0 + 255) / 64 + 1, lds, ncl, nclbase, lut, 0u, 0.f, qr, tid);
    }
}

__device__ __forceinline__ void ln_row(const f32x4 (&v)[8], const float* g, const float* bta, int lane, f32x4 (&y)[8], float* stat = nullptr) {
    float s = 0.f;
#pragma unroll
    for (int j = 0; j < 8; ++j) s += (v[j][0] + v[j][1]) + (v[j][2] + v[j][3]);
    const float mean = wave_sum(s) * (1.f / DM); float s2 = 0.f;
#pragma unroll
    for (int j = 0; j < 8; ++j) { const f32x4 d = v[j] - mean; s2 += (d[0] * d[0] + d[1] * d[1]) + (d[2] * d[2] + d[3] * d[3]); }
    const float rstd = 1.0f / sqrtf(wave_sum(s2) * (1.f / DM) + LN_EPS);
    if (stat != nullptr && lane == 0) { stat[0] = mean; stat[1] = rstd; }
#pragma unroll
    for (int j = 0; j < 8; ++j) { const f32x4 gg = *(const f32x4*)(g + 256 * j + 4 * lane), bb = *(const f32x4*)(bta + 256 * j + 4 * lane); y[j] = (v[j] - mean) * rstd * gg + bb; }
}
template <bool OUT8>
__device__ __forceinline__ void phase_ln(const Ctx& F, const float* g, const float* bta) {
    const int gw = F.bid * NWAVES + F.wave, NGW = F.G * NWAVES;
    for (int m = gw; m < M; m += NGW) {
        GAS f32x4* xr = (GAS f32x4*)(F.out + (size_t)m * DM) + F.lane;
        f32x4 v[8], y[8];
#pragma unroll
        for (int j = 0; j < 8; ++j) v[j] = xr[64 * j];
        ln_row(v, g, bta, F.lane, y, (float*)(F.ws + SM_STAT) + 2 * (size_t)m);
        if constexpr (OUT8) { GAS unsigned* o8 = (GAS unsigned*)(F.ws + WS_XB + (size_t)m * DM) + F.lane;
#pragma unroll
            for (int j = 0; j < 8; ++j) o8[64 * j] = pg8::pk4_fp8(y[j][0], y[j][1], y[j][2], y[j][3]); }
        else { GAS u32x2* o8 = (GAS u32x2*)((bf16_t*)(F.ws + WS_XB) + (size_t)m * DM) + F.lane;
#pragma unroll
            for (int j = 0; j < 8; ++j) { u32x2 w; w.x = pk2(y[j][0], y[j][1]); w.y = pk2(y[j][2], y[j][3]); o8[64 * j] = w; } }
    }
}
__device__ __forceinline__ void phase_ln_router(const Ctx& F, const float* g, const float* bta, const float* router) {
    const int gw = F.bid * NWAVES + F.wave, NGW = F.G * NWAVES;
    LAS float* wr = (LAS float*)F.lds;
    LAS unsigned* lcnt = (LAS unsigned*)(F.lds + 65536);
    LAS unsigned* rec = (LAS unsigned*)(F.lds + 65536 + 64) + F.wave * 64;
    for (int i = F.tid; i < 8 * 2048; i += NTHREADS) { const int j = i & 7, k = i >> 3; wr[j * 2048 + k] = router[(size_t)k * 8 + j]; }
    if (F.tid < 16) lcnt[F.tid] = 0u;
    __syncthreads();
    unsigned* cnt = (unsigned*)(F.ws + WS_CTL) + CW_CNT;
    const int nrow = (M - gw + NGW - 1) / NGW;
    const bool local = nrow <= 64;
    f32x4 v[8], vn[8];
    if (gw < M) { const GAS f32x4* xr = (const GAS f32x4*)(F.out + (size_t)gw * DM) + F.lane;
#pragma unroll
        for (int j = 0; j < 8; ++j) v[j] = xr[64 * j]; }
    int ri = 0;
    for (int m = gw; m < M; m += NGW, ++ri) {
        const int mn = m + NGW;
        if (mn < M) { const GAS f32x4* xn = (const GAS f32x4*)(F.out + (size_t)mn * DM) + F.lane;
#pragma unroll
            for (int j = 0; j < 8; ++j) vn[j] = xn[64 * j]; }
        f32x4 y[8];
        ln_row(v, g, bta, F.lane, y, (float*)(F.ws + SM_STAT) + 2 * (size_t)m);
        GAS unsigned* o8 = (GAS unsigned*)(F.ws + WS_XB + (size_t)m * DM) + F.lane;
#pragma unroll
        for (int j = 0; j < 8; ++j) o8[64 * j] = pg8::pk4_fp8(y[j][0], y[j][1], y[j][2], y[j][3]);
        float mylg = 0.f;
#pragma unroll 1
        for (int e = 0; e < 8; ++e) { float s = 0.f;
#pragma unroll
            for (int j = 0; j < 8; ++j) { const f32x4 w = *(const LAS f32x4*)(wr + e * 2048 + 256 * j + 4 * F.lane); s += y[j][0] * w[0] + y[j][1] * w[1] + y[j][2] * w[2] + y[j][3] * w[3]; }
            s = wave_sum(s); mylg = (F.lane == e) ? s : mylg; }
        float lg[8];
#pragma unroll
        for (int e = 0; e < 8; ++e) lg[e] = __builtin_bit_cast(float, __builtin_amdgcn_readlane(__builtin_bit_cast(int, mylg), e));
        if (F.lane == 0) {
            int e0 = 0; float l0 = lg[0];
#pragma unroll
            for (int e = 1; e < 8; ++e) if (lg[e] > l0) { l0 = lg[e]; e0 = e; }
            int e1 = -1; float l1 = -__builtin_inff();
#pragma unroll
            for (int e = 0; e < 8; ++e) if (e != e0 && lg[e] > l1) { l1 = lg[e]; e1 = e; }
            const float ex = expf(l1 - l0), g0 = 1.0f / (1.0f + ex), g1 = ex / (1.0f + ex);
            int* rte = (int*)(F.ws + SM_RTE) + (size_t)m * 2; float* rtg = (float*)(F.ws + SM_RTG) + (size_t)m * 2;
            rte[0] = e0; rte[1] = e1; rtg[0] = g0; rtg[1] = g1;
            if (local) {
                const unsigned r0 = __hip_atomic_fetch_add(lcnt + e0, 1u, __ATOMIC_RELAXED, __HIP_MEMORY_SCOPE_WORKGROUP), r1 = __hip_atomic_fetch_add(lcnt + e1, 1u, __ATOMIC_RELAXED, __HIP_MEMORY_SCOPE_WORKGROUP);
                rec[ri] = (unsigned)e0 | ((unsigned)e1 << 4) | (r0 << 8) | (r1 << 20);
            } else {
                const unsigned p0 = __hip_atomic_fetch_add(cnt + 64 * e0, 1u, RLX_AGENT), p1 = __hip_atomic_fetch_add(cnt + 64 * e1, 1u, RLX_AGENT);
                int* rtp = (int*)(F.ws + SM_RTP) + (size_t)m * 2; rtp[0] = (int)p0; rtp[1] = (int)p1;
            }
        }
#pragma unroll
        for (int j = 0; j < 8; ++j) v[j] = vn[j];
    }
    __syncthreads();
    if (F.tid < 8) lcnt[8 + F.tid] = __hip_atomic_fetch_add(cnt + 64 * F.tid, lcnt[F.tid], RLX_AGENT);
    __syncthreads();
    if (local && F.lane < nrow) { const int m = gw + F.lane * NGW; const unsigned r = rec[F.lane];
        int* rtp = (int*)(F.ws + SM_RTP) + (size_t)m * 2;
        rtp[0] = (int)(lcnt[8 + (r & 15u)] + ((r >> 8) & 0xFFFu)); rtp[1] = (int)(lcnt[8 + ((r >> 4) & 15u)] + (r >> 20)); }
}
__device__ __forceinline__ void moe_tstart(const Ctx& F, int (&ts)[9]) {
    const unsigned* cnt = (const unsigned*)(F.ws + WS_CTL) + CW_CNT; int a = 0;
#pragma unroll
    for (int e = 0; e < 8; ++e) { ts[e] = a; a += ((int)__hip_atomic_load(cnt + 64 * e, RLX_AGENT) + 255) >> 8; }
    ts[8] = a;
}
__device__ __forceinline__ void phase_gather(const Ctx& F) {
    int ts[9]; moe_tstart(F, ts);
    const int gw = F.bid * NWAVES + F.wave, NGW = F.G * NWAVES;
    const int* rte = (const int*)(F.ws + SM_RTE); const int* rtp = (const int*)(F.ws + SM_RTP); int* rrow = (int*)(F.ws + SM_ROW);
    for (int a = gw; a < 2 * M; a += NGW) {
        const int m = a >> 1, e = rte[a], p = rtp[a]; int st = 0;
#pragma unroll
        for (int j = 0; j < 8; ++j) st = (e == j) ? ts[j] : st;
        const int row = st * 256 + p;
        const GAS u32x4* src = (const GAS u32x4*)(F.ws + WS_XB + (size_t)m * DM) + F.lane;
        GAS u32x4* dst = (GAS u32x4*)(F.ws + B1_XG + (size_t)row * DM) + F.lane;
#pragma unroll
        for (int j = 0; j < 2; ++j) dst[64 * j] = src[64 * j];
        if (F.lane == 0) rrow[a] = row;
    }
}
__device__ __forceinline__ void phase_final(const Ctx& F, const float* g, const float* bta, const int S, const float* gp, const float* bp) {
    const int gw = F.bid * NWAVES + F.wave, NGW = F.G * NWAVES;
    const int* rrow = (const int*)(F.ws + SM_ROW); const float* rtg = (const float*)(F.ws + SM_RTG); const bf16_t* Y = (const bf16_t*)(F.ws + B1_Y);
    const unsigned* flags = (const unsigned*)(F.ws + WS_CTL) + CW_FLAG; const float* slabs = (const float*)(F.ws + B1_SLAB);
    for (int m = gw; m < M; m += NGW) {
        GAS f32x4* xr = (GAS f32x4*)(F.out + (size_t)m * DM) + F.lane;
        const int r0 = rrow[2 * m], r1 = rrow[2 * m + 1]; const float g0 = rtg[2 * m], g1 = rtg[2 * m + 1];
        const float pmean = ((const float*)(F.ws + SM_STAT))[2 * (size_t)m], prstd = ((const float*)(F.ws + SM_STAT))[2 * (size_t)m + 1];
        int lz = F.lane; asm volatile("" : "+v"(lz));
        const float* gpl = gp + 4 * lz; const float* bpl = bp + 4 * lz;
        const GAS u32x2* y0 = (const GAS u32x2*)(Y + (size_t)r0 * DM) + F.lane; const GAS u32x2* y1 = (const GAS u32x2*)(Y + (size_t)r1 * DM) + F.lane;
        f32x4 v[8], y[8];
        const unsigned* fl0 = flags + (r0 >> 8) * 8; const unsigned* fl1 = flags + (r1 >> 8) * 8;
#pragma unroll
        for (int j = 0; j < 8; ++j) { const f32x4 x = (xr[64 * j] - pmean) * prstd * *(const f32x4*)(gpl + 256 * j) + *(const f32x4*)(bpl + 256 * j); f32x4 fa, fc;
            const unsigned f0 = fl0[j], f1 = fl1[j];
            if (f0 == 0u) { const u32x2 a = y0[64 * j]; fa = (f32x4){bflo(a.x), bfhi(a.x), bflo(a.y), bfhi(a.y)}; }
            else { const float* sp = slabs + (size_t)(f0 - 1u) * 65536 + (size_t)(r0 & 255) * 256 + 4 * F.lane; fa = *(const f32x4*)sp; for (int s = 1; s < S; ++s) fa = fa + *(const f32x4*)(sp + (size_t)s * 65536); fa = (f32x4){bf2f((unsigned short)f2bf(fa[0])), bf2f((unsigned short)f2bf(fa[1])), bf2f((unsigned short)f2bf(fa[2])), bf2f((unsigned short)f2bf(fa[3]))}; }
            if (f1 == 0u) { const u32x2 c = y1[64 * j]; fc = (f32x4){bflo(c.x), bfhi(c.x), bflo(c.y), bfhi(c.y)}; }
            else { const float* sp = slabs + (size_t)(f1 - 1u) * 65536 + (size_t)(r1 & 255) * 256 + 4 * F.lane; fc = *(const f32x4*)sp; for (int s = 1; s < S; ++s) fc = fc + *(const f32x4*)(sp + (size_t)s * 65536); fc = (f32x4){bf2f((unsigned short)f2bf(fc[0])), bf2f((unsigned short)f2bf(fc[1])), bf2f((unsigned short)f2bf(fc[2])), bf2f((unsigned short)f2bf(fc[3]))}; }
            v[j] = x * ALPHA + (fa * g0 + fc * g1); }
        ln_row(v, g, bta, F.lane, y);
#pragma unroll
        for (int j = 0; j < 8; ++j) xr[64 * j] = y[j];
    }
}
__device__ __forceinline__ void phase_norm1(const Ctx& F, const float* gq, const float* gk) {
    const int gw = F.bid * NWAVES + F.wave, NGW = F.G * NWAVES;
    const float* proj = (const float*)(F.ws + B1_PROJ);
    for (int m = gw; m < M; m += NGW) {
        const float* pr = proj + (size_t)m * NIN1P;
        const f32x4 q0 = *(const f32x4*)(pr + 8 * F.lane), q1 = *(const f32x4*)(pr + 8 * F.lane + 4), k0 = *(const f32x4*)(pr + 512 + 8 * F.lane), k1 = *(const f32x4*)(pr + 512 + 8 * F.lane + 4);
        float sq = q0[0] * q0[0] + q0[1] * q0[1] + q0[2] * q0[2] + q0[3] * q0[3] + q1[0] * q1[0] + q1[1] * q1[1] + q1[2] * q1[2] + q1[3] * q1[3];
        float sk = k0[0] * k0[0] + k0[1] * k0[1] + k0[2] * k0[2] + k0[3] * k0[3] + k1[0] * k1[0] + k1[1] * k1[1] + k1[2] * k1[2] + k1[3] * k1[3];
        sq = wave_sum(sq); sk = wave_sum(sk);
        const float rq = 1.0f / sqrtf(sq * (1.f / 512.f) + RMS_EPS), rk = 1.0f / sqrtf(sk * (1.f / 512.f) + RMS_EPS);
        const f32x4 gq0 = *(const f32x4*)(gq + 8 * F.lane), gq1 = *(const f32x4*)(gq + 8 * F.lane + 4), gk0 = *(const f32x4*)(gk + 8 * F.lane), gk1 = *(const f32x4*)(gk + 8 * F.lane + 4);
        const f32x4 a0 = q0 * rq * gq0, a1 = q1 * rq * gq1, c0 = k0 * rk * gk0, c1 = k1 * rk * gk1;
        u32x4 w; w.x = pk2(a0[0], a0[1]); w.y = pk2(a0[2], a0[3]); w.z = pk2(a1[0], a1[1]); w.w = pk2(a1[2], a1[3]);
        *((GAS u32x4*)((bf16_t*)(F.ws + B1_CQN) + (size_t)m * 512) + F.lane) = w;
        w.x = pk2(c0[0], c0[1]); w.y = pk2(c0[2], c0[3]); w.z = pk2(c1[0], c1[1]); w.w = pk2(c1[2], c1[3]);
        *((GAS u32x4*)((bf16_t*)(F.ws + B1_CKVN) + (size_t)m * 512) + F.lane) = w;
        if (F.lane < 32) { const float a = pr[1024 + 2 * F.lane], c = pr[1024 + 2 * F.lane + 1]; ((unsigned*)((bf16_t*)(F.ws + SM_KIDX) + (size_t)m * 64))[F.lane] = pk2(a, c); }
        else if (F.lane < 48) ((float*)(F.ws + SM_WIDX))[(size_t)m * 16 + (F.lane - 32)] = pr[1088 + (F.lane - 32)];
    }
}
__device__ __forceinline__ size_t sc_row_off(int b, int t) { const int qc = t >> 7; return (size_t)b * SC_PER_BATCH + (size_t)16384 * (qc * (qc + 1) / 2) + (size_t)(t & 127) * (128 * (qc + 1)); }

__device__ __forceinline__ float relu_f(float x) { const int b = __builtin_bit_cast(int, x); return __builtin_bit_cast(float, b > 0 ? b : 0); }
__device__ __forceinline__ void phase_index(const Ctx& F, float* SC) {
    const bf16_t* QI = (const bf16_t*)(F.ws + B1_QIDX); const bf16_t* KI = (const bf16_t*)(F.ws + SM_KIDX); const float* WI = (const float*)(F.ws + SM_WIDX);
    const int tid = F.tid, lane = F.lane, l15 = lane & 15, q4 = lane >> 4, wid = F.wave;
    LAS unsigned char* ktile = F.lds + 65536;
    const int skey = tid >> 3, sch = tid & 7; const unsigned st_off = (unsigned)(skey * 128 + ((sch ^ (skey & 7)) << 4));
    unsigned rd_off[4][2];
#pragma unroll
    for (int sg = 0; sg < 4; ++sg)
#pragma unroll
        for (int s = 0; s < 2; ++s) { const int k = sg * 16 + l15, c = s * 4 + q4; rd_off[sg][s] = (unsigned)(k * 128 + ((c ^ (k & 7)) << 4)); }
    unsigned* qhead = (unsigned*)(F.ws + WS_CTL) + CW_QIDX; LAS int* qslot = (LAS int*)(F.lds + 65536 + 16384);
    if (tid == 0) qslot[0] = (int)__hip_atomic_fetch_add(qhead, 1u, RLX_AGENT);
    __syncthreads();
    for (;;) {
        const int u = __builtin_amdgcn_readfirstlane(qslot[0]);
        if (u >= 576) break;
        int unext = 0; if (tid == 0) unext = (int)__hip_atomic_fetch_add(qhead, 1u, RLX_AGENT);
        const int v = 575 - u;
        const int b = v / 288, w = v % 288; int g = 0;
#pragma unroll
        for (int j = 1; j < 8; ++j) g += (w >= 4 * j * (j + 1)) ? 1 : 0;
        const int rem = w - 4 * g * (g + 1), qc = 8 * g + rem / (g + 1), ks = rem % (g + 1);
        const int k_lo = ks * 1024; int k_hi = k_lo + 1024; if (k_hi > 128 * (qc + 1)) k_hi = 128 * (qc + 1);
        const int pitch = 128 * (qc + 1), ntile = (k_hi - k_lo) >> 6;
        const bf16_t* kg = KI + ((size_t)b * T + k_lo + skey) * 64 + sch * 8;
#pragma unroll 1
        for (int pass = 0; pass < 4; ++pass) {
            const int t0 = qc * 128 + wid * 16 + pass * 4;
            bf16x8 af[4][2]; f32x4 wq[4];
#pragma unroll
            for (int i = 0; i < 4; ++i) { const size_t m = (size_t)b * T + t0 + i;
                af[i][0] = *(const bf16x8*)(QI + m * 1024 + l15 * 64 + q4 * 8); af[i][1] = *(const bf16x8*)(QI + m * 1024 + l15 * 64 + 32 + q4 * 8);
                wq[i] = *(const f32x4*)(WI + m * 16 + 4 * q4); }
            LAS float* stg = (LAS float*)(F.lds + wid * 8192) + lane; float* scp = SC + sc_row_off(b, t0) + k_lo;
            u32x4 kreg = *(const u32x4*)kg;
            *(LAS u32x4*)(ktile + st_off) = kreg;
            if (ntile > 1) kreg = *(const u32x4*)(kg + (size_t)64 * 64);
            __syncthreads();
#pragma unroll 1
            for (int ti = 0; ti < ntile; ++ti) {
                const LAS unsigned char* kt = ktile + (ti & 1) * 8192;
                bf16x8 bfr[4][2];
#pragma unroll
                for (int sg = 0; sg < 4; ++sg) { bfr[sg][0] = *(const LAS bf16x8*)(kt + rd_off[sg][0]); bfr[sg][1] = *(const LAS bf16x8*)(kt + rd_off[sg][1]); }
                if (ti + 1 < ntile) *(LAS u32x4*)(ktile + ((ti + 1) & 1) * 8192 + st_off) = kreg;
                if (ti + 2 < ntile) kreg = *(const u32x4*)(kg + (size_t)(ti + 2) * 64 * 64);
                f32x4 acc[4][4];
#pragma unroll
                for (int i = 0; i < 4; ++i)
#pragma unroll
                    for (int sg = 0; sg < 4; ++sg) acc[i][sg] = __builtin_amdgcn_mfma_f32_16x16x32_bf16(af[i][0], bfr[sg][0], (f32x4){0.f, 0.f, 0.f, 0.f}, 0, 0, 0);
#pragma unroll
                for (int i = 0; i < 4; ++i)
#pragma unroll
                    for (int sg = 0; sg < 4; ++sg) acc[i][sg] = __builtin_amdgcn_mfma_f32_16x16x32_bf16(af[i][1], bfr[sg][1], acc[i][sg], 0, 0, 0);
#pragma unroll
                for (int i = 0; i < 4; ++i) {
                    float part[4];
#pragma unroll
                    for (int sg = 0; sg < 4; ++sg) part[sg] = relu_f(acc[i][sg][0]) * wq[i][0] + relu_f(acc[i][sg][1]) * wq[i][1] + relu_f(acc[i][sg][2]) * wq[i][2] + relu_f(acc[i][sg][3]) * wq[i][3];
                    auto s0 = __builtin_amdgcn_permlane32_swap(__float_as_uint(part[0]), __float_as_uint(part[2]), false, false);
                    auto s1 = __builtin_amdgcn_permlane32_swap(__float_as_uint(part[1]), __float_as_uint(part[3]), false, false);
                    const float k0 = __uint_as_float(s0[0]) + __uint_as_float(s0[1]), k1 = __uint_as_float(s1[0]) + __uint_as_float(s1[1]);
                    auto s2 = __builtin_amdgcn_permlane16_swap(__float_as_uint(k0), __float_as_uint(k1), false, false);
                    stg[i * 512 + (ti & 7) * 64] = __uint_as_float(s2[0]) + __uint_as_float(s2[1]);
                }
                if ((ti & 7) == 7 || ti + 1 == ntile) {
                    LDS_WAIT(); asm volatile("" ::: "memory");
                    const int c0 = (ti & ~7) * 64, nc = (ti + 1) * 64 - c0;
#pragma unroll
                    for (int i = 0; i < 4; ++i) for (int k = 4 * lane; k < nc; k += 256) *(f32x4*)(scp + (size_t)i * pitch + c0 + k) = *(const LAS f32x4*)((LAS float*)(F.lds + wid * 8192) + i * 512 + k);
                    LDS_WAIT(); asm volatile("" ::: "memory"); }
                __syncthreads();
            }
        }
        if (tid == 0) qslot[0] = unext;
        __syncthreads();
    }
}

__device__ __forceinline__ int cnt_ge8(unsigned a0, unsigned a1, unsigned a2, unsigned a3, unsigned a4, unsigned a5, unsigned a6, unsigned a7, unsigned b) {
    unsigned long long m0, m1, m2, m3, m4, m5, m6, m7;
    asm("v_cmp_ge_u32_e64 %0, %8, %16\n\tv_cmp_ge_u32_e64 %1, %9, %16\n\tv_cmp_ge_u32_e64 %2, %10, %16\n\tv_cmp_ge_u32_e64 %3, %11, %16\n\t"
        "v_cmp_ge_u32_e64 %4, %12, %16\n\tv_cmp_ge_u32_e64 %5, %13, %16\n\tv_cmp_ge_u32_e64 %6, %14, %16\n\tv_cmp_ge_u32_e64 %7, %15, %16"
        : "=&s"(m0), "=&s"(m1), "=&s"(m2), "=&s"(m3), "=&s"(m4), "=&s"(m5), "=&s"(m6), "=&s"(m7)
        : "v"(a0), "v"(a1), "v"(a2), "v"(a3), "v"(a4), "v"(a5), "v"(a6), "v"(a7), "v"(b));
    return (__builtin_popcountll(m0) + __builtin_popcountll(m1)) + (__builtin_popcountll(m2) + __builtin_popcountll(m3)) + (__builtin_popcountll(m4) + __builtin_popcountll(m5)) + (__builtin_popcountll(m6) + __builtin_popcountll(m7));
}
__device__ __forceinline__ void phase_topk(const Ctx& F, const int reps) {
    const float* SC = (const float*)(F.ws + B1_SC); int* SEL = (int*)(F.ws + SM_SEL);
    const int lane = F.lane;
    LAS int* lst = (LAS int*)(F.lds + F.wave * 1024);
    unsigned* qhead = (unsigned*)(F.ws + WS_CTL) + CW_QTOPK;
    unsigned nxt = 0u; if (lane == 0) nxt = __hip_atomic_fetch_add(qhead, 1u, RLX_AGENT);
#pragma unroll 1
    for (;;) {
        const unsigned qi = (unsigned)__builtin_amdgcn_readfirstlane((int)nxt);
        if (qi >= (unsigned)(M * reps)) break;
        if (lane == 0) nxt = __hip_atomic_fetch_add(qhead, 1u, RLX_AGENT);
        const int qq = (int)(qi % (unsigned)M), b = qq & 1, t = 8191 - (qq >> 1), m = b * T + t; int* out = SEL + (size_t)m * 256;
        if (t < 256) {
#pragma unroll
            for (int j = 0; j < 4; ++j) { const int i = lane + 64 * j; out[i] = (i <= t) ? i : -1; }
            continue;
        }
        const float* row = SC + sc_row_off(b, t);
        const int nreg = (t >> 6) + 1;
        unsigned u[128];
#pragma unroll
        for (int gi = 0; gi < 8; ++gi) {
            if (gi * 16 < nreg) {
#pragma unroll
                for (int i = gi * 16; i < gi * 16 + 16; ++i) u[i] = __float_as_uint(row[lane + 64 * i]);
            } else {
#pragma unroll
                for (int i = gi * 16; i < gi * 16 + 16; ++i) u[i] = 0u;
            }
        }
#pragma unroll
        for (int gi = 0; gi < 8; ++gi) if (gi * 16 < nreg) {
#pragma unroll
            for (int i = gi * 16; i < gi * 16 + 16; ++i) { const int idx = lane + 64 * i; const unsigned bits = u[i]; const unsigned key = (bits & 0x80000000u) ? ~bits : (bits | 0x80000000u); u[i] = (idx <= t) ? key : 0u; }
        }
        bool done = false;
        if (nreg > 16) {
            unsigned Tl = 0u;
            for (int bit = 31; bit >= 0; --bit) { const unsigned cand = Tl | (1u << bit); int c = 0;
#pragma unroll
                for (int gi = 0; gi < 8; ++gi) if (gi * 16 < nreg) c += __builtin_popcountll(__ballot(u[gi * 16] >= cand)) + __builtin_popcountll(__ballot(u[gi * 16 + 8] >= cand));
                if (c >= 48) Tl = cand; }
            int call = 0;
#pragma unroll
            for (int gi = 0; gi < 8; ++gi) if (gi * 16 < nreg) {
#pragma unroll
                for (int i = gi * 16; i < gi * 16 + 16; i += 8) call += cnt_ge8(u[i], u[i + 1], u[i + 2], u[i + 3], u[i + 4], u[i + 5], u[i + 6], u[i + 7], Tl); }
            if (call >= 256 && call <= 1024) {
                LAS unsigned* keyL = (LAS unsigned*)(F.lds + 8192 + F.wave * 8192); LAS unsigned* idxL = keyL + 1024;
                int cb = 0;
#pragma unroll
                for (int gi = 0; gi < 8; ++gi) if (gi * 16 < nreg) {
#pragma unroll
                    for (int i = gi * 16; i < gi * 16 + 16; ++i) { const bool s = u[i] >= Tl; const unsigned long long sb = __ballot(s);
                        if (s) { const int p = cb + (int)__builtin_amdgcn_mbcnt_hi((unsigned)(sb >> 32), __builtin_amdgcn_mbcnt_lo((unsigned)sb, 0u)); keyL[p] = u[i]; idxL[p] = (unsigned)(lane + 64 * i); }
                        cb += __builtin_popcountll(sb); } }
                LDS_WAIT(); asm volatile("" ::: "memory");
                const int nc = (call + 63) >> 6;
                unsigned ck[16], ci[16];
#pragma unroll
                for (int j = 0; j < 16; ++j) { const int p = lane + 64 * j; const bool ok = (j < nc) && (p < call); ck[j] = ok ? keyL[p] : 0u; ci[j] = ok ? idxL[p] : 0u; }
                unsigned Tk = 0u; bool exact = false;
                for (int bit = 31; bit >= 0; --bit) { const unsigned cand = Tk | (1u << bit); int c = 0;
#pragma unroll
                    for (int j = 0; j < 16; ++j) if (j < nc) c += __builtin_popcountll(__ballot(ck[j] >= cand));
                    if (c >= 256) { Tk = cand; if (c == 256) { exact = true; break; } } }
                int need = 0;
                if (!exact) { int c = 0;
#pragma unroll
                    for (int j = 0; j < 16; ++j) if (j < nc) c += __builtin_popcountll(__ballot(ck[j] > Tk));
                    need = 256 - c; }
                int base = 0, eq_taken = 0;
#pragma unroll
                for (int j = 0; j < 16; ++j) if (j < nc) {
                    const bool eq = ck[j] == Tk; const unsigned long long eb = __ballot(eq && !exact);
                    const int rank = eq_taken + __builtin_popcountll(eb & ((1ull << lane) - 1ull)); eq_taken += __builtin_popcountll(eb);
                    const bool s = exact ? (ck[j] >= Tk) : ((ck[j] > Tk) || (eq && rank < need));
                    const unsigned long long sb = __ballot(s);
                    if (s) { const int pos = base + __builtin_popcountll(sb & ((1ull << lane) - 1ull)); if (pos < 256) lst[pos] = (int)ci[j]; }
                    base += __builtin_popcountll(sb); }
                done = true;
            }
        }
        if (!done) {
            unsigned Tk = 0u; bool exact = false;
            for (int bit = 31; bit >= 0; --bit) {
                const unsigned cand = Tk | (1u << bit); int c = 0;
    #pragma unroll
                for (int gi = 0; gi < 8; ++gi) if (gi * 16 < nreg) {
    #pragma unroll
                    for (int i = gi * 16; i < gi * 16 + 16; i += 8) c += cnt_ge8(u[i], u[i + 1], u[i + 2], u[i + 3], u[i + 4], u[i + 5], u[i + 6], u[i + 7], cand); }
                if (c >= 256) { Tk = cand; if (c == 256) { exact = true; break; } }
            }
            int need = 0;
            if (!exact) { int c = 0;
    #pragma unroll
                for (int gi = 0; gi < 8; ++gi) if (gi * 16 < nreg) {
    #pragma unroll
                    for (int i = gi * 16; i < gi * 16 + 16; ++i) c += __builtin_popcountll(__ballot(u[i] > Tk)); }
                need = 256 - c; }
            int base = 0;
            if (exact) {
    #pragma unroll
                for (int gi = 0; gi < 8; ++gi) if (gi * 16 < nreg) {
    #pragma unroll
                    for (int i = gi * 16; i < gi * 16 + 16; ++i) {
                        const bool s = u[i] >= Tk; const unsigned long long sb = __ballot(s);
                        if (s) lst[base + (int)__builtin_amdgcn_mbcnt_hi((unsigned)(sb >> 32), __builtin_amdgcn_mbcnt_lo((unsigned)sb, 0u))] = lane + 64 * i;
                        base += __builtin_popcountll(sb);
                    } }
            } else {
                int eq_taken = 0;
    #pragma unroll
                for (int gi = 0; gi < 8; ++gi) if (gi * 16 < nreg) {
    #pragma unroll
                    for (int i = gi * 16; i < gi * 16 + 16; ++i) {
                        const bool eq = u[i] == Tk; const unsigned long long eb = __ballot(eq);
                        const int rank = eq_taken + __builtin_popcountll(eb & ((1ull << lane) - 1ull)); eq_taken += __builtin_popcountll(eb);
                        const bool s = (u[i] > Tk) || (eq && rank < need);
                        const unsigned long long sb = __ballot(s);
                        if (s) { const int pos = base + __builtin_popcountll(sb & ((1ull << lane) - 1ull)); if (pos < 256) lst[pos] = lane + 64 * i; }
                        base += __builtin_popcountll(sb);
                    } }
            }
        }
        LDS_WAIT(); asm volatile("" ::: "memory");
        *(GAS u32x4*)(out + 4 * lane) = *(const LAS u32x4*)(lst + 4 * lane);
        LDS_WAIT(); asm volatile("" ::: "memory");
    }
}

__device__ __forceinline__ void quad_barrier(volatile LAS unsigned* cnt, unsigned& epoch, int lane) {
    asm volatile("s_waitcnt lgkmcnt(0)" ::: "memory");
    epoch += 4u;
    if (lane == 0) __hip_atomic_fetch_add((LAS unsigned*)cnt, 1u, __ATOMIC_RELAXED, __HIP_MEMORY_SCOPE_WORKGROUP);
    for (unsigned sp = 0; __builtin_amdgcn_readfirstlane(*cnt) < epoch && sp < (1u << 24); ++sp) __builtin_amdgcn_s_sleep(1);
    asm volatile("" ::: "memory");
}
__device__ __forceinline__ void quad_signal(volatile LAS unsigned* cnt4, int qt, unsigned value, int lane) {
    asm volatile("s_waitcnt lgkmcnt(0)" ::: "memory");
    if (lane == 0) cnt4[qt] = value;
}
__device__ __forceinline__ void quad_wait(volatile LAS unsigned* cnt4, unsigned target) {
    for (unsigned sp = 0; sp < (1u << 24); ++sp) {
        const u32x4 v = *(const volatile LAS u32x4*)cnt4;
        unsigned mn = v.x < v.y ? v.x : v.y; const unsigned m2 = v.z < v.w ? v.z : v.w; mn = mn < m2 ? mn : m2;
        if ((int)((unsigned)__builtin_amdgcn_readfirstlane(mn) - target) >= 0) break;
        __builtin_amdgcn_s_sleep(1); }
    asm volatile("" ::: "memory");
}
namespace dsa {
constexpr int OFF_ROWS = 0, OFF_XCH = 65536, OFF_SEL = OFF_XCH + 32768, OFF_LUT = OFF_SEL + 4096, OFF_AL = OFF_LUT + 129 * 16 * 4 + 64, OFF_QB = OFF_AL + 8 * 64 * 4, LDS_END = OFF_QB + 64;
__device__ __forceinline__ unsigned off_a(unsigned row, unsigned ch) { return 2048u * (row >> 3) + 512u * (ch >> 2) + 64u * (row & 7) + 16u * ((ch & 3) ^ ((row >> 2) & 3)); }
}
#ifndef SATTN_LMAP
#define SATTN_LMAP 1
#endif
template <int V>
__device__ __forceinline__ void phase_sattn(const Ctx& F, const float* tab, unsigned char* OL) {
    using namespace dsa;
    const bf16_t* CKV = (const bf16_t*)(F.ws + B1_CKVN); const bf16_t* QL = (const bf16_t*)(F.ws + B1_QLAT); const int* SEL = (const int*)(F.ws + SM_SEL);
    const int lane = F.lane, wid = F.wave, l15 = lane & 15, q4 = lane >> 4, slot = wid >> 2, qt = wid & 3;
    char* lds = (char*)F.ldsg;
    char* rows = lds + OFF_ROWS + wid * 8192;
    float* lut = (float*)(lds + OFF_LUT); float* alw = (float*)(lds + OFF_AL) + wid * 64;
    for (int i = F.tid; i < 129 * 16; i += NTHREADS) lut[i] = tab[rel_bucket_dev(i >> 4) * 16 + (i & 15)] * LOG2E;
    unsigned st_addr[2][4];
#pragma unroll
    for (int c = 0; c < 2; ++c)
#pragma unroll
        for (int s = 0; s < 4; ++s) st_addr[c][s] = off_a(8u * (l15 >> 2) + 4u * c + (l15 & 3), 4u * s + q4);
    unsigned wr_addr[2];
#if SATTN_LMAP == 2
#define WR_IMM(s_) (4096 * ((s_) >> 1) + 1024 * ((s_) & 1))
#pragma unroll
    for (int c = 0; c < 2; ++c) { const unsigned nl = lane >> 3; wr_addr[c] = off_a(8u * (nl >> 2) + 4u * c + (nl & 3), lane & 7); }
#else
#define WR_IMM(s_) (512 * (s_))
#pragma unroll
    for (int c = 0; c < 2; ++c) { const unsigned nl = lane >> 2; wr_addr[c] = off_a(8u * (nl >> 2) + 4u * c + (nl & 3), lane & 3); }
#endif
    unsigned tr_base[2][2];
    { const unsigned q = (lane & 15) >> 2, p = lane & 3;
#pragma unroll
      for (int c1 = 0; c1 < 2; ++c1)
#pragma unroll
          for (int t = 0; t < 2; ++t) tr_base[c1][t] = (unsigned)(uintptr_t)rows + off_a(8u * q4 + 4u * t + q, 2u * c1 + (p >> 1)) + 8u * (p & 1); }
    __syncthreads();
    volatile LAS unsigned* pcnt = (volatile LAS unsigned*)(F.lds + OFF_QB) + slot * 8; volatile LAS unsigned* ccnt = pcnt + 4;
    if (F.tid < 16) ((LAS unsigned*)(F.lds + OFF_QB))[F.tid] = 0u;
    const int per = (M + F.G - 1) / F.G;
    int* sellb = (int*)(lds + OFF_SEL);
    bf16x8 bq[4];
    const bool xmap = (F.G == 256) && (per == 64);
    const int xb = (F.bid >> 2) & 1, xj = ((F.bid >> 3) << 2) | (F.bid & 3);
#define QUERY_OF(it_) (xmap ? (xb * T + ((it_) + slot) * 128 + xj) : (F.bid * per + (it_) + slot))
    { const int m0 = QUERY_OF(0); const int mm0 = m0 < M ? m0 : M - 1;
      if (qt == 0) *(u32x4*)(sellb + slot * 256 + 4 * lane) = *(const u32x4*)(SEL + (size_t)mm0 * 256 + 4 * lane);
#pragma unroll
      for (int s = 0; s < 4; ++s) bq[s] = *(const bf16x8*)(QL + (size_t)mm0 * 8192 + l15 * 512 + qt * 128 + 32 * s + 8 * q4); }
    __syncthreads();
    if (slot == 1) { for (int i = 0; i < 12; ++i) __builtin_amdgcn_s_sleep(64); }
    for (int it = 0; it < per; it += 2) {
        const int par = (it >> 1) & 1;
        const int m = QUERY_OF(it); const bool live = m < M;
        const int mm = live ? m : M - 1; const int b = mm >> 13, t = mm & 8191;
        const int* sell = sellb + (par * 2 + slot) * 256;
        int mn = QUERY_OF(it + 2); if (it + 2 >= per || mn >= M) mn = mm;
        u32x4 seln = {0u, 0u, 0u, 0u}; bf16x8 bqn[4];
        bf16x8 afn[2][4];
#if SATTN_LMAP == 2
#define LOAD_ROWS(dst, step_) do { _Pragma("unroll") for (int c = 0; c < 2; ++c) { _Pragma("unroll") for (int h2 = 0; h2 < 2; ++h2) { int kidx = sell[(step_) * 32 + c * 16 + 8 * h2 + (lane >> 3)]; kidx = kidx < 0 ? 0 : kidx; \
            const bf16_t* rp = CKV + ((size_t)b * T + kidx) * 512 + qt * 128 + 8 * (lane & 7); dst[c][2 * h2] = *(const bf16x8*)rp; dst[c][2 * h2 + 1] = *(const bf16x8*)(rp + 64); } } } while (0)
#else
#define LOAD_ROWS(dst, step_) do { _Pragma("unroll") for (int c = 0; c < 2; ++c) { int kidx = sell[(step_) * 32 + c * 16 + (lane >> 2)]; kidx = kidx < 0 ? 0 : kidx; \
            const bf16_t* rp = CKV + ((size_t)b * T + kidx) * 512 + qt * 128 + 8 * (lane & 3); _Pragma("unroll") for (int s = 0; s < 4; ++s) dst[c][s] = *(const bf16x8*)(rp + 32 * s); } } while (0)
#endif
        LOAD_ROWS(afn, 0);
        f32x4 o[8];
#pragma unroll
        for (int cb = 0; cb < 8; ++cb) o[cb] = (f32x4){0.f, 0.f, 0.f, 0.f};
        float m_run = -1e30f, l_run = 0.f;
        s16x4 v0[8], v1[8];
        const unsigned gbase = (unsigned)(it >> 1) * 8u;
#pragma unroll 1
        for (int step = 0; step <= 8; ++step) {
            if (step < 8) {
#pragma unroll
                for (int c = 0; c < 2; ++c)
#pragma unroll
                    for (int s = 0; s < 4; ++s) *(bf16x8*)(rows + wr_addr[c] + WR_IMM(s)) = afn[c][s];
                if (step < 7) LOAD_ROWS(afn, step + 1);
                if (step == 6) {
                    if (qt == 0) seln = *(const u32x4*)(SEL + (size_t)mn * 256 + 4 * lane);
#pragma unroll
                    for (int s = 0; s < 4; ++s) bqn[s] = *(const bf16x8*)(QL + (size_t)mn * 8192 + l15 * 512 + qt * 128 + 32 * s + 8 * q4); }
                f32x4 sp[2]; bf16x8 af[2][4];
#pragma unroll
                for (int c = 0; c < 2; ++c) { sp[c] = (f32x4){0.f, 0.f, 0.f, 0.f};
#pragma unroll
                    for (int s = 0; s < 4; ++s) af[c][s] = *(const bf16x8*)(rows + st_addr[c][s]);
#pragma unroll
                    for (int s = 0; s < 4; ++s) sp[c] = __builtin_amdgcn_mfma_f32_16x16x32_bf16(af[c][s], bq[s], sp[c], 0, 0, 0); }
                const unsigned g = gbase + (unsigned)step;
                if (g >= 2u) quad_wait(ccnt, g - 1u);
                if (step == 7 && qt == 0) *(u32x4*)(sellb + ((par ^ 1) * 2 + slot) * 256 + 4 * lane) = seln;
                f32x4* xch = (f32x4*)(lds + OFF_XCH) + (size_t)(step & 1) * 1024;
                xch[(wid * 2 + 0) * 64 + lane] = sp[0]; xch[(wid * 2 + 1) * 64 + lane] = sp[1];
                quad_signal(pcnt, qt, g + 1u, lane);
            }
            if (step > 0) {
                const int ps = step - 1;
                quad_wait(pcnt, gbase + (unsigned)ps + 1u);
                const f32x4* xch = (const f32x4*)(lds + OFF_XCH) + (size_t)(ps & 1) * 1024;
                f32x4 st[2];
#pragma unroll
                for (int c = 0; c < 2; ++c) { st[c] = xch[((slot * 4 + 0) * 2 + c) * 64 + lane] + xch[((slot * 4 + 1) * 2 + c) * 64 + lane] + xch[((slot * 4 + 2) * 2 + c) * 64 + lane] + xch[((slot * 4 + 3) * 2 + c) * 64 + lane]; }
                quad_signal(ccnt, qt, gbase + (unsigned)ps + 1u, lane);
                float pmax = -__builtin_inff();
#pragma unroll
                for (int c = 0; c < 2; ++c) { const u32x4 kk = *(const u32x4*)(sell + ps * 32 + c * 16 + 4 * q4);
                    float bv[4];
#pragma unroll
                    for (int j = 0; j < 4; ++j) { int d = t - (int)kk[j]; d = d < 0 ? 0 : (d > 128 ? 128 : d); bv[j] = lut[d * 16 + l15]; }
                    asm volatile("" : "+v"(bv[0]), "+v"(bv[1]), "+v"(bv[2]), "+v"(bv[3]));
#pragma unroll
                    for (int j = 0; j < 4; ++j) { const int kidx = (int)kk[j]; const bool ok = (kidx >= 0) && (kidx <= t);
                        const float v = ok ? st[c][j] + bv[j] : -__builtin_inff(); st[c][j] = v; pmax = fmaxf(pmax, v); } }
                { auto r16 = __builtin_amdgcn_permlane16_swap(__float_as_uint(pmax), __float_as_uint(pmax), false, false); pmax = fmaxf(__uint_as_float(r16[0]), __uint_as_float(r16[1]));
                  auto r32 = __builtin_amdgcn_permlane32_swap(__float_as_uint(pmax), __float_as_uint(pmax), false, false); pmax = fmaxf(__uint_as_float(r32[0]), __uint_as_float(r32[1])); }
                float alpha = 1.f;
                if (!__all((pmax - m_run) <= att::THR2)) { const float mnew = fmaxf(m_run, pmax); alpha = __builtin_amdgcn_exp2f(m_run - mnew); m_run = mnew;
                    if (q4 == 0) alw[l15] = alpha;
                    LDS_WAIT(); asm volatile("" ::: "memory");
                    const f32x4 a4 = *(const f32x4*)(alw + 4 * q4);
#pragma unroll
                    for (int cb = 0; cb < 8; ++cb) o[cb] = o[cb] * a4; }
                float ps_ = 0.f; unsigned pk[4];
#pragma unroll
                for (int c = 0; c < 2; ++c) { float p0 = __builtin_amdgcn_exp2f(st[c][0] - m_run), p1 = __builtin_amdgcn_exp2f(st[c][1] - m_run), p2 = __builtin_amdgcn_exp2f(st[c][2] - m_run), p3 = __builtin_amdgcn_exp2f(st[c][3] - m_run);
                    ps_ += (p0 + p1) + (p2 + p3); pk[2 * c] = cvt_pk_bf16(p0, p1); pk[2 * c + 1] = cvt_pk_bf16(p2, p3); }
                l_run = l_run * alpha + ps_;
                const u32x4 pw = {pk[0], pk[1], pk[2], pk[3]}; const bf16x8 pa = *reinterpret_cast<const bf16x8*>(&pw);
                asm volatile("s_waitcnt lgkmcnt(0)" ::: "memory");
#pragma unroll
                for (int cb = 0; cb < 8; ++cb)
                    o[cb] = __builtin_amdgcn_mfma_f32_16x16x32_bf16(pa, (bf16x8){v0[cb][0], v0[cb][1], v0[cb][2], v0[cb][3], v1[cb][0], v1[cb][1], v1[cb][2], v1[cb][3]}, o[cb], 0, 0, 0);
            }
            if (step < 8) {
#pragma unroll
                for (int cb = 0; cb < 8; ++cb) {
                    asm volatile("ds_read_b64_tr_b16 %0, %1 offset:%2" : "=&v"(v0[cb]) : "v"(tr_base[cb & 1][0]), "i"(512 * (cb >> 1)) : "memory");
                    asm volatile("ds_read_b64_tr_b16 %0, %1 offset:%2" : "=&v"(v1[cb]) : "v"(tr_base[cb & 1][1]), "i"(512 * (cb >> 1)) : "memory"); }
            }
        }
#undef LOAD_ROWS
        float l = l_run;
        { auto r16 = __builtin_amdgcn_permlane16_swap(__float_as_uint(l), __float_as_uint(l), false, false); l = __uint_as_float(r16[0]) + __uint_as_float(r16[1]);
          auto r32 = __builtin_amdgcn_permlane32_swap(__float_as_uint(l), __float_as_uint(l), false, false); l = __uint_as_float(r32[0]) + __uint_as_float(r32[1]); }
        if (q4 == 0) alw[16 + l15] = 1.0f / l;
        LDS_WAIT(); asm volatile("" ::: "memory");
        const f32x4 r4 = *(const f32x4*)(alw + 16 + 4 * q4);
        if (live) {
#pragma unroll
            for (int cb = 0; cb < 8; ++cb)
#pragma unroll
                for (int e = 0; e < 4; ++e) { const float v = o[cb][e] * (r4[e] * 16.0f); const float v1_ = pg8::quad_xor1(v), v2_ = pg8::quad_xor2(v), v3_ = pg8::quad_xor3(v);
                    if ((lane & 3) == 0) *(unsigned*)(OL + (size_t)m * 8192 + (4 * q4 + e) * 512 + qt * 128 + 16 * cb + l15) = pg8::pk4_fp8(v, v1_, v2_, v3_); }
        }
#pragma unroll
        for (int s = 0; s < 4; ++s) bq[s] = bqn[s];
    }
    __syncthreads();
}
#ifndef MK_PER_PHASE
#define MK_PER_PHASE 0
#endif
constexpr int NPHASE = 22;
#ifndef REPEAT_MASK
#define REPEAT_MASK 0ull
#endif
#define REP(k) ((int)(((unsigned long long)(REPEAT_MASK) >> (k)) & 1ull))
__global__ void __launch_bounds__(NTHREADS, 2) fwd(Args args) {
    extern __shared__ __attribute__((aligned(16))) unsigned char lds_raw[];
    const int wave_s = __builtin_amdgcn_readfirstlane((int)threadIdx.x >> 6);
#define MKCTX(F) Ctx F; { int t_ = (int)__builtin_amdgcn_mbcnt_hi(~0u, __builtin_amdgcn_mbcnt_lo(~0u, 0u)); asm volatile("" : "+v"(t_)); t_ |= wave_s << 6; F.lds = (LAS unsigned char*)lds_raw; F.ldsg = lds_raw; F.ws = args.ws; F.out = args.out; \
        F.tid = t_; F.lane = t_ & 63; F.wave = __builtin_amdgcn_readfirstlane(t_ >> 6); F.G = gridDim.x; F.bid = blockIdx.x; }
    volatile LAS unsigned* MISC = (volatile LAS unsigned*)((LAS unsigned char*)lds_raw + MISC_OFF);
    for (int u = (int)threadIdx.x; u < (LDS_BYTES - MISC_OFF) / 4; u += NTHREADS) ((LAS unsigned*)((LAS unsigned char*)lds_raw + MISC_OFF))[u] = 0u;
    __syncthreads();
    const int lo = args.ph_lo, hi = args.ph_hi;
    XcdBarrier bar; bar.bar = (unsigned*)(args.ws + WS_CTL) + CW_BAR; bar.x = 0; bar.st = nullptr;
    #define LEADER() (wave_s == 0 && __builtin_amdgcn_mbcnt_hi(~0u, __builtin_amdgcn_mbcnt_lo(~0u, 0u)) == 0u)
    if (hi - lo > 1) bar = xcd_barrier_post((unsigned*)(args.ws + WS_CTL) + CW_BAR, MISC + 8, LEADER());
#ifdef ONLY_PHASE
#define IN(k) ((k) == ONLY_PHASE && lo <= (k) && (k) < hi)
#else
#define IN(k) (lo <= (k) && (k) < hi)
#endif
#define SEAM(k) do { if (IN(k) && IN((k) + 1)) xcd_barrier(bar, LEADER()); } while (0)
    unsigned char* ws = args.ws;
    bf16_t* XB = (bf16_t*)(ws + WS_XB);

    if (IN(0)) for (int rep_ = 0; rep_ <= REP(0); ++rep_) { if (rep_) xcd_barrier(bar, LEADER()); MKCTX(F); const ProIn I{args.in[0], args.in[2], args.in[3], args.in[4], args.in[7], args.in[8], args.in[9], args.in[12], args.in[15], args.in[16], args.in[17], args.in[18], args.in[19], args.in[23], args.in[24], args.in[25]}; phase_prologue(F, I); } SEAM(0);
    if (IN(1)) for (int rep_ = 0; rep_ <= REP(1); ++rep_) { if (rep_) xcd_barrier(bar, LEADER()); MKCTX(F);
        { pg8::Gemm g{XB, (const bf16_t*)(ws + WS_WIN0), 2048, 2048, 2048}; pg8::ColMapSched S; S.init(M / 256, 16, F.G, F.bid); S.vsel = 0;
          pg8::EpiQKV0 E{(bf16_t*)(ws + B0_QKV), 1.0f}; pg8::gemm_phase(F.lds, g, S, E, F.tid); }
        { pg8::Gemm g{(const bf16_t*)(ws + B0_X8), (const bf16_t*)(ws + B0_WV8), 1024, 1024, 1024}; pg8::ColMapSched S; S.init(M / 256, 8, F.G, F.bid); S.vsel = 1;
          pg8::EpiQKV0 E{(bf16_t*)(ws + B0_QKV), 1.0f / 512.0f}; pg8::gemm_phase<pg8::EpiQKV0, pg8::ColMapSched, true>(F.lds, g, S, E, F.tid); } } SEAM(1);
    if (IN(2)) for (int rep_ = 0; rep_ <= REP(2); ++rep_) { if (rep_) xcd_barrier(bar, LEADER()); MKCTX(F); phase_pre0(F); } SEAM(2);
    if (IN(3)) { for (int rep_ = 0; rep_ <= REP(3); ++rep_) { if (rep_) xcd_barrier(bar, LEADER()); MKCTX(F); phase_attn0_moba(F, args.in[1]); } for (int rep_ = 0; rep_ <= REP(22); ++rep_) { if (rep_) xcd_barrier(bar, LEADER()); MKCTX(F); phase_attn0_fox(F); } } SEAM(3);
    if (IN(4)) for (int rep_ = 0; rep_ <= REP(4); ++rep_) { if (rep_) xcd_barrier(bar, LEADER()); MKCTX(F);
        pg8::Gemm g{(const bf16_t*)(ws + B0_O), (const bf16_t*)(ws + WS_WOUT0), 1024, 1024, 1024}; pg8::PlainSched S; S.init(M / 256, DM / 256, F.G, F.bid); S.akstep = 0;
        pg8::EpiResF32 E{args.in[0], args.out, DM, ALPHA, 1.0f / 1024.0f}; pg8::gemm_phase<pg8::EpiResF32, pg8::PlainSched, true>(F.lds, g, S, E, F.tid); } SEAM(4);
    if (IN(5)) for (int rep_ = 0; rep_ <= REP(5); ++rep_) { if (rep_) xcd_barrier(bar, LEADER()); MKCTX(F); phase_ln<true>(F, args.in[5], args.in[6]); } SEAM(5);
    if (IN(6)) for (int rep_ = 0; rep_ <= REP(6); ++rep_) { if (rep_) xcd_barrier(bar, LEADER()); MKCTX(F);
        pg8::Gemm g{XB, (const bf16_t*)(ws + WS_WFF13), 1024, 1024, 1024}; pg8::PlainSched S; S.init(M / 256, 2 * FF0 / 256, F.G, F.bid); S.akstep = 0;
        pg8::EpiSwiGLU8 E{ws + B0_ACT, FF0}; pg8::gemm_phase<pg8::EpiSwiGLU8, pg8::PlainSched, true>(F.lds, g, S, E, F.tid); } SEAM(6);
    if (IN(7)) for (int rep_ = 0; rep_ <= REP(7); ++rep_) { if (rep_) xcd_barrier(bar, LEADER()); MKCTX(F);
        pg8::Gemm g{(const bf16_t*)(ws + B0_ACT), (const bf16_t*)(ws + WS_WFF2), FF0 / 2, FF0 / 2, FF0 / 2}; pg8::PlainSched S; S.init(M / 256, DM / 256, F.G, F.bid); S.akstep = 0;
        pg8::EpiResLnF32 E{args.out, args.out, DM, ALPHA, 1.0f / 512.0f, (const float*)(ws + SM_STAT), args.in[5], args.in[6]}; pg8::gemm_phase<pg8::EpiResLnF32, pg8::PlainSched, true>(F.lds, g, S, E, F.tid); } SEAM(7);
    if (IN(8)) for (int rep_ = 0; rep_ <= REP(8); ++rep_) { if (rep_) xcd_barrier(bar, LEADER()); MKCTX(F); phase_ln<false>(F, args.in[10], args.in[11]); } SEAM(8);
    if (IN(9)) for (int rep_ = 0; rep_ <= REP(9); ++rep_) { if (rep_) xcd_barrier(bar, LEADER()); MKCTX(F);
        pg8::Gemm g{XB, (const bf16_t*)(ws + WS_WIN1), 2048, 2048, 2048}; pg8::PlainSched S; S.init(M / 256, NIN1P / 256, F.G, F.bid); S.akstep = 0;
        pg8::EpiF32 E{(float*)(ws + B1_PROJ), NIN1P}; pg8::gemm_phase(F.lds, g, S, E, F.tid); } SEAM(9);
    if (IN(10)) for (int rep_ = 0; rep_ <= REP(10); ++rep_) { if (rep_) xcd_barrier(bar, LEADER()); MKCTX(F); phase_norm1(F, args.in[13], args.in[14]); } SEAM(10);
    if (IN(11)) for (int rep_ = 0; rep_ <= REP(11); ++rep_) { if (rep_) xcd_barrier(bar, LEADER()); MKCTX(F);
        pg8::Gemm g{(const bf16_t*)(ws + B1_CQN), (const bf16_t*)(ws + WS_WQ1), 512, 512, 512}; pg8::PlainSched S; S.init(M / 256, NQ1 / 256, F.G, F.bid); S.akstep = 0;
        pg8::EpiBf16 E{(bf16_t*)(ws + B1_QLAT), 8192, 8192, (bf16_t*)(ws + B1_QIDX), 1024}; pg8::gemm_phase(F.lds, g, S, E, F.tid); } SEAM(11);
    if (IN(12)) for (int rep_ = 0; rep_ <= REP(12); ++rep_) { if (rep_) xcd_barrier(bar, LEADER()); MKCTX(F); phase_index(F, (float*)(ws + B1_SC)); } SEAM(12);
    if (IN(13)) { MKCTX(F); phase_topk(F, 1 + REP(13)); } SEAM(13);
    if (IN(14)) for (int rep_ = 0; rep_ <= REP(14); ++rep_) { if (rep_) xcd_barrier(bar, LEADER()); MKCTX(F); phase_sattn<0>(F, args.in[1], ws + B1_SC); }
#ifdef SATTN_PROBE
    if (IN(14)) { xcd_barrier(bar, LEADER()); MKCTX(F); phase_sattn<SATTN_PROBE>(F, args.in[1], ws + B1_SC); }
#endif
    SEAM(14);
    if (IN(15)) for (int rep_ = 0; rep_ <= REP(15); ++rep_) { if (rep_) xcd_barrier(bar, LEADER()); MKCTX(F);
        pg8::Gemm g{(const bf16_t*)(ws + B1_SC), (const bf16_t*)(ws + WS_WUV), 4096, 512, 512}; pg8::PlainSched S; S.init(M / 256, DM / 256, F.G, F.bid); S.akstep = 512;
        pg8::Epi8 E{ws + B1_OB, DM, 1.0f / 64.0f}; pg8::gemm_phase<pg8::Epi8, pg8::PlainSched, true>(F.lds, g, S, E, F.tid); } SEAM(15);
    if (IN(16)) for (int rep_ = 0; rep_ <= REP(16); ++rep_) { if (rep_) xcd_barrier(bar, LEADER()); MKCTX(F);
        pg8::Gemm g{(const bf16_t*)(ws + B1_OB), (const bf16_t*)(ws + WS_WOUT1), 1024, 1024, 1024}; pg8::PlainSched S; S.init(M / 256, DM / 256, F.G, F.bid); S.akstep = 0;
        pg8::EpiResLnF32 E{args.out, args.out, DM, ALPHA, 1.0f / 1024.0f, (const float*)(ws + SM_STAT), args.in[10], args.in[11]}; pg8::gemm_phase<pg8::EpiResLnF32, pg8::PlainSched, true>(F.lds, g, S, E, F.tid); } SEAM(16);
    if (IN(17)) for (int rep_ = 0; rep_ <= REP(17); ++rep_) { if (rep_) xcd_barrier(bar, LEADER()); MKCTX(F); phase_ln_router(F, args.in[20], args.in[21], args.in[22]); } SEAM(17);
    if (IN(18)) for (int rep_ = 0; rep_ <= REP(18); ++rep_) { if (rep_) xcd_barrier(bar, LEADER()); MKCTX(F); phase_gather(F); } SEAM(18);
    if (IN(19)) for (int rep_ = 0; rep_ <= REP(19); ++rep_) { if (rep_) xcd_barrier(bar, LEADER()); MKCTX(F);
        int ts_[9]; moe_tstart(F, ts_); pg8::MoeSched S; S.set_tstart(ts_); S.brows = 2 * FFE; S.init(ts_[8], 2 * FFE / 256, F.G, F.bid);
        pg8::Gemm g{(const bf16_t*)(ws + B1_XG), (const bf16_t*)(ws + WS_WE13), 1024, 1024, 1024};
        pg8::EpiSwiGLU8 E{ws + B1_H, FFE}; pg8::gemm_phase<pg8::EpiSwiGLU8, pg8::MoeSched, true>(F.lds, g, S, E, F.tid); } SEAM(19);
    if (IN(20)) for (int rep_ = 0; rep_ <= REP(20); ++rep_) { if (rep_) xcd_barrier(bar, LEADER()); MKCTX(F);
        int ts_[9]; moe_tstart(F, ts_); pg8::MoeSplitSched S; S.set_tstart(ts_); S.brows = DM; S.init2(ts_[8], DM / 256, F.G, F.bid, FFE / 128);
        pg8::Gemm g{(const bf16_t*)(ws + B1_H), (const bf16_t*)(ws + WS_WE2), FFE / 2, FFE / 2, FFE / 2};
        pg8::EpiYSlab E{(bf16_t*)(ws + B1_Y), DM, (float*)(ws + B1_SLAB), (unsigned*)(ws + WS_CTL) + CW_FLAG, DM / 256, S.S, 1.0f / 512.0f}; pg8::gemm_phase<pg8::EpiYSlab, pg8::MoeSplitSched, true>(F.lds, g, S, E, F.tid); } SEAM(20);
    if (IN(21)) for (int rep_ = 0; rep_ <= REP(21); ++rep_) { if (rep_) xcd_barrier(bar, LEADER()); MKCTX(F); int ts_[9]; moe_tstart(F, ts_); phase_final(F, args.in[26], args.in[27], pg8::split_factor(ts_[8] * (DM / 256), F.G, FFE / 128), args.in[20], args.in[21]); }
#undef IN
#undef SEAM
}

extern "C" void kernel_launch(void* const* d_in, const int* in_sizes, int n_in, void* d_out, int out_size, void* d_ws, size_t ws_size, hipStream_t stream) {
    static int grid = 0;
    if (grid == 0) {
        if (n_in != 28 || out_size != M * DM || ws_size < WS_NEED) { fprintf(stderr, "kernel_launch: unexpected shapes (n_in %d, out %d, ws %zu < %zu)\n", n_in, out_size, ws_size, (size_t)WS_NEED); grid = -1; return; }
        int dev = 0, cus = 0, per_cu = 0;
        if (hipGetDevice(&dev) != hipSuccess || hipDeviceGetAttribute(&cus, hipDeviceAttributeMultiprocessorCount, dev) != hipSuccess) { grid = -1; return; }
        if (hipFuncSetAttribute((const void*)fwd, hipFuncAttributeMaxDynamicSharedMemorySize, LDS_BYTES) != hipSuccess) { fprintf(stderr, "kernel_launch: hipFuncSetAttribute failed\n"); grid = -1; return; }
        if (hipOccupancyMaxActiveBlocksPerMultiprocessor(&per_cu, (const void*)fwd, NTHREADS, LDS_BYTES) != hipSuccess || per_cu < 1) fprintf(stderr, "kernel_launch: occupancy query reports %d\n", per_cu);
        (void)hipGetLastError();
        grid = cus;
    }
    if (grid < 0) return;
    if (hipMemsetAsync((char*)d_ws + WS_CTL, 0, CTL_ZERO_BYTES, stream) != hipSuccess) return;
    Args a{};
    for (int i = 0; i < 28; ++i) a.in[i] = (const float*)d_in[i];
    a.out = (float*)d_out; a.ws = (unsigned char*)d_ws;
#if MK_PER_PHASE
    for (int p = 0; p < NPHASE; ++p) { a.ph_lo = p; a.ph_hi = p + 1; hipLaunchKernelGGL(fwd, dim3(grid), dim3(NTHREADS), LDS_BYTES, stream, a); }
#else
    a.ph_lo = 0; a.ph_hi = NPHASE; hipLaunchKernelGGL(fwd, dim3(grid), dim3(NTHREADS), LDS_BYTES, stream, a);
#endif
}
```
